# Optimizing an MI355X kernel written in HIP

```python
import jax, jax.numpy as jnp
from jax import lax
import numpy as np

D_MODEL = 1024
BATCH = 8
SEQ = 4096
DEPTH = 2

N_MIXERS = 2
N_RET = (DEPTH + 1) // 2
N_FOX = DEPTH // 2
D_PLE = 256
D_FF = 2816
EPS = 1e-6
RET_DK = 256
RET_HEADS = D_MODEL // RET_DK
RET_DV = 2 * RET_DK
RET_CHUNK = 128
ROPE_BASE = 10000.0
RET_IN = RET_HEADS * (2 * RET_DK + 2 * RET_DV)
FOX_DH = 64
FOX_HEADS = D_MODEL // FOX_DH
FOX_BLOCK = 128
FOX_IN = 3 * FOX_HEADS * FOX_DH + FOX_HEADS

kernel_name = "hybrid_retention_forgetting_attention_macaron"


def rmsnorm(x, w):
    xf = x.astype(jnp.float32)
    y = xf * lax.rsqrt(jnp.mean(xf * xf, axis=-1, keepdims=True) + EPS)
    return (y * w.astype(jnp.float32)).astype(x.dtype)


def swiglu(x, w_in, w_out):
    g, u = jnp.split(x @ w_in, 2, axis=-1)
    return (jax.nn.silu(g) * u) @ w_out


def rotary(x, pos):
    half = x.shape[-1] // 2
    inv_freq = ROPE_BASE ** (-jnp.arange(half, dtype=jnp.float32) / half)
    ang = pos[:, None] * inv_freq[None, :]
    cos = jnp.cos(ang)[None, :, None, :]
    sin = jnp.sin(ang)[None, :, None, :]
    xf = x.astype(jnp.float32)
    x1, x2 = xf[..., :half], xf[..., half:]
    return jnp.concatenate([x1 * cos - x2 * sin, x1 * sin + x2 * cos], axis=-1).astype(x.dtype)


def retention(h, w_in, gn_w, w_out):
    B, S, _ = h.shape
    H, DK, DV, C = RET_HEADS, RET_DK, RET_DV, RET_CHUNK
    NC = S // C
    q, k, v, g = jnp.split(h @ w_in, [H * DK, 2 * H * DK, 2 * H * DK + H * DV], axis=-1)
    pos = jnp.arange(S, dtype=jnp.float32)
    q = rotary(q.reshape(B, S, H, DK), pos)
    k = rotary(k.reshape(B, S, H, DK), pos) * (DK ** -0.5)
    v = v.reshape(B, S, H, DV)
    log_gamma = jnp.log1p(-jnp.exp2(-5.0 - jnp.arange(H, dtype=jnp.float32)))
    idx = jnp.arange(C, dtype=jnp.float32)
    diff = idx[:, None] - idx[None, :]
    decay_intra = jnp.where(diff[None] >= 0,
                            jnp.exp(log_gamma[:, None, None] * jnp.maximum(diff, 0.0)[None]), 0.0)
    zeta = jnp.exp(log_gamma[:, None] * (C - 1 - idx)[None, :])
    xi = jnp.exp(log_gamma[:, None] * (idx + 1)[None, :]).T
    gamma_c = jnp.exp(log_gamma * C)

    def to_chunks(t):
        return t.reshape(B, NC, C, H, t.shape[-1]).transpose(1, 0, 2, 3, 4)

    def step(state, inp):
        qc, kc, vc = inp
        qf, kf, vf = (t.astype(jnp.float32) for t in (qc, kc, vc))
        s = jnp.einsum('bqhd,bkhd->bhqk', qf, kf) * decay_intra[None]
        inner = jnp.einsum('bhqk,bkhe->bqhe', s, vf)
        cross = jnp.einsum('bqhd,bhde->bqhe', qf, state) * xi[None, :, :, None]
        new_state = gamma_c[None, :, None, None] * state + jnp.einsum('bkhd,hk,bkhe->bhde', kf, zeta, vf)
        return new_state, (inner + cross).astype(qc.dtype)

    state0 = jnp.zeros((B, H, DK, DV), jnp.float32)
    _, o = lax.scan(step, state0, (to_chunks(q), to_chunks(k), to_chunks(v)))
    o = o.transpose(1, 0, 2, 3, 4).reshape(B, S, H, DV)
    o = rmsnorm(o, gn_w)
    y = jax.nn.silu(g) * o.reshape(B, S, H * DV)
    return y @ w_out


def forgetting_attention(h, w_in, b_f, w_out):
    B, S, D = h.shape
    H, DH, Q = FOX_HEADS, FOX_DH, FOX_BLOCK
    NB = S // Q
    q, k, v, fz = jnp.split(h @ w_in, [H * DH, 2 * H * DH, 3 * H * DH], axis=-1)
    q = q.reshape(B, S, H, DH).transpose(0, 2, 1, 3)
    k = k.reshape(B, S, H, DH).transpose(0, 2, 1, 3)
    v = v.reshape(B, S, H, DH).transpose(0, 2, 1, 3)
    log_f = jax.nn.log_sigmoid(fz.astype(jnp.float32) + b_f.astype(jnp.float32))
    c = jnp.cumsum(log_f, axis=1).transpose(0, 2, 1)
    kpos = jnp.arange(S)
    scale = DH ** -0.5

    def block(i):
        start = i * Q
        qb = lax.dynamic_slice_in_dim(q, start, Q, axis=2)
        cb = lax.dynamic_slice_in_dim(c, start, Q, axis=2)
        logits = (jnp.einsum('bhqd,bhkd->bhqk', qb, k).astype(jnp.float32) * scale
                  + cb[..., None] - c[:, :, None, :])
        qpos = start + jnp.arange(Q)
        logits = jnp.where((kpos[None, :] <= qpos[:, None])[None, None], logits, -jnp.inf)
        w = jax.nn.softmax(logits, axis=-1)
        return jnp.einsum('bhqk,bhkd->bhqd', w.astype(v.dtype), v)

    o = lax.map(block, jnp.arange(NB))
    o = o.transpose(1, 0, 3, 2, 4).reshape(B, S, H * DH)
    return o @ w_out


def setup_inputs(seed: int = 0) -> dict:
    key = jax.random.key(seed)
    ks = jax.random.split(key, 14)
    f32 = jnp.float32
    nrm = lambda k, shape, fan: jax.random.normal(k, shape, f32) * (fan ** -0.5)
    return {
        "x": jax.random.normal(ks[0], (BATCH, SEQ, D_MODEL), f32),
        "p": jax.random.normal(ks[1], (DEPTH, BATCH, SEQ, D_PLE), f32),
        "norm_w": 1.0 + 0.02 * jax.random.normal(ks[2], (DEPTH, 4, D_MODEL), f32),
        "ffn_w_in": nrm(ks[3], (DEPTH, 2, D_MODEL, 2 * D_FF), D_MODEL),
        "ffn_w_out": nrm(ks[4], (DEPTH, 2, D_FF, D_MODEL), D_FF),
        "ret_w_in": nrm(ks[5], (N_RET, D_MODEL, RET_IN), D_MODEL),
        "ret_gn_w": 1.0 + 0.02 * jax.random.normal(ks[6], (N_RET, RET_HEADS, RET_DV), f32),
        "ret_w_out": nrm(ks[7], (N_RET, RET_HEADS * RET_DV, D_MODEL), RET_HEADS * RET_DV),
        "fox_w_in": nrm(ks[8], (N_FOX, D_MODEL, FOX_IN), D_MODEL),
        "fox_b_f": jax.random.uniform(ks[9], (N_FOX, FOX_HEADS), f32, 1.0, 4.0),
        "fox_w_out": nrm(ks[10], (N_FOX, D_MODEL, D_MODEL), D_MODEL),
        "ple_w_proj": nrm(ks[11], (DEPTH, D_PLE, D_MODEL), D_PLE),
        "ple_w_gate": nrm(ks[12], (DEPTH, D_MODEL, D_MODEL), D_MODEL),
        "final_norm_w": 1.0 + 0.02 * jax.random.normal(ks[13], (D_MODEL,), f32),
    }


def reference(x, p, norm_w, ffn_w_in, ffn_w_out, ret_w_in, ret_gn_w, ret_w_out,
              fox_w_in, fox_b_f, fox_w_out, ple_w_proj, ple_w_gate, final_norm_w):
    h = x
    for i in range(DEPTH):
        nw = norm_w[i]
        h = h + 0.5 * swiglu(rmsnorm(h, nw[0]), ffn_w_in[i, 0], ffn_w_out[i, 0])
        hn = rmsnorm(h, nw[1])
        j = i // N_MIXERS
        if i % N_MIXERS == 0:
            h = h + retention(hn, ret_w_in[j], ret_gn_w[j], ret_w_out[j])
        else:
            h = h + forgetting_attention(hn, fox_w_in[j], fox_b_f[j], fox_w_out[j])
        h = h + 0.5 * swiglu(rmsnorm(h, nw[2]), ffn_w_in[i, 1], ffn_w_out[i, 1])
        gate = jax.nn.sigmoid(rmsnorm(h, nw[3]) @ ple_w_gate[i])
        h = h + gate * (p[i] @ ple_w_proj[i])
    return rmsnorm(h, final_norm_w)
```

```cpp
#include <hip/hip_runtime.h>
#include <hip/hip_cooperative_groups.h>
#include <cstdio>
#include <cstdint>
namespace cg = cooperative_groups;
namespace pg8 {
#define PG8_LAS __attribute__((address_space(3)))
typedef unsigned short bf16_t;
typedef short bf16x8 __attribute__((ext_vector_type(8)));
typedef float f32x4 __attribute__((ext_vector_type(4)));
typedef unsigned u32x4 __attribute__((ext_vector_type(4)));
constexpr int BM = 256, BK = 64, HALF = 128, HTB = HALF * BK * 2  , STAGE_BYTES = 8 * HTB, NXCD = 8, WGM = 8;

__host__ __device__ __forceinline__ int lds_byte(int r, int c) { const int st = (r >> 4) * 2 + (c >> 5), rr = r & 15, cc = c & 31, ob = rr * 64 + cc * 2; return st * 1024 + (ob ^ (((ob >> 9) & 1) << 5)); }
__host__ __device__ __forceinline__ void stage_rc(int b, int& R, int& C) { const int st = b / 1024, sb = b % 1024, swz = sb ^ (((sb >> 9) & 1) << 5); R = (st >> 1) * 16 + swz / 64; C = (st & 1) * 32 + (swz % 64) / 2; }
__host__ __device__ __forceinline__ int perm32(int rho) { const int n = rho >> 4, i = rho & 15; return 8 * (i >> 2) + 4 * n + (i & 3); }

struct Unit { int pm, pn; };
struct Gemm { const bf16_t* A; const bf16_t* Bt; int M, N, K; };

struct StaticOrder {
    int nM, nN, nwg, G, c;
    __host__ __device__ void init(int M, int N, int G_, int c_) { nM = M / BM; nN = N / BM; nwg = nM * nN; G = G_; c = c_; }
    __host__ __device__ bool next(int i, Unit& u) const {
        const long L = (long)i * G + c; if (L >= nwg) return false;
        int wgid = (int)L; { const int q = nwg / NXCD, r = nwg % NXCD, xcd = wgid % NXCD, off = wgid / NXCD; wgid = (xcd < r ? xcd * (q + 1) : r * (q + 1) + (xcd - r) * q) + off; }
        const int nig = WGM * nN, gid = wgid / nig, fm = gid * WGM, gsz = (nM - fm) < WGM ? (nM - fm) : WGM;
        u.pm = fm + ((wgid % nig) % gsz); u.pn = (wgid % nig) / gsz; return true;
    }
    __device__ __forceinline__ void a_ready(const Unit&) const {}
    __device__ __forceinline__ void done(const Unit&) const {}
};
__device__ __forceinline__ unsigned cvt_pk_bf16(float lo, float hi) { unsigned r; asm volatile("v_cvt_pk_bf16_f32 %0, %1, %2" : "=v"(r) : "v"(lo), "v"(hi)); return r; }
__device__ __forceinline__ u32x4 pack8(const f32x4 v0, const f32x4 v1) { u32x4 w; w.x = cvt_pk_bf16(v0[0], v0[1]); w.y = cvt_pk_bf16(v0[2], v0[3]); w.z = cvt_pk_bf16(v1[0], v1[1]); w.w = cvt_pk_bf16(v1[2], v1[3]); return w; }
__device__ __forceinline__ float bflo(unsigned u) { return __uint_as_float(u << 16); }
__device__ __forceinline__ float bfhi(unsigned u) { return __uint_as_float(u & 0xffff0000u); }
__device__ __forceinline__ void unpack8(const u32x4 w, f32x4& v0, f32x4& v1) { v0 = (f32x4){bflo(w.x), bfhi(w.x), bflo(w.y), bfhi(w.y)}; v1 = (f32x4){bflo(w.z), bfhi(w.z), bflo(w.w), bfhi(w.w)}; }
__device__ __forceinline__ float sigm(float x) { return __builtin_amdgcn_rcpf(1.0f + __builtin_amdgcn_exp2f(-1.4426950408889634f * x)); }
__device__ __forceinline__ f32x4 silu4(const f32x4 x) { return (f32x4){x[0] * sigm(x[0]), x[1] * sigm(x[1]), x[2] * sigm(x[2]), x[3] * sigm(x[3])}; }
__device__ __forceinline__ f32x4 sigm4(const f32x4 x) { return (f32x4){sigm(x[0]), sigm(x[1]), sigm(x[2]), sigm(x[3])}; }
__device__ __forceinline__ float rinv_of(const float* ss, int r) { return 1.0f / sqrtf(ss[r] * (1.0f / 1024.0f) + 1e-6f); }
#define EPI_ARGS const f32x4 (&acc)[2][2][4][2], const Unit& u, int wr, int wc, int fr, int fq
#define EPI_ROWS(ai, m) (u.pm * BM + (ai) * HALF + wr * 64 + (m) * 16 + fr)

struct EpiSwiglu { static constexpr bool PERM = true, AFTER_DRAIN = false; bf16_t* act; const float* ss;
    __device__ __forceinline__ void operator()(EPI_ARGS) const {
        const int col0 = u.pn * HALF + wc * 32 + 8 * fq;
#pragma unroll
        for (int ai = 0; ai < 2; ++ai)
#pragma unroll
            for (int m = 0; m < 4; ++m) { const int r = EPI_ROWS(ai, m); const float ri = rinv_of(ss, r);
                const f32x4 a0 = silu4(acc[ai][0][m][0] * ri) * (acc[ai][1][m][0] * ri), a1 = silu4(acc[ai][0][m][1] * ri) * (acc[ai][1][m][1] * ri);
                *(u32x4*)(act + (size_t)r * 2816 + col0) = pack8(a0, a1); }
    }
};
struct EpiRes { static constexpr bool PERM = true, AFTER_DRAIN = false; const float* hin; float* hout; bf16_t* hb; float* ssn; float scale;
    __device__ __forceinline__ void operator()(EPI_ARGS) const {
#pragma unroll
        for (int ai = 0; ai < 2; ++ai)
#pragma unroll
            for (int m = 0; m < 4; ++m) { const int r = EPI_ROWS(ai, m); float sq = 0.f;
#pragma unroll
                for (int bj = 0; bj < 2; ++bj) { const size_t off = (size_t)r * 1024 + u.pn * BM + bj * HALF + wc * 32 + 8 * fq;
                    const f32x4 v0 = *(const f32x4*)(hin + off) + acc[ai][bj][m][0] * scale, v1 = *(const f32x4*)(hin + off + 4) + acc[ai][bj][m][1] * scale;
                    *(f32x4*)(hout + off) = v0; *(f32x4*)(hout + off + 4) = v1; *(u32x4*)(hb + off) = pack8(v0, v1);
                    sq += (v0[0] * v0[0] + v0[1] * v0[1]) + (v0[2] * v0[2] + v0[3] * v0[3]) + (v1[0] * v1[0] + v1[1] * v1[1]) + (v1[2] * v1[2] + v1[3] * v1[3]); }
                sq += __shfl_xor(sq, 16); sq += __shfl_xor(sq, 32); if (fq == 0) atomicAdd(ssn + r, sq); }
    }
};
struct EpiPle { static constexpr bool PERM = true, AFTER_DRAIN = false; const float* hin; float* hout; bf16_t* hb; float* ssn; const float* ss; const bf16_t* pp;
    __device__ __forceinline__ void operator()(EPI_ARGS) const {
#pragma unroll
        for (int ai = 0; ai < 2; ++ai)
#pragma unroll
            for (int m = 0; m < 4; ++m) { const int r = EPI_ROWS(ai, m); const float ri = rinv_of(ss, r); float sq = 0.f;
#pragma unroll
                for (int bj = 0; bj < 2; ++bj) { const size_t off = (size_t)r * 1024 + u.pn * BM + bj * HALF + wc * 32 + 8 * fq;
                    f32x4 p0, p1; unpack8(*(const u32x4*)(pp + off), p0, p1);
                    const f32x4 v0 = *(const f32x4*)(hin + off) + sigm4(acc[ai][bj][m][0] * ri) * p0, v1 = *(const f32x4*)(hin + off + 4) + sigm4(acc[ai][bj][m][1] * ri) * p1;
                    *(f32x4*)(hout + off) = v0; *(f32x4*)(hout + off + 4) = v1; *(u32x4*)(hb + off) = pack8(v0, v1);
                    sq += (v0[0] * v0[0] + v0[1] * v0[1]) + (v0[2] * v0[2] + v0[3] * v0[3]) + (v1[0] * v1[0] + v1[1] * v1[1]) + (v1[2] * v1[2] + v1[3] * v1[3]); }
                sq += __shfl_xor(sq, 16); sq += __shfl_xor(sq, 32); if (fq == 0) atomicAdd(ssn + r, sq); }
    }
};
struct EpiPlain { static constexpr bool PERM = true, AFTER_DRAIN = false; bf16_t* O; int ldc; const float* ss; int split_cols; size_t split_stride; float scale0;
    __device__ __forceinline__ void operator()(EPI_ARGS) const {
        int colt = u.pn * BM; bf16_t* base = O; float sc = 1.f;
        if (split_cols) { const int t = colt / split_cols; base += (size_t)t * split_stride; colt -= t * split_cols; if (t == 0) sc = scale0; }
        const int col0 = colt + wc * 32 + 8 * fq;
#pragma unroll
        for (int ai = 0; ai < 2; ++ai)
#pragma unroll
            for (int m = 0; m < 4; ++m) { const int r = EPI_ROWS(ai, m); const float ri = (ss ? rinv_of(ss, r) : 1.0f) * sc;
#pragma unroll
                for (int bj = 0; bj < 2; ++bj) *(u32x4*)(base + (size_t)r * ldc + col0 + bj * HALF) = pack8(acc[ai][bj][m][0] * ri, acc[ai][bj][m][1] * ri); }
    }
};
struct EpiRetIn { static constexpr bool PERM = true, AFTER_DRAIN = false; bf16_t* Qt; bf16_t* Kt; bf16_t* V; const float* ss; const float* rope  ;
    __device__ __forceinline__ void operator()(EPI_ARGS) const {
        const int pn = u.pn;
        if (pn >= 8) {
            const int col0 = (pn - 8) * BM + wc * 32 + 8 * fq;
#pragma unroll
            for (int ai = 0; ai < 2; ++ai)
#pragma unroll
                for (int m = 0; m < 4; ++m) { const int r = EPI_ROWS(ai, m); const float ri = rinv_of(ss, r);
#pragma unroll
                    for (int bj = 0; bj < 2; ++bj) *(u32x4*)(V + (size_t)r * 2048 + col0 + bj * HALF) = pack8(acc[ai][bj][m][0] * ri, acc[ai][bj][m][1] * ri); }
            return;
        }
        const bool isk = pn >= 4; const int hd = pn & 3; bf16_t* outp = isk ? Kt : Qt;
        const float lg = log2f(1.0f - exp2f(-5.0f - (float)hd));
        const int j0 = wc * 32 + 8 * fq;
#pragma unroll
        for (int ai = 0; ai < 2; ++ai)
#pragma unroll
            for (int m = 0; m < 4; ++m) { const int r = EPI_ROWS(ai, m); const int pos = r & 4095; const float e1 = (float)((pos & 63) + 1) * lg;
                const float f = rinv_of(ss, r) * (isk ? 0.0625f * exp2f(-e1) : exp2f(e1));
                const f32x4* cs = (const f32x4*)(rope + ((size_t)pos * 128 + j0) * 2);
                const f32x4 c01 = cs[0], c23 = cs[1], c45 = cs[2], c67 = cs[3];
                const f32x4 x10 = acc[ai][0][m][0] * f, x11 = acc[ai][0][m][1] * f, x20 = acc[ai][1][m][0] * f, x21 = acc[ai][1][m][1] * f;
                const f32x4 cc0 = (f32x4){c01[0], c01[2], c23[0], c23[2]}, sn0 = (f32x4){c01[1], c01[3], c23[1], c23[3]};
                const f32x4 cc1 = (f32x4){c45[0], c45[2], c67[0], c67[2]}, sn1 = (f32x4){c45[1], c45[3], c67[1], c67[3]};
                const f32x4 y10 = x10 * cc0 - x20 * sn0, y11 = x11 * cc1 - x21 * sn1, y20 = x10 * sn0 + x20 * cc0, y21 = x11 * sn1 + x21 * cc1;
                bf16_t* rowp = outp + (size_t)r * 1024 + hd * 256 + j0;
                *(u32x4*)(rowp) = pack8(y10, y11); *(u32x4*)(rowp + HALF) = pack8(y20, y21); }
    }
};
struct EpiRetGate { static constexpr bool PERM = true, AFTER_DRAIN = false; bf16_t* Y; const float* ss; const float* hss; const float* gnw;
    __device__ __forceinline__ void operator()(EPI_ARGS) const {
        const int hd = u.pn >> 1;
#pragma unroll
        for (int ai = 0; ai < 2; ++ai)
#pragma unroll
            for (int m = 0; m < 4; ++m) { const int r = EPI_ROWS(ai, m); const float ri = rinv_of(ss, r); const float hr = 1.0f / sqrtf(hss[(size_t)r * 4 + hd] * (1.0f / 512.0f) + 1e-6f);
#pragma unroll
                for (int bj = 0; bj < 2; ++bj) { const int c = u.pn * BM + bj * HALF + wc * 32 + 8 * fq; bf16_t* p = Y + (size_t)r * 2048 + c;
                    f32x4 o0, o1; unpack8(*(const u32x4*)p, o0, o1);
                    const f32x4 g0 = *(const f32x4*)(gnw + c) * hr, g1 = *(const f32x4*)(gnw + c + 4) * hr;
                    *(u32x4*)p = pack8(silu4(acc[ai][bj][m][0] * ri) * o0 * g0, silu4(acc[ai][bj][m][1] * ri) * o1 * g1); }
            }
    }
};
template <class Epi, class Sched, bool ALIGN_EPI = false, bool SP2 = false>
__device__ __forceinline__ void gemm_phase(PG8_LAS unsigned char* lds, const Gemm g, const Sched& S, const Epi& E) {
    int tid_ = threadIdx.x; asm volatile("" : "+v"(tid_));
    const int tid = tid_, wid = __builtin_amdgcn_readfirstlane(tid >> 6), lane = tid & 63, wr = wid >> 2, wc = wid & 3, fr = lane & 15, fq = lane >> 4;
    const int K = g.K, nt = K / BK;
    unsigned voffA[2], voffB[2];
#pragma unroll
    for (int i = 0; i < 2; ++i) { int R, C; stage_rc(tid * 16 + i * 8192, R, C); const int Rb = Epi::PERM ? ((R & ~31) + perm32(R & 31)) : R;
        voffA[i] = (unsigned)(R * K + C) * 2u; voffB[i] = (unsigned)(Rb * K + C) * 2u; }
    const size_t kstep = (size_t)(BK * 2);
    const size_t hstep = (size_t)HALF * K * 2;
    const size_t tstep = 2 * hstep;
    const unsigned ldsw = (unsigned)wid * 1024u;
    const int aoff = lds_byte(wr * 64 + fr, fq * 8), boff = lds_byte(wc * 32 + fr, fq * 8);
#define PG8_SA(b, h) (((b) * 2 + (h)) * HTB)
#define PG8_SB(b, h) ((4 + (b) * 2 + (h)) * HTB)
#define PG8_STAGE(bufoff, gbase, voff) do { _Pragma("unroll") for (int _i = 0; _i < 2; ++_i) \
        __builtin_amdgcn_global_load_lds((const unsigned*)((const char*)(gbase) + (voff)[_i]), (PG8_LAS unsigned*)(lds + (bufoff) + ldsw + _i * 8192), 16, 0, 0); } while (0)
#define PG8_LDA(dst, b, h) do { _Pragma("unroll") for (int m = 0; m < 4; ++m) _Pragma("unroll") for (int k = 0; k < 2; ++k) dst[m][k] = *(const PG8_LAS bf16x8*)(lds + PG8_SA(b, h) + aoff + m * 2048 + k * 1024); } while (0)
#define PG8_LDB(dst, b, h) do { _Pragma("unroll") for (int n = 0; n < 2; ++n) _Pragma("unroll") for (int k = 0; k < 2; ++k) dst[n][k] = *(const PG8_LAS bf16x8*)(lds + PG8_SB(b, h) + boff + n * 2048 + k * 1024); } while (0)
#define PG8_MMA(ai, bj, At, Bt) do { __builtin_amdgcn_s_setprio(1); _Pragma("unroll") for (int m = 0; m < 4; ++m) _Pragma("unroll") for (int n = 0; n < 2; ++n) _Pragma("unroll") for (int k = 0; k < 2; ++k) \
        acc[ai][bj][m][n] = __builtin_amdgcn_mfma_f32_16x16x32_bf16(Bt[n][k], At[m][k], acc[ai][bj][m][n], 0, 0, 0); __builtin_amdgcn_s_setprio(0); } while (0)
#define PG8_WAIT_V(n) asm volatile("s_waitcnt vmcnt(" #n ")" ::: "memory")
#define PG8_WAIT_L(n) asm volatile("s_waitcnt lgkmcnt(" #n ")" ::: "memory")
#define PG8_BAR __builtin_amdgcn_s_barrier()
#define PG8_SCHED __builtin_amdgcn_sched_barrier(0)
    Unit cur, nxt; int ui = 0;
    if (!S.next(0, cur)) return;
    f32x4 acc[2][2][4][2];
#pragma unroll
    for (int a = 0; a < 2; ++a)
#pragma unroll
        for (int b = 0; b < 2; ++b)
#pragma unroll
            for (int m = 0; m < 4; ++m)
#pragma unroll
                for (int n = 0; n < 2; ++n) acc[a][b][m][n] = (f32x4){0.f, 0.f, 0.f, 0.f};
    bf16x8 At[4][2], B0[2][2], B1[2][2];
    const char* cA = (const char*)g.A + (size_t)cur.pm * tstep; const char* cB = (const char*)g.Bt + (size_t)cur.pn * tstep;
    S.a_ready(cur);
    if constexpr (SP2) {
        PG8_STAGE(PG8_SB(0, 0), cB, voffB); PG8_STAGE(PG8_SB(0, 1), cB + hstep, voffB); PG8_STAGE(PG8_SA(0, 0), cA, voffA); PG8_STAGE(PG8_SA(0, 1), cA + hstep, voffA);
        if (wr == 1) PG8_BAR;
        PG8_WAIT_V(2); PG8_BAR;
        PG8_STAGE(PG8_SB(1, 0), cB + kstep, voffB); PG8_STAGE(PG8_SA(1, 0), cA + kstep, voffA); PG8_STAGE(PG8_SB(1, 1), cB + hstep + kstep, voffB);
        PG8_WAIT_V(6); PG8_BAR;
    } else {
        PG8_STAGE(PG8_SB(0, 0), cB, voffB); PG8_STAGE(PG8_SA(0, 0), cA, voffA); PG8_STAGE(PG8_SB(0, 1), cB + hstep, voffB); PG8_STAGE(PG8_SA(0, 1), cA + hstep, voffA);
        if (wr == 1) PG8_BAR;
        PG8_WAIT_V(4); PG8_BAR;
        PG8_STAGE(PG8_SB(1, 0), cB + kstep, voffB); PG8_STAGE(PG8_SA(1, 0), cA + kstep, voffA); PG8_STAGE(PG8_SB(1, 1), cB + hstep + kstep, voffB);
        PG8_WAIT_V(6); PG8_BAR;
    }
    for (;;) {
        const bool has_next = S.next(ui + 1, nxt);
        const char* nA = has_next ? (const char*)g.A + (size_t)nxt.pm * tstep : cA; const char* nB = has_next ? (const char*)g.Bt + (size_t)nxt.pn * tstep : cB;
        for (int t = 0; t < nt; t += 2) {
            const bool last = (t == nt - 2);
            const char* a1 = cA + (size_t)(t + 1) * kstep;
            const char* a2 = last ? nA : cA + (size_t)(t + 2) * kstep; const char* b2 = last ? nB : cB + (size_t)(t + 2) * kstep;
            const char* a3 = a2 + kstep; const char* b3 = b2 + kstep;
            if (last && has_next) S.a_ready(nxt);
            if constexpr (SP2) {
            PG8_LDB(B0, 0, 0); PG8_LDB(B1, 0, 1); PG8_SCHED; PG8_LDA(At, 0, 0); PG8_STAGE(PG8_SA(1, 1), a1 + hstep, voffA);
            PG8_WAIT_V(8); PG8_WAIT_L(0); PG8_BAR; PG8_MMA(0, 0, At, B0); PG8_MMA(0, 1, At, B1); PG8_BAR; PG8_SCHED;
            PG8_LDA(At, 0, 1); PG8_STAGE(PG8_SB(0, 0), b2, voffB); PG8_STAGE(PG8_SB(0, 1), b2 + hstep, voffB); PG8_STAGE(PG8_SA(0, 0), a2, voffA);
            PG8_WAIT_V(8); PG8_WAIT_L(0); PG8_BAR; PG8_MMA(1, 0, At, B0); PG8_MMA(1, 1, At, B1); PG8_BAR; PG8_SCHED;
            PG8_LDB(B0, 1, 0); PG8_LDB(B1, 1, 1); PG8_SCHED; PG8_LDA(At, 1, 0); PG8_STAGE(PG8_SA(0, 1), a2 + hstep, voffA);
            PG8_WAIT_V(8); PG8_WAIT_L(0); PG8_BAR; PG8_MMA(0, 0, At, B0); PG8_MMA(0, 1, At, B1); PG8_BAR; PG8_SCHED;
            PG8_LDA(At, 1, 1); PG8_STAGE(PG8_SB(1, 0), b3, voffB); PG8_STAGE(PG8_SB(1, 1), b3 + hstep, voffB); PG8_STAGE(PG8_SA(1, 0), a3, voffA);
            PG8_WAIT_V(8); PG8_WAIT_L(0); PG8_BAR; PG8_MMA(1, 0, At, B0); PG8_MMA(1, 1, At, B1); PG8_BAR; PG8_SCHED;
            } else {
            PG8_LDB(B0, 0, 0); PG8_SCHED; PG8_LDA(At, 0, 0); PG8_STAGE(PG8_SA(1, 1), a1 + hstep, voffA);
            PG8_WAIT_L(8); PG8_BAR; PG8_WAIT_L(0); PG8_MMA(0, 0, At, B0); PG8_BAR; PG8_SCHED;
            PG8_LDB(B1, 0, 1); PG8_STAGE(PG8_SB(0, 0), b2, voffB);
            PG8_BAR; PG8_WAIT_L(0); PG8_MMA(0, 1, At, B1); PG8_BAR;
            PG8_LDA(At, 0, 1); PG8_STAGE(PG8_SA(0, 0), a2, voffA);
            PG8_BAR; PG8_WAIT_L(0); PG8_MMA(1, 0, At, B0); PG8_BAR; PG8_SCHED;
            PG8_STAGE(PG8_SB(0, 1), b2 + hstep, voffB);
            PG8_WAIT_V(6); PG8_BAR; PG8_MMA(1, 1, At, B1); PG8_BAR;
            PG8_LDB(B0, 1, 0); PG8_SCHED; PG8_LDA(At, 1, 0); PG8_STAGE(PG8_SA(0, 1), a2 + hstep, voffA);
            PG8_WAIT_L(8); PG8_BAR; PG8_WAIT_L(0); PG8_MMA(0, 0, At, B0); PG8_BAR; PG8_SCHED;
            PG8_LDB(B1, 1, 1); PG8_STAGE(PG8_SB(1, 0), b3, voffB);
            PG8_BAR; PG8_WAIT_L(0); PG8_MMA(0, 1, At, B1); PG8_BAR;
            PG8_LDA(At, 1, 1); PG8_STAGE(PG8_SA(1, 0), a3, voffA);
            PG8_BAR; PG8_WAIT_L(0); PG8_MMA(1, 0, At, B0); PG8_BAR; PG8_SCHED;
            PG8_STAGE(PG8_SB(1, 1), b3 + hstep, voffB);
            PG8_WAIT_V(6); PG8_BAR; PG8_MMA(1, 1, At, B1); PG8_BAR;
            }
        }
        if constexpr (ALIGN_EPI) { if (wr == 0) PG8_BAR; }
        if constexpr (!Epi::AFTER_DRAIN) { E(acc, cur, wr, wc, fr, fq); S.done(cur); }
        if (!has_next) break;
#pragma unroll
        for (int a = 0; a < 2; ++a)
#pragma unroll
            for (int b = 0; b < 2; ++b)
#pragma unroll
                for (int m = 0; m < 4; ++m)
#pragma unroll
                    for (int n = 0; n < 2; ++n) acc[a][b][m][n] = (f32x4){0.f, 0.f, 0.f, 0.f};
        cur = nxt; cA = nA; cB = nB; ++ui;
        if constexpr (ALIGN_EPI) { if (wr == 1) PG8_BAR; }
    }
    PG8_WAIT_V(0);
    if constexpr (!ALIGN_EPI) { if (wr == 0) PG8_BAR; }
    PG8_BAR;
    if constexpr (Epi::AFTER_DRAIN) { E.fused(acc, cur, wr, wc, fr, fq, lds, wid, lane); S.done(cur); }
#undef PG8_SA
#undef PG8_SB
#undef PG8_STAGE
#undef PG8_LDA
#undef PG8_LDB
#undef PG8_MMA
#undef PG8_WAIT_V
#undef PG8_WAIT_L
#undef PG8_BAR
#undef PG8_SCHED
}
}
#include <hip/hip_bf16.h>
#include <cmath>
namespace attn_body {
using bf16=__hip_bfloat16;
using bf16x8=__attribute__((ext_vector_type(8)))short;
using s16x4=__attribute__((ext_vector_type(4)))short;
using f32x16=__attribute__((ext_vector_type(16)))float;
using u32x4=__attribute__((ext_vector_type(4)))unsigned;
constexpr int BATCH=8,NHEAD=16,SEQ=4096,D=64,DM=NHEAD*D;
constexpr int NW=8,QBLK=32,QB=QBLK*NW,KVBLK=64,NQB=SEQ/QB;
constexpr int ATTN_PITCH=DM, ATTN_UNIT_ROWS=QB;
__device__ __forceinline__ int crow(int r,int hi){return (r&3)+8*(r>>2)+4*hi;}
#define SBAR() __builtin_amdgcn_sched_barrier(0)
__device__ __forceinline__ void cmask(f32x16&p0,f32x16&p1,int jb,int qrel,int hi){
  const float NEG=-INFINITY; int kb=64*jb+4*hi;
  #pragma unroll
  for(int r=0;r<16;++r){int kv=kb+(r&3)+8*(r>>2); if(kv>qrel)p0[r]=NEG; if(kv+32>qrel)p1[r]=NEG;}
}

constexpr int NSLOT=3, SLOTB=8192;
typedef float f32x4_t __attribute__((ext_vector_type(4)));
constexpr int LDS_K=0, LDS_V=NSLOT*SLOTB, LDS_WS=2*NSLOT*SLOTB, LDS_OST=LDS_WS+NW*64*4, LDS_NB=LDS_OST+NW*4096, LDS_BYTES=LDS_NB+SEQ*4;
constexpr float C2=0.125f*1.4426950408889634f;
__device__ __forceinline__ void glds16(const void*gsrc,unsigned lds_dst){unsigned keep;
  asm volatile("s_mov_b32 %0, m0\n\ts_mov_b32 m0, %2\n\ts_nop 0\n\tglobal_load_lds_dwordx4 %1, off\n\ts_mov_b32 m0, %0":"=&s"(keep):"v"(gsrc),"s"(lds_dst):"memory");}
__device__ __forceinline__ float max3f(float a,float b,float c){float r;asm("v_max3_f32 %0, %1, %2, %3":"=v"(r):"v"(a),"v"(b),"v"(c));return r;}
__device__ __forceinline__ float max2f(float a,float b){float r;asm("v_max_f32_e32 %0, %1, %2":"=v"(r):"v"(a),"v"(b));return r;}
__device__ __forceinline__ float fadd_s(float a,float b){float r;asm("v_add_f32_e32 %0, %1, %2":"=v"(r):"v"(a),"v"(b));return r;}
__device__ __forceinline__ float fsub_s(float a,float b){float r;asm("v_sub_f32_e32 %0, %1, %2":"=v"(r):"v"(a),"v"(b));return r;}
typedef float f32x2_t __attribute__((ext_vector_type(2))); typedef __bf16 bf16x2_t __attribute__((ext_vector_type(2)));
__device__ __forceinline__ unsigned cvtpk_s(float lo,float hi){f32x2_t v={lo,hi};bf16x2_t b=__builtin_convertvector(v,bf16x2_t);return __builtin_bit_cast(unsigned,b);}
#define WAIT_BAR(N) asm volatile("s_waitcnt vmcnt(" #N ") lgkmcnt(0)\n\ts_barrier":::"memory")

__device__ __forceinline__ void qkt(f32x16&p0,f32x16&p1,const char*Kslot,const bf16x8*qr,int r32,int hi){
  const char*kb=Kslot+hi*1024+r32*16;
  #pragma unroll
  for(int d0=0;d0<4;++d0){
    const bf16x8 b0=*reinterpret_cast<const bf16x8*>(kb+d0*2048);
    const bf16x8 b1=*reinterpret_cast<const bf16x8*>(kb+d0*2048+512);
    p0=__builtin_amdgcn_mfma_f32_32x32x16_bf16(b0,qr[d0],p0,0,0,0);p1=__builtin_amdgcn_mfma_f32_32x32x16_bf16(b1,qr[d0],p1,0,0,0);}
}
typedef __attribute__((address_space(3))) const char* lds_cptr;
typedef short v4i16_t __attribute__((ext_vector_type(4)));
__device__ __forceinline__ void kload8(bf16x8*kf,lds_cptr kp){
  kf[0]=*(const __attribute__((address_space(3))) bf16x8*)(kp);      kf[1]=*(const __attribute__((address_space(3))) bf16x8*)(kp+512);
  kf[2]=*(const __attribute__((address_space(3))) bf16x8*)(kp+2048); kf[3]=*(const __attribute__((address_space(3))) bf16x8*)(kp+2560);
  kf[4]=*(const __attribute__((address_space(3))) bf16x8*)(kp+4096); kf[5]=*(const __attribute__((address_space(3))) bf16x8*)(kp+4608);
  kf[6]=*(const __attribute__((address_space(3))) bf16x8*)(kp+6144); kf[7]=*(const __attribute__((address_space(3))) bf16x8*)(kp+6656);
}
__device__ __forceinline__ void kload2(bf16x8*kf,lds_cptr kp,int j){ kf[2*j]=*(const __attribute__((address_space(3))) bf16x8*)(kp+j*2048); kf[2*j+1]=*(const __attribute__((address_space(3))) bf16x8*)(kp+j*2048+512); }
__device__ __forceinline__ s16x4 vtr(lds_cptr p){ return __builtin_bit_cast(s16x4,__builtin_amdgcn_ds_read_tr16_b64_v4i16((__attribute__((address_space(3))) v4i16_t*)p)); }
__device__ __forceinline__ float rowmax(const f32x16&p0,const f32x16&p1){
  float a=max3f(p0[0],p0[1],p1[0]),b=max3f(p0[2],p0[3],p1[1]);a=max3f(a,p1[2],p1[3]);
  #pragma unroll
  for(int r=4;r<16;r+=4){a=max3f(a,p0[r],p0[r+1]);b=max3f(b,p0[r+2],p0[r+3]);a=max3f(a,p1[r],p1[r+1]);b=max3f(b,p1[r+2],p1[r+3]);}
  const float m=max2f(a,b);
  auto rr=__builtin_amdgcn_permlane32_swap(__float_as_uint(m),__float_as_uint(m),false,false);
  return max2f(__uint_as_float(rr[0]),__uint_as_float(rr[1]));
}
__device__ __forceinline__ void pv(f32x16*o,int vb,bf16x8 pa0,bf16x8 pa1,bf16x8 pa2,bf16x8 pa3){
  #pragma unroll
  for(int d0=0;d0<2;++d0){s16x4 lo[4],hi[4];
    #pragma unroll
    for(int ks=0;ks<4;++ks){
      asm volatile("ds_read_b64_tr_b16 %0,%1 offset:%c2":"=&v"(lo[ks]):"v"(vb),"i"(d0*4096+ks*1024):"memory");
      asm volatile("ds_read_b64_tr_b16 %0,%1 offset:%c2":"=&v"(hi[ks]):"v"(vb),"i"(d0*4096+ks*1024+512):"memory");}
    asm volatile("s_waitcnt lgkmcnt(0)":::"memory");SBAR();
    #define PK(k) (bf16x8){lo[k][0],lo[k][1],lo[k][2],lo[k][3],hi[k][0],hi[k][1],hi[k][2],hi[k][3]}
    o[d0]=__builtin_amdgcn_mfma_f32_32x32x16_bf16(pa0,PK(0),o[d0],0,0,0);
    o[d0]=__builtin_amdgcn_mfma_f32_32x32x16_bf16(pa1,PK(1),o[d0],0,0,0);
    o[d0]=__builtin_amdgcn_mfma_f32_32x32x16_bf16(pa2,PK(2),o[d0],0,0,0);
    o[d0]=__builtin_amdgcn_mfma_f32_32x32x16_bf16(pa3,PK(3),o[d0],0,0,0);
    #undef PK
  }
}

#ifndef ATTN_STORE16
#define ATTN_STORE16(p,v) (*(u32x4*)(p)=(v))
#endif
template<int THRL> __device__ __forceinline__ void attn_unit(int b,int h,int qb,const bf16*Q,const bf16*__restrict__ K,const bf16*__restrict__ V,bf16*O,char*shm){
  const __attribute__((address_space(3))) float* nbp=(const __attribute__((address_space(3))) float*)(lds_cptr)(shm+LDS_NB);
  #define BIASC(C0,C1,t) do{ const __attribute__((address_space(3))) float* bp_=nbp+(t)*64+4*hi; \
    _Pragma("unroll") for(int g_=0;g_<4;++g_){ const f32x4_t a_=*(const __attribute__((address_space(3))) f32x4_t*)(bp_+8*g_); const f32x4_t b_=*(const __attribute__((address_space(3))) f32x4_t*)(bp_+32+8*g_); \
      C0[4*g_]=a_[0]-mhat;C0[4*g_+1]=a_[1]-mhat;C0[4*g_+2]=a_[2]-mhat;C0[4*g_+3]=a_[3]-mhat; C1[4*g_]=b_[0]-mhat;C1[4*g_+1]=b_[1]-mhat;C1[4*g_+2]=b_[2]-mhat;C1[4*g_+3]=b_[3]-mhat; } }while(0)

  int tid_=threadIdx.x; asm volatile("":"+v"(tid_)); const int tid=tid_,lane=tid&63,r32=lane&31,hi=lane>>5; const int wid=__builtin_amdgcn_readfirstlane(tid>>6);
  const long rowbase=(long)b*SEQ; const int q0=qb*QB;
  const bf16*Qw=Q+(rowbase+q0+wid*QBLK)*DM+h*D;
  const bf16*Kh=K+rowbase*DM+h*D,*Vh=V+rowbase*DM+h*D;
  const unsigned lds0=(unsigned)(uintptr_t)shm;
  float*wsf=(float*)(shm+LDS_WS)+wid*64;
  const bf16*ksrc=Kh+(long)lane*DM+wid*8;
  const bf16*vsrc=Vh+(long)(16*(wid&3)+(lane>>2))*DM+(wid>>2)*32+(lane&3)*8;
  const unsigned kdst=lds0+LDS_K+wid*1024, vdst=lds0+LDS_V+wid*1024;
  #define DMA_K(t,slot) glds16(ksrc+(long)(t)*KVBLK*DM,(unsigned)__builtin_amdgcn_readfirstlane(kdst+(slot)))
  #define DMA_V(t,slot) glds16(vsrc+(long)(t)*KVBLK*DM,(unsigned)__builtin_amdgcn_readfirstlane(vdst+(slot)))
  const int vb0=(int)(lds0+LDS_V)+((lane>>4)&1)*32+(lane&3)*8+(4*hi+((lane&15)>>2))*64;
  const char*Kbase=shm+LDS_K; bf16x8 kf[8];
  const lds_cptr shm3=(lds_cptr)shm; const lds_cptr kp0=shm3+LDS_K+hi*1024+r32*16; const lds_cptr vp0=shm3+LDS_V+((lane>>4)&1)*32+(lane&3)*8+(4*hi+((lane&15)>>2))*64;
  const int NT=(q0+QB)/KVBLK;
  DMA_K(0,0);DMA_V(0,0);DMA_K(1,SLOTB);
  bf16x8 qr[4];
  #pragma unroll
  for(int d0=0;d0<4;++d0)qr[d0]=*reinterpret_cast<const bf16x8*>(&Qw[(long)r32*DM+d0*16+hi*8]);
  float mhat=0.f,l_reg=0.f;f32x16 o[2];o[0]=f32x16{};o[1]=f32x16{};
  const int qrel=wid*QBLK+r32;
  #define CMASK(P0,P1,t) do{int jb_=(t)-(NT-4); if(jb_>=0)cmask(P0,P1,jb_,qrel,hi);}while(0)
  bool resc=false;
  #define START(P0,P1) do{ const float rm=rowmax(P0,P1); resc=false; \
    { const float dl=rm; mhat=fadd_s(mhat,dl); \
      _Pragma("unroll") for(int r=0;r<16;++r){P0[r]=fsub_s(P0[r],dl);P1[r]=fsub_s(P1[r],dl);} \
      } \
    _Pragma("unroll") for(int r=0;r<16;++r)P0[r]=__builtin_amdgcn_exp2f(P0[r]); }while(0)
  #define RESC() do{ if(resc){ asm volatile("s_waitcnt lgkmcnt(0)":::"memory"); \
      _Pragma("unroll") for(int d_=0;d_<2;++d_) _Pragma("unroll") for(int r=0;r<16;++r)o[d_][r]*=wsf[crow(r,hi)]; } }while(0)
  f32x16 pA0,pA1,pB0,pB1;
  int sl_prev=0,sl_cur=0,sl_next=SLOTB;
  #define ROT() do{sl_prev=sl_cur;sl_cur=sl_next;sl_next=(sl_next==(NSLOT-1)*SLOTB)?0:sl_next+SLOTB;}while(0)
  DMA_K(2,2*SLOTB);
  WAIT_BAR(3);
  BIASC(pA0,pA1,0); qkt(pA0,pA1,Kbase,qr,r32,hi);asm volatile("s_nop 15\n\ts_nop 7":"+v"(pA0),"+v"(pA1));CMASK(pA0,pA1,0);
  START(pA0,pA1);
  _Pragma("unroll") for(int r=0;r<16;++r)pA1[r]=__builtin_amdgcn_exp2f(pA1[r]);
  WAIT_BAR(0);
  DMA_K(3,0);DMA_V(1,SLOTB);
  ROT();
  kload8(kf,kp0+sl_cur);
  WAIT_BAR(2);
  s16x4 vlo[8],vhi[8]; u32x4 pw0,pw1,pw2,pw3;
  #define PKW(P,B) cvtpk_s(P[B],P[B+1])
  #define PAF(k) __builtin_bit_cast(bf16x8,pw##k)
  #define VFR(i) (bf16x8){vlo[i][0],vlo[i][1],vlo[i][2],vlo[i][3],vhi[i][0],vhi[i][1],vhi[i][2],vhi[i][3]}
  #define PIN(x) asm volatile("":"+v"(x))
  #define MX3(a,b,c) __builtin_fmaxf(__builtin_fmaxf((a),(b)),(c))
  #define GAPA(MF,A0,A1,A2,A3,W0,W1,PW) do{ MF; sacc+=A0; sacc+=A1; sacc+=A2; sacc+=A3; PIN(sacc); W0; W1; PIN(PW); SBAR(); }while(0)
  #define EX(v) __builtin_amdgcn_exp2f(v)
  #define GAPB(MF,X,B) do{ MF; X[B]=EX(X[B]); X[B+1]=EX(X[B+1]); X[B+2]=EX(X[B+2]); X[B+3]=EX(X[B+3]); PIN(X); SBAR(); }while(0)
  #define VRD(i) do{ vlo[i]=vtr(vp_+(((i)>>2)*4096+((i)&3)*1024)); vhi[i]=vtr(vp_+(((i)>>2)*4096+((i)&3)*1024+512)); }while(0)
  #define KRD(G,j) do{ if(G){ kload2(kf,kp0+sl_next,j); SBAR(); } }while(0)
  #define STEP(C0,C1,P0,P1,t,GK,GV,GL) do{ SBAR(); BIASC(C0,C1,t); SBAR(); \
    const lds_cptr vp_=vp0+sl_prev; \
    VRD(0); SBAR(); float sacc=(P0[0]+P0[1]); \
    GAPA(C0=__builtin_amdgcn_mfma_f32_32x32x16_bf16(kf[0],qr[0],C0,0,0,0), P0[2],P0[3],P0[4],P0[5],     pw0[0]=PKW(P0,0), pw0[1]=PKW(P0,2), pw0); \
    VRD(4); SBAR(); GAPA(C1=__builtin_amdgcn_mfma_f32_32x32x16_bf16(kf[1],qr[0],C1,0,0,0), P0[6],P0[7],P0[8],P0[9],     pw0[2]=PKW(P0,4), pw0[3]=PKW(P0,6), pw0); \
    VRD(1); SBAR(); GAPA(C0=__builtin_amdgcn_mfma_f32_32x32x16_bf16(kf[2],qr[1],C0,0,0,0),   P0[10],P0[11],P0[12],P0[13], pw1[0]=PKW(P0,8), pw1[1]=PKW(P0,10), pw1); \
    VRD(5); SBAR(); GAPA(C1=__builtin_amdgcn_mfma_f32_32x32x16_bf16(kf[3],qr[1],C1,0,0,0),   P0[14],P0[15],P1[0],P1[1],   pw1[2]=PKW(P0,12),pw1[3]=PKW(P0,14), pw1); \
    VRD(2); SBAR(); GAPA(C0=__builtin_amdgcn_mfma_f32_32x32x16_bf16(kf[4],qr[2],C0,0,0,0),   P1[2],P1[3],P1[4],P1[5],     pw2[0]=PKW(P1,0), pw2[1]=PKW(P1,2), pw2); \
    VRD(6); SBAR(); GAPA(C1=__builtin_amdgcn_mfma_f32_32x32x16_bf16(kf[5],qr[2],C1,0,0,0),   P1[6],P1[7],P1[8],P1[9],     pw2[2]=PKW(P1,4), pw2[3]=PKW(P1,6), pw2); \
    VRD(3); SBAR(); GAPA(C0=__builtin_amdgcn_mfma_f32_32x32x16_bf16(kf[6],qr[3],C0,0,0,0),   P1[10],P1[11],P1[12],P1[13], pw3[0]=PKW(P1,8), pw3[1]=PKW(P1,10), pw3); \
    VRD(7); SBAR(); GAPA(C1=__builtin_amdgcn_mfma_f32_32x32x16_bf16(kf[7],qr[3],C1,0,0,0),   P1[14],P1[15],0.f,0.f,       pw3[2]=PKW(P1,12),pw3[3]=PKW(P1,14), pw3); \
    l_reg+=sacc; \
    if(GK){DMA_K((t)+3,sl_cur);} if(GV){DMA_V((t)+1,sl_next);} \
    CMASK(C0,C1,t); \
    { float a=MX3(C0[0],C0[1],C1[0]),b=MX3(C0[2],C0[3],C1[1]); a=MX3(a,C1[2],C1[3]); \
      _Pragma("unroll") for(int r=4;r<16;r+=4){a=MX3(a,C0[r],C0[r+1]);b=MX3(b,C0[r+2],C0[r+3]);a=MX3(a,C1[r],C1[r+1]);b=MX3(b,C1[r+2],C1[r+3]);} \
      float rm=__builtin_fmaxf(a,b); { auto rr=__builtin_amdgcn_permlane32_swap(__float_as_uint(rm),__float_as_uint(rm),false,false); rm=__builtin_fmaxf(__uint_as_float(rr[0]),__uint_as_float(rr[1])); } \
      resc=false; \
      if(__builtin_expect(__any(rm>(float)THRL),0)){ const float dl=__builtin_fmaxf(rm,0.f); mhat+=dl; \
        _Pragma("unroll") for(int r=0;r<16;++r){C0[r]-=dl;C1[r]-=dl;} \
        const float f=__builtin_amdgcn_exp2f(-dl); l_reg*=f; if(hi==0)wsf[r32]=f; resc=true; } } \
    SBAR(); \
    GAPB(o[0]=__builtin_amdgcn_mfma_f32_32x32x16_bf16(PAF(0),VFR(0),o[0],0,0,0), C0,0); \
    GAPB(o[1]=__builtin_amdgcn_mfma_f32_32x32x16_bf16(PAF(0),VFR(4),o[1],0,0,0), C0,4); \
    KRD(GL,0); GAPB(o[0]=__builtin_amdgcn_mfma_f32_32x32x16_bf16(PAF(1),VFR(1),o[0],0,0,0), C0,8); \
    KRD(GL,1); GAPB(o[1]=__builtin_amdgcn_mfma_f32_32x32x16_bf16(PAF(1),VFR(5),o[1],0,0,0), C0,12); \
    KRD(GL,2); GAPB(o[0]=__builtin_amdgcn_mfma_f32_32x32x16_bf16(PAF(2),VFR(2),o[0],0,0,0), C1,0); \
    KRD(GL,3); GAPB(o[1]=__builtin_amdgcn_mfma_f32_32x32x16_bf16(PAF(2),VFR(6),o[1],0,0,0), C1,4); \
    GAPB(o[0]=__builtin_amdgcn_mfma_f32_32x32x16_bf16(PAF(3),VFR(3),o[0],0,0,0), C1,8); \
    GAPB(o[1]=__builtin_amdgcn_mfma_f32_32x32x16_bf16(PAF(3),VFR(7),o[1],0,0,0), C1,12); \
    }while(0)
  int t=1;
  #undef CMASK
  #define CMASK(P0,P1,t) do{}while(0)
  for(;t+5<NT;t+=2){
    STEP(pB0,pB1,pA0,pA1,t,true,true,true);     WAIT_BAR(2); RESC(); ROT();
    STEP(pA0,pA1,pB0,pB1,t+1,true,true,true);   WAIT_BAR(2); RESC(); ROT();
  }
  #undef CMASK
  #define CMASK(P0,P1,t) do{int jb_=(t)-(NT-4); if(jb_>=0)cmask(P0,P1,jb_,qrel,hi);}while(0)
  #define ENDW(tt) do{ if((tt)+3<NT){WAIT_BAR(2);} else if((tt)+2<NT){WAIT_BAR(1);} else {WAIT_BAR(0);} }while(0)
  for(;t+1<NT;t+=2){
    STEP(pB0,pB1,pA0,pA1,t,(t+3<NT),(t+1<NT),(t+1<NT));       ENDW(t);   RESC(); ROT();
    STEP(pA0,pA1,pB0,pB1,t+1,(t+4<NT),(t+2<NT),(t+2<NT));     ENDW(t+1); RESC(); ROT();
  }
  STEP(pB0,pB1,pA0,pA1,NT-1,false,false,false); RESC();
  { float sacc=pB0[0]+pB0[1]; _Pragma("unroll") for(int r=2;r<16;++r)sacc+=pB0[r]; _Pragma("unroll") for(int r=0;r<16;++r)sacc+=pB1[r]; l_reg+=sacc;
    pw0=(u32x4){PKW(pB0,0),PKW(pB0,2),PKW(pB0,4),PKW(pB0,6)};pw1=(u32x4){PKW(pB0,8),PKW(pB0,10),PKW(pB0,12),PKW(pB0,14)};pw2=(u32x4){PKW(pB1,0),PKW(pB1,2),PKW(pB1,4),PKW(pB1,6)};pw3=(u32x4){PKW(pB1,8),PKW(pB1,10),PKW(pB1,12),PKW(pB1,14)};
    SBAR(); pv(o,vb0+sl_cur,PAF(0),PAF(1),PAF(2),PAF(3)); }
  #undef PKW
  #undef PAF
  #undef VFR
  #undef PIN
  #undef MX3
  #undef GAPA
  #undef GAPB
  #undef EX
  #undef VRD
  #undef KRD
  #undef STEP
  #undef ENDW
  {auto rr=__builtin_amdgcn_permlane32_swap(__float_as_uint(l_reg),__float_as_uint(l_reg),false,false);l_reg=__uint_as_float(rr[0])+__uint_as_float(rr[1]);}
  if(hi==0)wsf[32+r32]=l_reg;asm volatile("s_waitcnt lgkmcnt(0)":::"memory");
  float rli[16];
  #pragma unroll
  for(int r=0;r<16;++r)rli[r]=__builtin_amdgcn_rcpf(wsf[32+crow(r,hi)]);
  bf16*Ow=O+(rowbase+q0+wid*QBLK)*DM+h*D;
  { bf16*stg=(bf16*)(shm+LDS_OST)+wid*2048;
    #pragma unroll
    for(int r=0;r<16;++r){const int orow=crow(r,hi);
      #pragma unroll
      for(int d0=0;d0<2;++d0)stg[orow*64+d0*32+r32]=__float2bfloat16(o[d0][r]*rli[r]);}
    asm volatile("s_waitcnt lgkmcnt(0)":::"memory");
    #pragma unroll
    for(int i=0;i<4;++i){const int row=i*8+(lane>>3),ch=lane&7; const u32x4 v=*(const u32x4*)(stg+row*64+ch*8); ATTN_STORE16(Ow+(long)row*DM+ch*8,v);} }
  asm volatile("s_waitcnt lgkmcnt(0)\n\ts_barrier":::"memory");
  #undef BIASC
  #undef DMA_K
  #undef DMA_V
  #undef CMASK
  #undef START
  #undef RESC
  #undef ROT
}
constexpr int ATTN_LDS_BYTES=LDS_BYTES;
struct AttnTensors { const bf16* Q; const bf16* K; const bf16* V; bf16* O; };
struct AttnUnit { int bh; int qb; };
struct StaticOrder {
  int vcu;
  __device__ __forceinline__ explicit StaticOrder(int grid,int block):vcu((block%8)*(grid/8)+block/8){}
  __device__ __forceinline__ bool next(int i,AttnUnit&u)const{ if(i>=8)return false; const int p=vcu&1; u.bh=vcu>>1; const int base=4*(i>>1); u.qb=(i&1)?base+3-p:base+p; return true; }
  __device__ __forceinline__ void a_ready(const AttnUnit&)const{}
  __device__ __forceinline__ void done(const AttnUnit&)const{}
};
template<class Sched,int THRL=8> __device__ __forceinline__ void attn_phase(char*lds,const AttnTensors&T,const Sched&S){
  AttnUnit u;
  for(int i=0;S.next(i,u);++i){ S.a_ready(u); attn_unit<THRL>(u.bh/NHEAD,u.bh%NHEAD,u.qb,T.Q,T.K,T.V,T.O,lds); S.done(u); }
}
#undef SBAR
#undef WAIT_BAR
}
constexpr int BATCH = 8, SEQ = 4096, DM = 1024, T = BATCH * SEQ, DFF = 2816, DPLE = 256;
constexpr int NWAVES = 8;
#define GAS __attribute__((address_space(1)))
#define LAS __attribute__((address_space(3)))
typedef unsigned short bf16;
typedef unsigned v4u __attribute__((ext_vector_type(4)));
typedef unsigned v2u __attribute__((ext_vector_type(2)));
typedef float f32x4 __attribute__((ext_vector_type(4)));
typedef short bf16x8 __attribute__((ext_vector_type(8)));
typedef short v4i16 __attribute__((ext_vector_type(4)));
__device__ __forceinline__ unsigned f2bf(float f) { unsigned u = __builtin_bit_cast(unsigned, f); return (u + 0x7fffu + ((u >> 16) & 1u)) >> 16; }
__device__ __forceinline__ unsigned pk2(float lo, float hi) { return f2bf(lo) | (f2bf(hi) << 16); }

constexpr size_t MiB = 1u << 20;
constexpr size_t WS_SS = 0;
constexpr size_t WS_HSS = 1280 * 1024;
constexpr size_t WS_LOGF = 2 * MiB;
constexpr size_t WS_ROPE = 4 * MiB;
constexpr size_t WS_WFFI = 8 * MiB;
constexpr size_t WS_WFFO = 52 * MiB;
constexpr size_t WS_WRIN = 74 * MiB;
constexpr size_t WS_WRG = 82 * MiB;
constexpr size_t WS_WRO = 86 * MiB;
constexpr size_t WS_WFIN = 90 * MiB;
constexpr size_t WS_WFZ = 96 * MiB;
constexpr size_t WS_WFO = 97 * MiB;
constexpr size_t WS_WPG = 99 * MiB;
constexpr size_t WS_WPP = 103 * MiB;
constexpr size_t WS_HB = 104 * MiB;
constexpr size_t WS_PB = 168 * MiB;
constexpr size_t WS_POOL = 200 * MiB;
constexpr size_t WS_END = 456 * MiB;
constexpr int LDS_BYTES = 147456, RING_BYTES = 131072;

namespace ret {
constexpr int KP = 544, VP = 144, PPI = 144;
constexpr int L_K = 0, L_V = L_K + 64 * KP, L_P = L_V + 64 * VP, L_ST = L_P + 64 * PPI, L_END = L_ST + 64 * KP;
static_assert(L_END <= RING_BYTES, "retention LDS");
#define MFMA16(a, b, c) __builtin_amdgcn_mfma_f32_16x16x32_bf16((a), (b), (c), 0, 0, 0)
__device__ __forceinline__ bf16x8 trfrag(const LAS char* p, int pitch) {
    const v4i16 lo = __builtin_amdgcn_ds_read_tr16_b64_v4i16((LAS v4i16*)p), hi = __builtin_amdgcn_ds_read_tr16_b64_v4i16((LAS v4i16*)(p + 4 * pitch));
    return (bf16x8){lo[0], lo[1], lo[2], lo[3], hi[0], hi[1], hi[2], hi[3]};
}
__device__ __forceinline__ void ret_phase(LAS char* L, const bf16* Qt, const bf16* Kt, bf16* VO, float* hss, int vcu) {
    int tid_ = threadIdx.x; asm volatile("" : "+v"(tid_));
    const int tid = tid_, lane = tid & 63, w = __builtin_amdgcn_readfirstlane(tid >> 6), m16 = lane & 15, g = lane >> 4, q4 = m16 >> 2, p4 = lane & 3;
    const int ib = w >> 1, half = w & 1;
    const int bh = vcu >> 3, es = vcu & 7, b = bh >> 2, h = bh & 3;
    const float lg = log2f(1.0f - exp2f(-5.0f - (float)h)), gC = exp2f(64.0f * lg);
    const size_t tok0 = (size_t)b * SEQ;
    const bf16* kbase = Kt + tok0 * 1024 + h * 256 + (size_t)(tid >> 5) * 1024 + (tid & 31) * 8;
    const bf16* vbase = VO + tok0 * 2048 + h * 512 + es * 64 + (size_t)(tid >> 3) * 2048 + (tid & 7) * 8;
    const bf16* qbase = Qt + tok0 * 1024 + h * 256 + (size_t)(16 * ib + m16) * 1024 + 8 * g;
    for (int i = tid; i < 64 * KP / 16; i += 512) *(LAS v4u*)(L + L_ST + 16 * i) = (v4u){0u, 0u, 0u, 0u};
    f32x4 st[2][4];
#pragma unroll
    for (int a = 0; a < 2; ++a)
#pragma unroll
        for (int e = 0; e < 4; ++e) st[a][e] = (f32x4){0.f, 0.f, 0.f, 0.f};
    v4u kreg[4], vreg; bf16x8 qn[8];
#define RET_LOAD(c) do { _Pragma("unroll") for (int u_ = 0; u_ < 4; ++u_) kreg[u_] = *(const v4u*)(kbase + (size_t)((c) * 64 + 16 * u_) * 1024); \
        vreg = *(const v4u*)(vbase + (size_t)(c) * 64 * 2048); \
        _Pragma("unroll") for (int s_ = 0; s_ < 8; ++s_) qn[s_] = *(const bf16x8*)(qbase + (size_t)(c) * 64 * 1024 + 32 * s_); } while (0)
    RET_LOAD(0);
    const int troff_k = (8 * g + q4) * KP + 8 * p4, troff_v = (8 * g + q4) * VP + 8 * p4;
    for (int c = 0; c < 64; ++c) {
#pragma unroll
        for (int u_ = 0; u_ < 4; ++u_) *(LAS v4u*)(L + L_K + ((tid >> 5) + 16 * u_) * KP + (tid & 31) * 16) = kreg[u_];
        *(LAS v4u*)(L + L_V + (tid >> 3) * VP + (tid & 7) * 16) = vreg;
        bf16x8 qf[8];
#pragma unroll
        for (int s = 0; s < 8; ++s) qf[s] = qn[s];
        __syncthreads();
        if (c + 1 < 64) RET_LOAD(c + 1);
#pragma unroll
        for (int jj = 0; jj < 2; ++jj) { const int jb = 2 * half + jj; f32x4 sa = (f32x4){0.f, 0.f, 0.f, 0.f};
#pragma unroll
            for (int s = 0; s < 8; ++s) { const bf16x8 a = *(const LAS bf16x8*)(L + L_K + (16 * jb + m16) * KP + (32 * s + 8 * g) * 2); sa = MFMA16(a, qf[s], sa); }
            const int il = 16 * ib + m16, j0 = 16 * jb + 4 * g;
            const float s0 = (j0 + 0 <= il) ? sa[0] : 0.f, s1 = (j0 + 1 <= il) ? sa[1] : 0.f, s2 = (j0 + 2 <= il) ? sa[2] : 0.f, s3 = (j0 + 3 <= il) ? sa[3] : 0.f;
            *(LAS v2u*)(L + L_P + il * PPI + j0 * 2) = (v2u){pk2(s0, s1), pk2(s2, s3)}; }
        f32x4 oa[2];
#pragma unroll
        for (int ee = 0; ee < 2; ++ee) { const int eb = 2 * half + ee; oa[ee] = (f32x4){0.f, 0.f, 0.f, 0.f};
#pragma unroll
            for (int s = 0; s < 8; ++s) { const bf16x8 a = *(const LAS bf16x8*)(L + L_ST + (16 * eb + m16) * KP + (32 * s + 8 * g) * 2); oa[ee] = MFMA16(a, qf[s], oa[ee]); } }
        __syncthreads();
        bf16x8 vt[2][4];
#pragma unroll
        for (int ks = 0; ks < 2; ++ks)
#pragma unroll
            for (int eb = 0; eb < 4; ++eb) vt[ks][eb] = trfrag(L + L_V + (32 * ks) * VP + (16 * eb) * 2 + troff_v, VP);
#pragma unroll
        for (int ks = 0; ks < 2; ++ks) { const bf16x8 pf = *(const LAS bf16x8*)(L + L_P + (16 * ib + m16) * PPI + (32 * ks + 8 * g) * 2);
            if (half == 0) { oa[0] = MFMA16(vt[ks][0], pf, oa[0]); oa[1] = MFMA16(vt[ks][1], pf, oa[1]); }
            else           { oa[0] = MFMA16(vt[ks][2], pf, oa[0]); oa[1] = MFMA16(vt[ks][3], pf, oa[1]); } }
        { const size_t tok = tok0 + (size_t)c * 64 + 16 * ib + m16; float sq = 0.f;
#pragma unroll
            for (int ee = 0; ee < 2; ++ee) { const f32x4 o = oa[ee]; sq += (o[0] * o[0] + o[1] * o[1]) + (o[2] * o[2] + o[3] * o[3]);
                *(v2u*)(VO + tok * 2048 + h * 512 + es * 64 + 16 * (2 * half + ee) + 4 * g) = (v2u){pk2(o[0], o[1]), pk2(o[2], o[3])}; }
            sq += __shfl_xor(sq, 16); sq += __shfl_xor(sq, 32); if (g == 0) atomicAdd(hss + tok * 4 + h, sq); }
#pragma unroll
        for (int ks = 0; ks < 2; ++ks)
#pragma unroll
            for (int dd = 0; dd < 2; ++dd) { const bf16x8 kt = trfrag(L + L_K + (32 * ks) * KP + (16 * (2 * w + dd)) * 2 + troff_k, KP);
#pragma unroll
                for (int eb = 0; eb < 4; ++eb) st[dd][eb] = MFMA16(kt, vt[ks][eb], st[dd][eb]); }
#pragma unroll
        for (int dd = 0; dd < 2; ++dd)
#pragma unroll
            for (int eb = 0; eb < 4; ++eb) { st[dd][eb] = st[dd][eb] * gC; const f32x4 s = st[dd][eb];
                *(LAS v2u*)(L + L_ST + (16 * eb + m16) * KP + (16 * (2 * w + dd) + 4 * g) * 2) = (v2u){pk2(s[0], s[1]), pk2(s[2], s[3])}; }
        __syncthreads();
    }
#undef RET_LOAD
}
}

struct Args { const float* in[14]; float* out; unsigned char* ws; };
struct Frame { LAS unsigned char* lds; int tid, lane, wave, vcu, G; };

__device__ __forceinline__ float wave_sum(float v) {
#pragma unroll
    for (int o = 1; o < 64; o <<= 1) v += __shfl_xor(v, o);
    return v;
}
__device__ __forceinline__ void prep_item(const float* W, int K, int Nsrc, bf16* WT, int rows, int mode, int coloff, const float* ks, LAS float* scr, int item, int lane) {
    const int nblk = rows / 32, kb = item / nblk, nb = item % nblk, k0 = 64 * kb, n0 = 32 * nb;
    const int src0 = mode ? (((n0 >> 7) & 1) * DFF + 128 * (n0 >> 8) + (n0 & 127)) : (coloff + n0);
#pragma unroll 8
    for (int i = 0; i < 32; ++i) { const int kk = 2 * i + (lane >> 5); scr[kk * 33 + (lane & 31)] = W[(size_t)(k0 + kk) * Nsrc + src0 + (lane & 31)]; }
    asm volatile("s_waitcnt lgkmcnt(0)" ::: "memory");
    const int c = lane & 7;
    float sc[8];
#pragma unroll
    for (int x = 0; x < 8; ++x) sc[x] = ks ? ks[k0 + 8 * c + x] : 1.0f;
#pragma unroll
    for (int j = 0; j < 4; ++j) { const int n = (lane >> 3) + 8 * j; const LAS float* s = scr + (8 * c) * 33 + n;
        v4u o; o.x = pk2(s[0 * 33] * sc[0], s[1 * 33] * sc[1]); o.y = pk2(s[2 * 33] * sc[2], s[3 * 33] * sc[3]); o.z = pk2(s[4 * 33] * sc[4], s[5 * 33] * sc[5]); o.w = pk2(s[6 * 33] * sc[6], s[7 * 33] * sc[7]);
        *(v4u*)(WT + (size_t)(n0 + n) * K + k0 + 8 * c) = o; }
    asm volatile("s_waitcnt lgkmcnt(0)" ::: "memory");
}
#define PREP(Wp, K_, Nsrc_, WTp, rows_, mode_, coloff_, ksp) do { const int nit_ = ((K_) / 64) * ((rows_) / 32); \
    for (int it_ = gw; it_ < nit_; it_ += NGW) prep_item((Wp), (K_), (Nsrc_), (WTp), (rows_), (mode_), (coloff_), (ksp), scr, it_, F.lane); } while (0)

typedef const volatile __attribute__((address_space(4))) unsigned long long* kargp_t;
#define KARG(i) ((unsigned long long)(*((kargp_t)__builtin_amdgcn_kernarg_segment_ptr() + (i))))
#define KIN(i) ((const float*)KARG(i))
#define KOUT ((float*)KARG(14))
#define KWS ((unsigned char*)KARG(15))
#define GEMM_PHASE(EpiT, Aop, Bop, N_, K_, Eobj) do { pg8::Gemm g_{(const pg8::bf16_t*)(Aop), (const pg8::bf16_t*)(Bop), T, (N_), (K_)}; pg8::StaticOrder S_; S_.init(T, (N_), F.G, (int)blockIdx.x); \
        pg8::gemm_phase<EpiT, pg8::StaticOrder, true, true>(F.lds, g_, S_, (Eobj)); } while (0)

__device__ __forceinline__ void p0_prologue(const Frame& F) {
    unsigned char* ws = KWS;
    const float* norm_w = KIN(2);
    float* SS = (float*)(ws + WS_SS); float* HSS = (float*)(ws + WS_HSS);
    const int gw = F.vcu * NWAVES + F.wave, NGW = F.G * NWAVES, gtid = gw * 64 + F.lane, NGT = NGW * 64;
    LAS float* scr = (LAS float*)(F.lds + F.wave * 16384);
    for (int i = gtid; i < 8 * T + 4 * T; i += NGT) { if (i < 8 * T) SS[T + i] = 0.f; else HSS[i - 8 * T] = 0.f; }
    { float* ROPE = (float*)(ws + WS_ROPE);
      for (int i = gtid; i < 4096 * 128; i += NGT) { const int pos = i >> 7, j = i & 127;
        const float inv = exp2f(-(float)j * (13.287712379549449f / 128.0f)); const float ang = (float)pos * inv;
        double tr = (double)ang * 0.15915494309189535; tr -= rint(tr); const float tf = (float)tr;
        ROPE[2 * i] = __builtin_amdgcn_cosf(tf); ROPE[2 * i + 1] = __builtin_amdgcn_sinf(tf); } }
    { const float* x = KIN(0); bf16* HB = (bf16*)(ws + WS_HB);
      for (int m = gw; m < T; m += NGW) {
        const f32x4* xr = (const f32x4*)(x + (size_t)m * DM) + F.lane; float s = 0.f; unsigned long long* o8 = (unsigned long long*)(HB + (size_t)m * DM) + F.lane;
#pragma unroll
        for (int j = 0; j < 4; ++j) { const f32x4 v = xr[64 * j]; s += (v.x * v.x + v.y * v.y) + (v.z * v.z + v.w * v.w); o8[64 * j] = (unsigned long long)pk2(v.x, v.y) | ((unsigned long long)pk2(v.z, v.w) << 32); }
        s = wave_sum(s); if (F.lane == 0) SS[m] = s; } }
    { const float* pin = KIN(1); bf16* PB = (bf16*)(ws + WS_PB);
      for (int i = gtid; i < 2 * T * DPLE / 4; i += NGT) { const f32x4 v = ((const f32x4*)pin)[i]; ((unsigned long long*)PB)[i] = (unsigned long long)pk2(v.x, v.y) | ((unsigned long long)pk2(v.z, v.w) << 32); } }
    { const float* fox_w_in = KIN(8); bf16* WFZ = (bf16*)(ws + WS_WFZ);
      for (int i = gtid; i < 16 * 1024; i += NGT) { const int n = i >> 10, k = i & 1023; WFZ[i] = (bf16)f2bf(fox_w_in[(size_t)k * 3088 + 3072 + n] * norm_w[(4 + 1) * DM + k]); } }
#pragma unroll 1
    for (int fi = 0; fi < 4; ++fi) { const int li = fi >> 1, f = fi & 1;
        PREP(KIN(3) + (size_t)fi * DM * 2 * DFF, DM, 2 * DFF, (bf16*)(ws + WS_WFFI) + (size_t)fi * 2 * DFF * DM, 2 * DFF, 1, 0, norm_w + (li * 4 + (f ? 2 : 0)) * DM);
        PREP(KIN(4) + (size_t)fi * DFF * DM, DFF, DM, (bf16*)(ws + WS_WFFO) + (size_t)fi * DM * DFF, DM, 0, 0, (const float*)nullptr); }
    PREP(KIN(5), DM, 6144, (bf16*)(ws + WS_WRIN), 4096, 0, 0, norm_w + 1 * DM);
    PREP(KIN(5), DM, 6144, (bf16*)(ws + WS_WRG), 2048, 0, 4096, norm_w + 1 * DM);
    PREP(KIN(7), 2048, DM, (bf16*)(ws + WS_WRO), DM, 0, 0, (const float*)nullptr);
    PREP(KIN(8), DM, 3088, (bf16*)(ws + WS_WFIN), 3072, 0, 0, norm_w + (4 + 1) * DM);
    PREP(KIN(10), DM, DM, (bf16*)(ws + WS_WFO), DM, 0, 0, (const float*)nullptr);
#pragma unroll 1
    for (int li = 0; li < 2; ++li) {
        PREP(KIN(12) + (size_t)li * DM * DM, DM, DM, (bf16*)(ws + WS_WPG) + (size_t)li * DM * DM, DM, 0, 0, norm_w + (li * 4 + 3) * DM);
        PREP(KIN(11) + (size_t)li * DPLE * DM, DPLE, DM, (bf16*)(ws + WS_WPP) + (size_t)li * DM * DPLE, DM, 0, 0, (const float*)nullptr); }
}

template <int FI, int SITE, bool FIRST, bool WITH_PP> __device__ __forceinline__ void ffn_half(const Frame& F, cg::grid_group& grid) {
    { unsigned char* ws = KWS; pg8::EpiSwiglu E{(pg8::bf16_t*)(ws + WS_POOL), (const float*)(ws + WS_SS) + (size_t)SITE * T};
      GEMM_PHASE(pg8::EpiSwiglu, ws + WS_HB, (bf16*)(ws + WS_WFFI) + (size_t)FI * 2 * DFF * DM, 2 * DFF, DM, E); }
    grid.sync();
    { unsigned char* ws = KWS; float* hres = KOUT; pg8::EpiRes E{FIRST ? KIN(0) : (const float*)hres, hres, (pg8::bf16_t*)(ws + WS_HB), (float*)(ws + WS_SS) + (size_t)(SITE + 1) * T, 0.5f};
      GEMM_PHASE(pg8::EpiRes, ws + WS_POOL, (bf16*)(ws + WS_WFFO) + (size_t)FI * DM * DFF, DM, DFF, E); }
    if (WITH_PP) { unsigned char* ws = KWS; constexpr int LI = FI >> 1; pg8::EpiPlain E{(pg8::bf16_t*)(ws + WS_POOL + 176 * MiB), DM, (const float*)nullptr, 0, 0, 1.0f};
      GEMM_PHASE(pg8::EpiPlain, (bf16*)(ws + WS_PB) + (size_t)LI * T * DPLE, (bf16*)(ws + WS_WPP) + (size_t)LI * DM * DPLE, DM, DPLE, E); }
    grid.sync();
}
template <int LI> __device__ __forceinline__ void ple_phase(const Frame& F, cg::grid_group& grid) {
    { unsigned char* ws = KWS; float* hres = KOUT; float* SS = (float*)(ws + WS_SS);
      pg8::EpiPle E{hres, hres, (pg8::bf16_t*)(ws + WS_HB), SS + (size_t)(4 * LI + 4) * T, SS + (size_t)(4 * LI + 3) * T, (const pg8::bf16_t*)(ws + WS_POOL + 176 * MiB)};
      GEMM_PHASE(pg8::EpiPle, ws + WS_HB, (bf16*)(ws + WS_WPG) + (size_t)LI * DM * DM, DM, DM, E); }
    grid.sync();
}
__device__ __forceinline__ void retention_mixer(const Frame& F, cg::grid_group& grid) {
    { unsigned char* ws = KWS; pg8::EpiRetIn E{(pg8::bf16_t*)(ws + WS_POOL), (pg8::bf16_t*)(ws + WS_POOL + 64 * MiB), (pg8::bf16_t*)(ws + WS_POOL + 128 * MiB), (const float*)(ws + WS_SS) + T, (const float*)(ws + WS_ROPE)};
      GEMM_PHASE(pg8::EpiRetIn, ws + WS_HB, ws + WS_WRIN, 4096, DM, E); }
    grid.sync();
    { unsigned char* ws = KWS; ret::ret_phase((LAS char*)F.lds, (const bf16*)(ws + WS_POOL), (const bf16*)(ws + WS_POOL + 64 * MiB), (bf16*)(ws + WS_POOL + 128 * MiB), (float*)(ws + WS_HSS), F.vcu); }
    grid.sync();
    { unsigned char* ws = KWS; pg8::EpiRetGate E{(pg8::bf16_t*)(ws + WS_POOL + 128 * MiB), (const float*)(ws + WS_SS) + T, (const float*)(ws + WS_HSS), KIN(6)};
      GEMM_PHASE(pg8::EpiRetGate, ws + WS_HB, ws + WS_WRG, 2048, DM, E); }
    grid.sync();
    { unsigned char* ws = KWS; float* hres = KOUT; pg8::EpiRes E{hres, hres, (pg8::bf16_t*)(ws + WS_HB), (float*)(ws + WS_SS) + 2 * (size_t)T, 1.0f};
      GEMM_PHASE(pg8::EpiRes, ws + WS_POOL + 128 * MiB, ws + WS_WRO, DM, 2048, E); }
    grid.sync();
}
__device__ __forceinline__ void fox_mixer(const Frame& F, cg::grid_group& grid, unsigned char* lds_generic) {
    { unsigned char* ws = KWS; pg8::EpiPlain E{(pg8::bf16_t*)(ws + WS_POOL), DM, (const float*)(ws + WS_SS) + 5 * (size_t)T, DM, (size_t)(64 * MiB / 2), attn_body::C2};
      GEMM_PHASE(pg8::EpiPlain, ws + WS_HB, ws + WS_WFIN, 3072, DM, E); }
    { unsigned char* ws = KWS; const bf16* HB = (const bf16*)(ws + WS_HB); const bf16* WFZ = (const bf16*)(ws + WS_WFZ); float* LOGF = (float*)(ws + WS_LOGF); const float* ssm = (const float*)(ws + WS_SS) + 5 * (size_t)T; const float* fox_b_f = KIN(9);
      const int gw = F.vcu * NWAVES + F.wave, NGW = F.G * NWAVES;
      for (int task = gw; task < T / 16; task += NGW) {
        const int m16 = F.lane & 15, g = F.lane >> 4; f32x4 a4 = (f32x4){0.f, 0.f, 0.f, 0.f};
        const bf16* ar = HB + (size_t)(16 * task + m16) * DM + 8 * g; const bf16* br = WFZ + (size_t)m16 * DM + 8 * g;
#pragma unroll 8
        for (int s = 0; s < 32; ++s) a4 = __builtin_amdgcn_mfma_f32_16x16x32_bf16(*(const bf16x8*)(ar + 32 * s), *(const bf16x8*)(br + 32 * s), a4, 0, 0, 0);
        const float bfh = fox_b_f[m16];
#pragma unroll
        for (int r = 0; r < 4; ++r) { const int t = 16 * task + 4 * g + r; const float z = a4[r] * pg8::rinv_of(ssm, t) + bfh;
            LOGF[(size_t)t * 16 + m16] = fminf(z, 0.f) - log1pf(__expf(-fabsf(z))); } } }
    grid.sync();
    {
        unsigned char* ws = KWS; const float* LOGF = (const float*)(ws + WS_LOGF);
        const int bh = F.vcu >> 1, b = bh >> 4, h = bh & 15; LAS float* nb = (LAS float*)(F.lds + attn_body::LDS_NB); LAS float* wtot = (LAS float*)(F.lds + attn_body::LDS_WS);
        float v[8]; float run = 0.f;
#pragma unroll
        for (int q = 0; q < 8; ++q) { run += LOGF[((size_t)b * SEQ + 8 * F.tid + q) * 16 + h]; v[q] = run; }
        float incl = run;
#pragma unroll
        for (int o = 1; o < 64; o <<= 1) { const float y = __shfl_up(incl, o); if (F.lane >= o) incl += y; }
        if (F.lane == 63) wtot[F.wave] = incl;
        __syncthreads();
        float off = incl - run;
        for (int w2 = 0; w2 < F.wave; ++w2) off += wtot[w2];
#pragma unroll
        for (int q = 0; q < 8; ++q) nb[8 * F.tid + q] = -(off + v[q]) * 1.4426950408889634f;
        __syncthreads();
        const attn_body::bf16* FQ = (const attn_body::bf16*)(ws + WS_POOL);
        const attn_body::AttnTensors AT{FQ, FQ + (size_t)T * DM, FQ + (size_t)2 * T * DM, (attn_body::bf16*)FQ};
        const attn_body::StaticOrder S((int)F.G, (int)blockIdx.x);
        attn_body::attn_phase<attn_body::StaticOrder>((char*)lds_generic, AT, S);
    }
    grid.sync();
    { unsigned char* ws = KWS; float* hres = KOUT; pg8::EpiRes E{hres, hres, (pg8::bf16_t*)(ws + WS_HB), (float*)(ws + WS_SS) + 6 * (size_t)T, 1.0f};
      GEMM_PHASE(pg8::EpiRes, ws + WS_POOL, ws + WS_WFO, DM, DM, E); }
    grid.sync();
}

__global__ void __launch_bounds__(NWAVES * 64, 2) hybrid_fwd(Args args) {
    extern __shared__ __attribute__((aligned(16))) unsigned char lds[];
    cg::grid_group grid = cg::this_grid();
    Frame F; F.lds = (LAS unsigned char*)lds; F.tid = threadIdx.x; F.lane = F.tid & 63; F.wave = __builtin_amdgcn_readfirstlane(F.tid >> 6);
    F.G = gridDim.x; { const int bx = blockIdx.x; F.vcu = (F.G % 8 == 0) ? (bx % 8) * (F.G / 8) + bx / 8 : bx; }
    p0_prologue(F);
    grid.sync();
    ffn_half<0, 0, true, false>(F, grid);
    retention_mixer(F, grid);
    ffn_half<1, 2, false, true>(F, grid);
    ple_phase<0>(F, grid);
    ffn_half<2, 4, false, false>(F, grid);
    fox_mixer(F, grid, lds);
    ffn_half<3, 6, false, true>(F, grid);
    ple_phase<1>(F, grid);
    { float* hres = KOUT; const float* final_norm_w = KIN(13); const int gw = F.vcu * NWAVES + F.wave, NGW = F.G * NWAVES;
      for (int m = gw; m < T; m += NGW) {
        f32x4* xr = (f32x4*)(hres + (size_t)m * DM) + F.lane; const f32x4* wr = (const f32x4*)final_norm_w + F.lane; f32x4 v[4]; float s = 0.f;
#pragma unroll
        for (int j = 0; j < 4; ++j) { v[j] = xr[64 * j]; s += (v[j].x * v[j].x + v[j].y * v[j].y) + (v[j].z * v[j].z + v[j].w * v[j].w); }
        const float ri = 1.0f / sqrtf(wave_sum(s) * (1.0f / DM) + 1e-6f);
#pragma unroll
        for (int j = 0; j < 4; ++j) xr[64 * j] = v[j] * ri * wr[64 * j];
      } }
}

extern "C" void kernel_launch(void* const* d_in, const int* in_sizes, int n_in, void* d_out, int out_size, void* d_ws, size_t ws_size, hipStream_t stream) {
    static int grid = 0;
    if (grid == 0) {
        if (n_in != 14 || out_size != T * DM || ws_size < WS_END) { fprintf(stderr, "kernel_launch: unexpected shapes (n_in %d out %d ws %zu)\n", n_in, out_size, ws_size); grid = -1; return; }
        int dev = 0, cus = 0, per_cu = 0;
        if (hipGetDevice(&dev) != hipSuccess || hipDeviceGetAttribute(&cus, hipDeviceAttributeMultiprocessorCount, dev) != hipSuccess) { grid = -1; return; }
        if (hipFuncSetAttribute((const void*)hybrid_fwd, hipFuncAttributeMaxDynamicSharedMemorySize, LDS_BYTES) != hipSuccess) { fprintf(stderr, "kernel_launch: hipFuncSetAttribute failed\n"); grid = -1; return; }
        if (hipOccupancyMaxActiveBlocksPerMultiprocessor(&per_cu, (const void*)hybrid_fwd, NWAVES * 64, LDS_BYTES) != hipSuccess || per_cu < 1) { fprintf(stderr, "kernel_launch: occupancy query says %d\n", per_cu); per_cu = 1; }
        (void)hipGetLastError();
        grid = cus * 1;
    }
    if (grid < 0) return;
    Args a{};
    for (int i = 0; i < 14; ++i) a.in[i] = (const float*)d_in[i];
    a.out = (float*)d_out; a.ws = (unsigned char*)d_ws;
    void* kargs[] = {&a};
    hipError_t e = hipLaunchCooperativeKernel((const void*)hybrid_fwd, dim3(grid), dim3(NWAVES * 64), kargs, LDS_BYTES, stream);
    if (e != hipSuccess) fprintf(stderr, "cooperative launch failed: %s (grid %d)\n", hipGetErrorString(e), grid);
}
```

```cpp
#include <hip/hip_runtime.h>
#include <hip/hip_cooperative_groups.h>
#include <cstdio>
#include <cstdint>
namespace cg = cooperative_groups;
#define GAS __attribute__((address_space(1)))
#define LAS __attribute__((address_space(3)))
namespace pg8 {
#define PG8_LAS __attribute__((address_space(3)))
typedef unsigned short bf16_t;
typedef short bf16x8 __attribute__((ext_vector_type(8)));
typedef float f32x4 __attribute__((ext_vector_type(4)));
typedef unsigned u32x4 __attribute__((ext_vector_type(4)));
constexpr int BM = 256, BK = 64, HALF = 128, HTB = HALF * BK * 2  , STAGE_BYTES = 8 * HTB, NXCD = 8, WGM = 8;

__host__ __device__ __forceinline__ int lds_byte(int r, int c) { const int st = (r >> 4) * 2 + (c >> 5), rr = r & 15, cc = c & 31, ob = rr * 64 + cc * 2; return st * 1024 + (ob ^ (((ob >> 9) & 1) << 5)); }
__host__ __device__ __forceinline__ void stage_rc(int b, int& R, int& C) { const int st = b / 1024, sb = b % 1024, swz = sb ^ (((sb >> 9) & 1) << 5); R = (st >> 1) * 16 + swz / 64; C = (st & 1) * 32 + (swz % 64) / 2; }
__host__ __device__ __forceinline__ int perm32(int rho) { const int n = rho >> 4, i = rho & 15; return 8 * (i >> 2) + 4 * n + (i & 3); }

struct Unit { int pm, pn; };
struct Gemm { const bf16_t* A; const bf16_t* Bt; int M, N, K; };

struct StaticOrder {
    int nM, nN, nwg, G, c;
    __host__ __device__ void init(int M, int N, int G_, int c_) { nM = M / BM; nN = N / BM; nwg = nM * nN; G = G_; c = c_; }
    __host__ __device__ bool next(int i, Unit& u) const {
        const long L = (long)i * G + c; if (L >= nwg) return false;
        int wgid = (int)L; { const int q = nwg / NXCD, r = nwg % NXCD, xcd = wgid % NXCD, off = wgid / NXCD; wgid = (xcd < r ? xcd * (q + 1) : r * (q + 1) + (xcd - r) * q) + off; }
        const int nig = WGM * nN, gid = wgid / nig, fm = gid * WGM, gsz = (nM - fm) < WGM ? (nM - fm) : WGM;
        u.pm = fm + ((wgid % nig) % gsz); u.pn = (wgid % nig) / gsz; return true;
    }
    __device__ __forceinline__ void a_ready(const Unit&) const {}
    __device__ __forceinline__ void done(const Unit&) const {}
};
__device__ __forceinline__ unsigned cvt_pk_bf16(float lo, float hi) { unsigned r; asm volatile("v_cvt_pk_bf16_f32 %0, %1, %2" : "=v"(r) : "v"(lo), "v"(hi)); return r; }
__device__ __forceinline__ u32x4 pack8(const f32x4 v0, const f32x4 v1) { u32x4 w; w.x = cvt_pk_bf16(v0[0], v0[1]); w.y = cvt_pk_bf16(v0[2], v0[3]); w.z = cvt_pk_bf16(v1[0], v1[1]); w.w = cvt_pk_bf16(v1[2], v1[3]); return w; }
__device__ __forceinline__ float bflo(unsigned u) { return __uint_as_float(u << 16); }
__device__ __forceinline__ float bfhi(unsigned u) { return __uint_as_float(u & 0xffff0000u); }
__device__ __forceinline__ void unpack8(const u32x4 w, f32x4& v0, f32x4& v1) { v0 = (f32x4){bflo(w.x), bfhi(w.x), bflo(w.y), bfhi(w.y)}; v1 = (f32x4){bflo(w.z), bfhi(w.z), bflo(w.w), bfhi(w.w)}; }
__device__ __forceinline__ float sigm(float x) { return __builtin_amdgcn_rcpf(1.0f + __builtin_amdgcn_exp2f(-1.4426950408889634f * x)); }
__device__ __forceinline__ f32x4 silu4(const f32x4 x) { return (f32x4){x[0] * sigm(x[0]), x[1] * sigm(x[1]), x[2] * sigm(x[2]), x[3] * sigm(x[3])}; }
__device__ __forceinline__ f32x4 sigm4(const f32x4 x) { return (f32x4){sigm(x[0]), sigm(x[1]), sigm(x[2]), sigm(x[3])}; }
__device__ __forceinline__ float rinv_of(const float* ss, int r) { return 1.0f / sqrtf(ss[r] * (1.0f / 1024.0f) + 1e-6f); }
#define EPI_ARGS const f32x4 (&acc)[2][2][4][2], const Unit& u, int wr, int wc, int fr, int fq
#define EPI_ROWS(ai, m) (u.pm * BM + (ai) * HALF + wr * 64 + (m) * 16 + fr)

struct EpiSwiglu { static constexpr bool PERM = true, AFTER_DRAIN = false; bf16_t* act; const float* ss;
    __device__ __forceinline__ void operator()(EPI_ARGS) const {
        const int col0 = u.pn * HALF + wc * 32 + 8 * fq;
#pragma unroll
        for (int ai = 0; ai < 2; ++ai)
#pragma unroll
            for (int m = 0; m < 4; ++m) { const int r = EPI_ROWS(ai, m); const float ri = rinv_of(ss, r);
                const f32x4 a0 = silu4(acc[ai][0][m][0] * ri) * (acc[ai][1][m][0] * ri), a1 = silu4(acc[ai][0][m][1] * ri) * (acc[ai][1][m][1] * ri);
                *(u32x4*)(act + (size_t)r * 2816 + col0) = pack8(a0, a1); }
    }
};
struct EpiRes { static constexpr bool PERM = true, AFTER_DRAIN = false; const float* hin; float* hout; bf16_t* hb; float* ssn; float scale;
    __device__ __forceinline__ void operator()(EPI_ARGS) const {
#pragma unroll
        for (int ai = 0; ai < 2; ++ai)
#pragma unroll
            for (int m = 0; m < 4; ++m) { const int r = EPI_ROWS(ai, m); float sq = 0.f;
#pragma unroll
                for (int bj = 0; bj < 2; ++bj) { const size_t off = (size_t)r * 1024 + u.pn * BM + bj * HALF + wc * 32 + 8 * fq;
                    const f32x4 v0 = *(const f32x4*)(hin + off) + acc[ai][bj][m][0] * scale, v1 = *(const f32x4*)(hin + off + 4) + acc[ai][bj][m][1] * scale;
                    *(f32x4*)(hout + off) = v0; *(f32x4*)(hout + off + 4) = v1; *(u32x4*)(hb + off) = pack8(v0, v1);
                    sq += (v0[0] * v0[0] + v0[1] * v0[1]) + (v0[2] * v0[2] + v0[3] * v0[3]) + (v1[0] * v1[0] + v1[1] * v1[1]) + (v1[2] * v1[2] + v1[3] * v1[3]); }
                sq += __shfl_xor(sq, 16); sq += __shfl_xor(sq, 32); if (fq == 0) atomicAdd(ssn + r, sq); }
    }
};
struct EpiPle { static constexpr bool PERM = true, AFTER_DRAIN = false; const float* hin; float* hout; bf16_t* hb; float* ssn; const float* ss; const bf16_t* pp;
    __device__ __forceinline__ void operator()(EPI_ARGS) const {
#pragma unroll
        for (int ai = 0; ai < 2; ++ai)
#pragma unroll
            for (int m = 0; m < 4; ++m) { const int r = EPI_ROWS(ai, m); const float ri = rinv_of(ss, r); float sq = 0.f;
#pragma unroll
                for (int bj = 0; bj < 2; ++bj) { const size_t off = (size_t)r * 1024 + u.pn * BM + bj * HALF + wc * 32 + 8 * fq;
                    f32x4 p0, p1; unpack8(*(const u32x4*)(pp + off), p0, p1);
                    const f32x4 v0 = *(const f32x4*)(hin + off) + sigm4(acc[ai][bj][m][0] * ri) * p0, v1 = *(const f32x4*)(hin + off + 4) + sigm4(acc[ai][bj][m][1] * ri) * p1;
                    *(f32x4*)(hout + off) = v0; *(f32x4*)(hout + off + 4) = v1; *(u32x4*)(hb + off) = pack8(v0, v1);
                    sq += (v0[0] * v0[0] + v0[1] * v0[1]) + (v0[2] * v0[2] + v0[3] * v0[3]) + (v1[0] * v1[0] + v1[1] * v1[1]) + (v1[2] * v1[2] + v1[3] * v1[3]); }
                sq += __shfl_xor(sq, 16); sq += __shfl_xor(sq, 32); if (fq == 0) atomicAdd(ssn + r, sq); }
    }
};
struct EpiPlain { static constexpr bool PERM = true, AFTER_DRAIN = false; bf16_t* O; int ldc; const float* ss; int split_cols; size_t split_stride; float scale0;
    __device__ __forceinline__ void operator()(EPI_ARGS) const {
        int colt = u.pn * BM; bf16_t* base = O; float sc = 1.f;
        if (split_cols) { const int t = colt / split_cols; base += (size_t)t * split_stride; colt -= t * split_cols; if (t == 0) sc = scale0; }
        const int col0 = colt + wc * 32 + 8 * fq;
#pragma unroll
        for (int ai = 0; ai < 2; ++ai)
#pragma unroll
            for (int m = 0; m < 4; ++m) { const int r = EPI_ROWS(ai, m); const float ri = (ss ? rinv_of(ss, r) : 1.0f) * sc;
#pragma unroll
                for (int bj = 0; bj < 2; ++bj) *(u32x4*)(base + (size_t)r * ldc + col0 + bj * HALF) = pack8(acc[ai][bj][m][0] * ri, acc[ai][bj][m][1] * ri); }
    }
};
struct EpiRetIn { static constexpr bool PERM = true, AFTER_DRAIN = false; bf16_t* Qt; bf16_t* Kt; bf16_t* V; const float* ss; const float* rope  ;
    __device__ __forceinline__ void operator()(EPI_ARGS) const {
        const int pn = u.pn;
        if (pn >= 8) {
            const int col0 = (pn - 8) * BM + wc * 32 + 8 * fq;
#pragma unroll
            for (int ai = 0; ai < 2; ++ai)
#pragma unroll
                for (int m = 0; m < 4; ++m) { const int r = EPI_ROWS(ai, m); const float ri = rinv_of(ss, r);
#pragma unroll
                    for (int bj = 0; bj < 2; ++bj) *(u32x4*)(V + (size_t)r * 2048 + col0 + bj * HALF) = pack8(acc[ai][bj][m][0] * ri, acc[ai][bj][m][1] * ri); }
            return;
        }
        const bool isk = pn >= 4; const int hd = pn & 3; bf16_t* outp = isk ? Kt : Qt;
        const float lg = log2f(1.0f - exp2f(-5.0f - (float)hd));
        const int j0 = wc * 32 + 8 * fq;
#pragma unroll
        for (int ai = 0; ai < 2; ++ai)
#pragma unroll
            for (int m = 0; m < 4; ++m) { const int r = EPI_ROWS(ai, m); const int pos = r & 4095; const float e1 = (float)((pos & 63) + 1) * lg;
                const float f = rinv_of(ss, r) * (isk ? 0.0625f * exp2f(-e1) : exp2f(e1));
                const f32x4* cs = (const f32x4*)(rope + ((size_t)pos * 128 + j0) * 2);
                const f32x4 c01 = cs[0], c23 = cs[1], c45 = cs[2], c67 = cs[3];
                const f32x4 x10 = acc[ai][0][m][0] * f, x11 = acc[ai][0][m][1] * f, x20 = acc[ai][1][m][0] * f, x21 = acc[ai][1][m][1] * f;
                const f32x4 cc0 = (f32x4){c01[0], c01[2], c23[0], c23[2]}, sn0 = (f32x4){c01[1], c01[3], c23[1], c23[3]};
                const f32x4 cc1 = (f32x4){c45[0], c45[2], c67[0], c67[2]}, sn1 = (f32x4){c45[1], c45[3], c67[1], c67[3]};
                const f32x4 y10 = x10 * cc0 - x20 * sn0, y11 = x11 * cc1 - x21 * sn1, y20 = x10 * sn0 + x20 * cc0, y21 = x11 * sn1 + x21 * cc1;
                bf16_t* rowp = outp + (size_t)r * 1024 + hd * 256 + j0;
                *(u32x4*)(rowp) = pack8(y10, y11); *(u32x4*)(rowp + HALF) = pack8(y20, y21); }
    }
};
struct EpiRetGate { static constexpr bool PERM = true, AFTER_DRAIN = false; bf16_t* Y; const float* ss; const float* hss; const float* gnw;
    __device__ __forceinline__ void operator()(EPI_ARGS) const {
        const int hd = u.pn >> 1;
#pragma unroll
        for (int ai = 0; ai < 2; ++ai)
#pragma unroll
            for (int m = 0; m < 4; ++m) { const int r = EPI_ROWS(ai, m); const float ri = rinv_of(ss, r); const float hr = 1.0f / sqrtf(hss[(size_t)r * 4 + hd] * (1.0f / 512.0f) + 1e-6f);
#pragma unroll
                for (int bj = 0; bj < 2; ++bj) { const int c = u.pn * BM + bj * HALF + wc * 32 + 8 * fq; bf16_t* p = Y + (size_t)r * 2048 + c;
                    f32x4 o0, o1; unpack8(*(const u32x4*)p, o0, o1);
                    const f32x4 g0 = *(const f32x4*)(gnw + c) * hr, g1 = *(const f32x4*)(gnw + c + 4) * hr;
                    *(u32x4*)p = pack8(silu4(acc[ai][bj][m][0] * ri) * o0 * g0, silu4(acc[ai][bj][m][1] * ri) * o1 * g1); }
            }
    }
};
template <class Epi, class Sched, bool ALIGN_EPI = false, bool SP2 = false>
__device__ __forceinline__ void gemm_phase(PG8_LAS unsigned char* lds, const Gemm g, const Sched& S, const Epi& E) {
    int tid_ = threadIdx.x; asm volatile("" : "+v"(tid_));
    const int tid = tid_, wid = __builtin_amdgcn_readfirstlane(tid >> 6), lane = tid & 63, wr = wid >> 2, wc = wid & 3, fr = lane & 15, fq = lane >> 4;
    const int K = g.K, nt = K / BK;
    unsigned voffA[2], voffB[2];
#pragma unroll
    for (int i = 0; i < 2; ++i) { int R, C; stage_rc(tid * 16 + i * 8192, R, C); const int Rb = Epi::PERM ? ((R & ~31) + perm32(R & 31)) : R;
        voffA[i] = (unsigned)(R * K + C) * 2u; voffB[i] = (unsigned)(Rb * K + C) * 2u; }
    const size_t kstep = (size_t)(BK * 2);
    const size_t hstep = (size_t)HALF * K * 2;
    const size_t tstep = 2 * hstep;
    const unsigned ldsw = (unsigned)wid * 1024u;
    const int aoff = lds_byte(wr * 64 + fr, fq * 8), boff = lds_byte(wc * 32 + fr, fq * 8);
#define PG8_SA(b, h) (((b) * 2 + (h)) * HTB)
#define PG8_SB(b, h) ((4 + (b) * 2 + (h)) * HTB)
#define PG8_STAGE(bufoff, gbase, voff) do { _Pragma("unroll") for (int _i = 0; _i < 2; ++_i) \
        __builtin_amdgcn_global_load_lds((const unsigned*)((const char*)(gbase) + (voff)[_i]), (PG8_LAS unsigned*)(lds + (bufoff) + ldsw + _i * 8192), 16, 0, 0); } while (0)
#define PG8_LDA(dst, b, h) do { _Pragma("unroll") for (int m = 0; m < 4; ++m) _Pragma("unroll") for (int k = 0; k < 2; ++k) dst[m][k] = *(const PG8_LAS bf16x8*)(lds + PG8_SA(b, h) + aoff + m * 2048 + k * 1024); } while (0)
#define PG8_LDB(dst, b, h) do { _Pragma("unroll") for (int n = 0; n < 2; ++n) _Pragma("unroll") for (int k = 0; k < 2; ++k) dst[n][k] = *(const PG8_LAS bf16x8*)(lds + PG8_SB(b, h) + boff + n * 2048 + k * 1024); } while (0)
#define PG8_MMA(ai, bj, At, Bt) do { __builtin_amdgcn_s_setprio(1); _Pragma("unroll") for (int m = 0; m < 4; ++m) _Pragma("unroll") for (int n = 0; n < 2; ++n) _Pragma("unroll") for (int k = 0; k < 2; ++k) \
        acc[ai][bj][m][n] = __builtin_amdgcn_mfma_f32_16x16x32_bf16(Bt[n][k], At[m][k], acc[ai][bj][m][n], 0, 0, 0); __builtin_amdgcn_s_setprio(0); } while (0)
#define PG8_WAIT_V(n) asm volatile("s_waitcnt vmcnt(" #n ")" ::: "memory")
#define PG8_WAIT_L(n) asm volatile("s_waitcnt lgkmcnt(" #n ")" ::: "memory")
#define PG8_BAR __builtin_amdgcn_s_barrier()
#define PG8_SCHED __builtin_amdgcn_sched_barrier(0)
    Unit cur, nxt; int ui = 0;
    if (!S.next(0, cur)) return;
    f32x4 acc[2][2][4][2];
#pragma unroll
    for (int a = 0; a < 2; ++a)
#pragma unroll
        for (int b = 0; b < 2; ++b)
#pragma unroll
            for (int m = 0; m < 4; ++m)
#pragma unroll
                for (int n = 0; n < 2; ++n) acc[a][b][m][n] = (f32x4){0.f, 0.f, 0.f, 0.f};
    bf16x8 At[4][2], B0[2][2], B1[2][2];
    const char* cA = (const char*)g.A + (size_t)cur.pm * tstep; const char* cB = (const char*)g.Bt + (size_t)cur.pn * tstep;
    S.a_ready(cur);
    if constexpr (SP2) {
        PG8_STAGE(PG8_SB(0, 0), cB, voffB); PG8_STAGE(PG8_SB(0, 1), cB + hstep, voffB); PG8_STAGE(PG8_SA(0, 0), cA, voffA); PG8_STAGE(PG8_SA(0, 1), cA + hstep, voffA);
        if (wr == 1) PG8_BAR;
        PG8_WAIT_V(2); PG8_BAR;
        PG8_STAGE(PG8_SB(1, 0), cB + kstep, voffB); PG8_STAGE(PG8_SA(1, 0), cA + kstep, voffA); PG8_STAGE(PG8_SB(1, 1), cB + hstep + kstep, voffB);
        PG8_WAIT_V(6); PG8_BAR;
    } else {
        PG8_STAGE(PG8_SB(0, 0), cB, voffB); PG8_STAGE(PG8_SA(0, 0), cA, voffA); PG8_STAGE(PG8_SB(0, 1), cB + hstep, voffB); PG8_STAGE(PG8_SA(0, 1), cA + hstep, voffA);
        if (wr == 1) PG8_BAR;
        PG8_WAIT_V(4); PG8_BAR;
        PG8_STAGE(PG8_SB(1, 0), cB + kstep, voffB); PG8_STAGE(PG8_SA(1, 0), cA + kstep, voffA); PG8_STAGE(PG8_SB(1, 1), cB + hstep + kstep, voffB);
        PG8_WAIT_V(6); PG8_BAR;
    }
    for (;;) {
        const bool has_next = S.next(ui + 1, nxt);
        const char* nA = has_next ? (const char*)g.A + (size_t)nxt.pm * tstep : cA; const char* nB = has_next ? (const char*)g.Bt + (size_t)nxt.pn * tstep : cB;
        for (int t = 0; t < nt; t += 2) {
            const bool last = (t == nt - 2);
            const char* a1 = cA + (size_t)(t + 1) * kstep;
            const char* a2 = last ? nA : cA + (size_t)(t + 2) * kstep; const char* b2 = last ? nB : cB + (size_t)(t + 2) * kstep;
            const char* a3 = a2 + kstep; const char* b3 = b2 + kstep;
            if (last && has_next) S.a_ready(nxt);
            if constexpr (SP2) {
            PG8_LDB(B0, 0, 0); PG8_LDB(B1, 0, 1); PG8_SCHED; PG8_LDA(At, 0, 0); PG8_STAGE(PG8_SA(1, 1), a1 + hstep, voffA);
            PG8_WAIT_V(8); PG8_WAIT_L(0); PG8_BAR; PG8_MMA(0, 0, At, B0); PG8_MMA(0, 1, At, B1); PG8_BAR; PG8_SCHED;
            PG8_LDA(At, 0, 1); PG8_STAGE(PG8_SB(0, 0), b2, voffB); PG8_STAGE(PG8_SB(0, 1), b2 + hstep, voffB); PG8_STAGE(PG8_SA(0, 0), a2, voffA);
            PG8_WAIT_V(8); PG8_WAIT_L(0); PG8_BAR; PG8_MMA(1, 0, At, B0); PG8_MMA(1, 1, At, B1); PG8_BAR; PG8_SCHED;
            PG8_LDB(B0, 1, 0); PG8_LDB(B1, 1, 1); PG8_SCHED; PG8_LDA(At, 1, 0); PG8_STAGE(PG8_SA(0, 1), a2 + hstep, voffA);
            PG8_WAIT_V(8); PG8_WAIT_L(0); PG8_BAR; PG8_MMA(0, 0, At, B0); PG8_MMA(0, 1, At, B1); PG8_BAR; PG8_SCHED;
            PG8_LDA(At, 1, 1); PG8_STAGE(PG8_SB(1, 0), b3, voffB); PG8_STAGE(PG8_SB(1, 1), b3 + hstep, voffB); PG8_STAGE(PG8_SA(1, 0), a3, voffA);
            PG8_WAIT_V(8); PG8_WAIT_L(0); PG8_BAR; PG8_MMA(1, 0, At, B0); PG8_MMA(1, 1, At, B1); PG8_BAR; PG8_SCHED;
            } else {
            PG8_LDB(B0, 0, 0); PG8_SCHED; PG8_LDA(At, 0, 0); PG8_STAGE(PG8_SA(1, 1), a1 + hstep, voffA);
            PG8_WAIT_L(8); PG8_BAR; PG8_WAIT_L(0); PG8_MMA(0, 0, At, B0); PG8_BAR; PG8_SCHED;
            PG8_LDB(B1, 0, 1); PG8_STAGE(PG8_SB(0, 0), b2, voffB);
            PG8_BAR; PG8_WAIT_L(0); PG8_MMA(0, 1, At, B1); PG8_BAR;
            PG8_LDA(At, 0, 1); PG8_STAGE(PG8_SA(0, 0), a2, voffA);
            PG8_BAR; PG8_WAIT_L(0); PG8_MMA(1, 0, At, B0); PG8_BAR; PG8_SCHED;
            PG8_STAGE(PG8_SB(0, 1), b2 + hstep, voffB);
            PG8_WAIT_V(6); PG8_BAR; PG8_MMA(1, 1, At, B1); PG8_BAR;
            PG8_LDB(B0, 1, 0); PG8_SCHED; PG8_LDA(At, 1, 0); PG8_STAGE(PG8_SA(0, 1), a2 + hstep, voffA);
            PG8_WAIT_L(8); PG8_BAR; PG8_WAIT_L(0); PG8_MMA(0, 0, At, B0); PG8_BAR; PG8_SCHED;
            PG8_LDB(B1, 1, 1); PG8_STAGE(PG8_SB(1, 0), b3, voffB);
            PG8_BAR; PG8_WAIT_L(0); PG8_MMA(0, 1, At, B1); PG8_BAR;
            PG8_LDA(At, 1, 1); PG8_STAGE(PG8_SA(1, 0), a3, voffA);
            PG8_BAR; PG8_WAIT_L(0); PG8_MMA(1, 0, At, B0); PG8_BAR; PG8_SCHED;
            PG8_STAGE(PG8_SB(1, 1), b3 + hstep, voffB);
            PG8_WAIT_V(6); PG8_BAR; PG8_MMA(1, 1, At, B1); PG8_BAR;
            }
        }
        if constexpr (ALIGN_EPI) { if (wr == 0) PG8_BAR; }
        if constexpr (!Epi::AFTER_DRAIN) { E(acc, cur, wr, wc, fr, fq); S.done(cur); }
        if (!has_next) break;
#pragma unroll
        for (int a = 0; a < 2; ++a)
#pragma unroll
            for (int b = 0; b < 2; ++b)
#pragma unroll
                for (int m = 0; m < 4; ++m)
#pragma unroll
                    for (int n = 0; n < 2; ++n) acc[a][b][m][n] = (f32x4){0.f, 0.f, 0.f, 0.f};
        cur = nxt; cA = nA; cB = nB; ++ui;
        if constexpr (ALIGN_EPI) { if (wr == 1) PG8_BAR; }
    }
    PG8_WAIT_V(0);
    if constexpr (!ALIGN_EPI) { if (wr == 0) PG8_BAR; }
    PG8_BAR;
    if constexpr (Epi::AFTER_DRAIN) { E.fused(acc, cur, wr, wc, fr, fq, lds, wid, lane); S.done(cur); }
#undef PG8_SA
#undef PG8_SB
#undef PG8_STAGE
#undef PG8_LDA
#undef PG8_LDB
#undef PG8_MMA
#undef PG8_WAIT_V
#undef PG8_WAIT_L
#undef PG8_BAR
#undef PG8_SCHED
}
}
#include <hip/hip_bf16.h>
#include <cmath>
namespace attn_body {
using bf16=__hip_bfloat16;
using bf16x8=__attribute__((ext_vector_type(8)))short;
using s16x4=__attribute__((ext_vector_type(4)))short;
using f32x16=__attribute__((ext_vector_type(16)))float;
using u32x4=__attribute__((ext_vector_type(4)))unsigned;
constexpr int BATCH=8,NHEAD=16,SEQ=4096,D=64,DM=NHEAD*D;
constexpr int NW=8,QBLK=32,QB=QBLK*NW,KVBLK=64,NQB=SEQ/QB;
constexpr int ATTN_PITCH=DM, ATTN_UNIT_ROWS=QB;
__device__ __forceinline__ int crow(int r,int hi){return (r&3)+8*(r>>2)+4*hi;}
#define SBAR() __builtin_amdgcn_sched_barrier(0)
__device__ __forceinline__ void cmask(f32x16&p0,f32x16&p1,int jb,int qrel,int hi){
  const float NEG=-INFINITY; int kb=64*jb+4*hi;
  #pragma unroll
  for(int r=0;r<16;++r){int kv=kb+(r&3)+8*(r>>2); if(kv>qrel)p0[r]=NEG; if(kv+32>qrel)p1[r]=NEG;}
}

constexpr int NSLOT=3, SLOTB=8192;
typedef float f32x4_t __attribute__((ext_vector_type(4)));
constexpr int LDS_K=0, LDS_V=NSLOT*SLOTB, LDS_WS=2*NSLOT*SLOTB, LDS_OST=LDS_WS+NW*64*4, LDS_NB=LDS_OST+NW*4096, LDS_BYTES=LDS_NB+SEQ*4;
constexpr float C2=0.125f*1.4426950408889634f;
__device__ __forceinline__ void glds16(const void*gsrc,unsigned lds_dst){unsigned keep;
  asm volatile("s_mov_b32 %0, m0\n\ts_mov_b32 m0, %2\n\ts_nop 0\n\tglobal_load_lds_dwordx4 %1, off\n\ts_mov_b32 m0, %0":"=&s"(keep):"v"(gsrc),"s"(lds_dst):"memory");}
__device__ __forceinline__ float max3f(float a,float b,float c){float r;asm("v_max3_f32 %0, %1, %2, %3":"=v"(r):"v"(a),"v"(b),"v"(c));return r;}
__device__ __forceinline__ float max2f(float a,float b){float r;asm("v_max_f32_e32 %0, %1, %2":"=v"(r):"v"(a),"v"(b));return r;}
__device__ __forceinline__ float fadd_s(float a,float b){float r;asm("v_add_f32_e32 %0, %1, %2":"=v"(r):"v"(a),"v"(b));return r;}
__device__ __forceinline__ float fsub_s(float a,float b){float r;asm("v_sub_f32_e32 %0, %1, %2":"=v"(r):"v"(a),"v"(b));return r;}
typedef float f32x2_t __attribute__((ext_vector_type(2))); typedef __bf16 bf16x2_t __attribute__((ext_vector_type(2)));
__device__ __forceinline__ unsigned cvtpk_s(float lo,float hi){f32x2_t v={lo,hi};bf16x2_t b=__builtin_convertvector(v,bf16x2_t);return __builtin_bit_cast(unsigned,b);}
#define WAIT_BAR(N) asm volatile("s_waitcnt vmcnt(" #N ") lgkmcnt(0)\n\ts_barrier":::"memory")

__device__ __forceinline__ void qkt(f32x16&p0,f32x16&p1,const char*Kslot,const bf16x8*qr,int r32,int hi){
  const char*kb=Kslot+hi*1024+r32*16;
  #pragma unroll
  for(int d0=0;d0<4;++d0){
    const bf16x8 b0=*reinterpret_cast<const bf16x8*>(kb+d0*2048);
    const bf16x8 b1=*reinterpret_cast<const bf16x8*>(kb+d0*2048+512);
    p0=__builtin_amdgcn_mfma_f32_32x32x16_bf16(b0,qr[d0],p0,0,0,0);p1=__builtin_amdgcn_mfma_f32_32x32x16_bf16(b1,qr[d0],p1,0,0,0);}
}
typedef __attribute__((address_space(3))) const char* lds_cptr;
typedef short v4i16_t __attribute__((ext_vector_type(4)));
__device__ __forceinline__ void kload8(bf16x8*kf,lds_cptr kp){
  kf[0]=*(const __attribute__((address_space(3))) bf16x8*)(kp);      kf[1]=*(const __attribute__((address_space(3))) bf16x8*)(kp+512);
  kf[2]=*(const __attribute__((address_space(3))) bf16x8*)(kp+2048); kf[3]=*(const __attribute__((address_space(3))) bf16x8*)(kp+2560);
  kf[4]=*(const __attribute__((address_space(3))) bf16x8*)(kp+4096); kf[5]=*(const __attribute__((address_space(3))) bf16x8*)(kp+4608);
  kf[6]=*(const __attribute__((address_space(3))) bf16x8*)(kp+6144); kf[7]=*(const __attribute__((address_space(3))) bf16x8*)(kp+6656);
}
__device__ __forceinline__ void kload2(bf16x8*kf,lds_cptr kp,int j){ kf[2*j]=*(const __attribute__((address_space(3))) bf16x8*)(kp+j*2048); kf[2*j+1]=*(const __attribute__((address_space(3))) bf16x8*)(kp+j*2048+512); }
__device__ __forceinline__ s16x4 vtr(lds_cptr p){ return __builtin_bit_cast(s16x4,__builtin_amdgcn_ds_read_tr16_b64_v4i16((__attribute__((address_space(3))) v4i16_t*)p)); }
__device__ __forceinline__ float rowmax(const f32x16&p0,const f32x16&p1){
  float a=max3f(p0[0],p0[1],p1[0]),b=max3f(p0[2],p0[3],p1[1]);a=max3f(a,p1[2],p1[3]);
  #pragma unroll
  for(int r=4;r<16;r+=4){a=max3f(a,p0[r],p0[r+1]);b=max3f(b,p0[r+2],p0[r+3]);a=max3f(a,p1[r],p1[r+1]);b=max3f(b,p1[r+2],p1[r+3]);}
  const float m=max2f(a,b);
  auto rr=__builtin_amdgcn_permlane32_swap(__float_as_uint(m),__float_as_uint(m),false,false);
  return max2f(__uint_as_float(rr[0]),__uint_as_float(rr[1]));
}
__device__ __forceinline__ void pv(f32x16*o,int vb,bf16x8 pa0,bf16x8 pa1,bf16x8 pa2,bf16x8 pa3){
  #pragma unroll
  for(int d0=0;d0<2;++d0){s16x4 lo[4],hi[4];
    #pragma unroll
    for(int ks=0;ks<4;++ks){
      asm volatile("ds_read_b64_tr_b16 %0,%1 offset:%c2":"=&v"(lo[ks]):"v"(vb),"i"(d0*4096+ks*1024):"memory");
      asm volatile("ds_read_b64_tr_b16 %0,%1 offset:%c2":"=&v"(hi[ks]):"v"(vb),"i"(d0*4096+ks*1024+512):"memory");}
    asm volatile("s_waitcnt lgkmcnt(0)":::"memory");SBAR();
    #define PK(k) (bf16x8){lo[k][0],lo[k][1],lo[k][2],lo[k][3],hi[k][0],hi[k][1],hi[k][2],hi[k][3]}
    o[d0]=__builtin_amdgcn_mfma_f32_32x32x16_bf16(pa0,PK(0),o[d0],0,0,0);
    o[d0]=__builtin_amdgcn_mfma_f32_32x32x16_bf16(pa1,PK(1),o[d0],0,0,0);
    o[d0]=__builtin_amdgcn_mfma_f32_32x32x16_bf16(pa2,PK(2),o[d0],0,0,0);
    o[d0]=__builtin_amdgcn_mfma_f32_32x32x16_bf16(pa3,PK(3),o[d0],0,0,0);
    #undef PK
  }
}

#ifndef ATTN_STORE16
#define ATTN_STORE16(p,v) (*(u32x4*)(p)=(v))
#endif
template<int THRL> __device__ __forceinline__ void attn_unit(int b,int h,int qb,const bf16*Q,const bf16*__restrict__ K,const bf16*__restrict__ V,bf16*O,char*shm){
  const __attribute__((address_space(3))) float* nbp=(const __attribute__((address_space(3))) float*)(lds_cptr)(shm+LDS_NB);
  #define BIASC(C0,C1,t) do{ const __attribute__((address_space(3))) float* bp_=nbp+(t)*64+4*hi; \
    _Pragma("unroll") for(int g_=0;g_<4;++g_){ const f32x4_t a_=*(const __attribute__((address_space(3))) f32x4_t*)(bp_+8*g_); const f32x4_t b_=*(const __attribute__((address_space(3))) f32x4_t*)(bp_+32+8*g_); \
      C0[4*g_]=a_[0]-mhat;C0[4*g_+1]=a_[1]-mhat;C0[4*g_+2]=a_[2]-mhat;C0[4*g_+3]=a_[3]-mhat; C1[4*g_]=b_[0]-mhat;C1[4*g_+1]=b_[1]-mhat;C1[4*g_+2]=b_[2]-mhat;C1[4*g_+3]=b_[3]-mhat; } }while(0)

  int tid_=threadIdx.x; asm volatile("":"+v"(tid_)); const int tid=tid_,lane=tid&63,r32=lane&31,hi=lane>>5; const int wid=__builtin_amdgcn_readfirstlane(tid>>6);
  const long rowbase=(long)b*SEQ; const int q0=qb*QB;
  const bf16*Qw=Q+(rowbase+q0+wid*QBLK)*DM+h*D;
  const bf16*Kh=K+rowbase*DM+h*D,*Vh=V+rowbase*DM+h*D;
  const unsigned lds0=(unsigned)(uintptr_t)shm;
  float*wsf=(float*)(shm+LDS_WS)+wid*64;
  const bf16*ksrc=Kh+(long)lane*DM+wid*8;
  const bf16*vsrc=Vh+(long)(16*(wid&3)+(lane>>2))*DM+(wid>>2)*32+(lane&3)*8;
  const unsigned kdst=lds0+LDS_K+wid*1024, vdst=lds0+LDS_V+wid*1024;
  #define DMA_K(t,slot) glds16(ksrc+(long)(t)*KVBLK*DM,(unsigned)__builtin_amdgcn_readfirstlane(kdst+(slot)))
  #define DMA_V(t,slot) glds16(vsrc+(long)(t)*KVBLK*DM,(unsigned)__builtin_amdgcn_readfirstlane(vdst+(slot)))
  const int vb0=(int)(lds0+LDS_V)+((lane>>4)&1)*32+(lane&3)*8+(4*hi+((lane&15)>>2))*64;
  const char*Kbase=shm+LDS_K; bf16x8 kf[8];
  const lds_cptr shm3=(lds_cptr)shm; const lds_cptr kp0=shm3+LDS_K+hi*1024+r32*16; const lds_cptr vp0=shm3+LDS_V+((lane>>4)&1)*32+(lane&3)*8+(4*hi+((lane&15)>>2))*64;
  const int NT=(q0+QB)/KVBLK;
  DMA_K(0,0);DMA_V(0,0);DMA_K(1,SLOTB);
  bf16x8 qr[4];
  #pragma unroll
  for(int d0=0;d0<4;++d0)qr[d0]=*reinterpret_cast<const bf16x8*>(&Qw[(long)r32*DM+d0*16+hi*8]);
  float mhat=0.f,l_reg=0.f;f32x16 o[2];o[0]=f32x16{};o[1]=f32x16{};
  const int qrel=wid*QBLK+r32;
  #define CMASK(P0,P1,t) do{int jb_=(t)-(NT-4); if(jb_>=0)cmask(P0,P1,jb_,qrel,hi);}while(0)
  bool resc=false;
  #define START(P0,P1) do{ const float rm=rowmax(P0,P1); resc=false; \
    { const float dl=rm; mhat=fadd_s(mhat,dl); \
      _Pragma("unroll") for(int r=0;r<16;++r){P0[r]=fsub_s(P0[r],dl);P1[r]=fsub_s(P1[r],dl);} \
      } \
    _Pragma("unroll") for(int r=0;r<16;++r)P0[r]=__builtin_amdgcn_exp2f(P0[r]); }while(0)
  #define RESC() do{ if(resc){ asm volatile("s_waitcnt lgkmcnt(0)":::"memory"); \
      _Pragma("unroll") for(int d_=0;d_<2;++d_) _Pragma("unroll") for(int r=0;r<16;++r)o[d_][r]*=wsf[crow(r,hi)]; } }while(0)
  f32x16 pA0,pA1,pB0,pB1;
  int sl_prev=0,sl_cur=0,sl_next=SLOTB;
  #define ROT() do{sl_prev=sl_cur;sl_cur=sl_next;sl_next=(sl_next==(NSLOT-1)*SLOTB)?0:sl_next+SLOTB;}while(0)
  DMA_K(2,2*SLOTB);
  WAIT_BAR(3);
  BIASC(pA0,pA1,0); qkt(pA0,pA1,Kbase,qr,r32,hi);asm volatile("s_nop 15\n\ts_nop 7":"+v"(pA0),"+v"(pA1));CMASK(pA0,pA1,0);
  START(pA0,pA1);
  _Pragma("unroll") for(int r=0;r<16;++r)pA1[r]=__builtin_amdgcn_exp2f(pA1[r]);
  WAIT_BAR(0);
  DMA_K(3,0);DMA_V(1,SLOTB);
  ROT();
  kload8(kf,kp0+sl_cur);
  WAIT_BAR(2);
  s16x4 vlo[8],vhi[8]; u32x4 pw0,pw1,pw2,pw3;
  #define PKW(P,B) cvtpk_s(P[B],P[B+1])
  #define PAF(k) __builtin_bit_cast(bf16x8,pw##k)
  #define VFR(i) (bf16x8){vlo[i][0],vlo[i][1],vlo[i][2],vlo[i][3],vhi[i][0],vhi[i][1],vhi[i][2],vhi[i][3]}
  #define PIN(x) asm volatile("":"+v"(x))
  #define MX3(a,b,c) __builtin_fmaxf(__builtin_fmaxf((a),(b)),(c))
  #define GAPA(MF,A0,A1,A2,A3,W0,W1,PW) do{ MF; sacc+=A0; sacc+=A1; sacc+=A2; sacc+=A3; PIN(sacc); W0; W1; PIN(PW); SBAR(); }while(0)
  #define EX(v) __builtin_amdgcn_exp2f(v)
  #define GAPB(MF,X,B) do{ MF; X[B]=EX(X[B]); X[B+1]=EX(X[B+1]); X[B+2]=EX(X[B+2]); X[B+3]=EX(X[B+3]); PIN(X); SBAR(); }while(0)
  #define VRD(i) do{ vlo[i]=vtr(vp_+(((i)>>2)*4096+((i)&3)*1024)); vhi[i]=vtr(vp_+(((i)>>2)*4096+((i)&3)*1024+512)); }while(0)
  #define KRD(G,j) do{ if(G){ kload2(kf,kp0+sl_next,j); SBAR(); } }while(0)
  #define STEP(C0,C1,P0,P1,t,GK,GV,GL) do{ SBAR(); BIASC(C0,C1,t); SBAR(); \
    const lds_cptr vp_=vp0+sl_prev; \
    VRD(0); SBAR(); float sacc=(P0[0]+P0[1]); \
    GAPA(C0=__builtin_amdgcn_mfma_f32_32x32x16_bf16(kf[0],qr[0],C0,0,0,0), P0[2],P0[3],P0[4],P0[5],     pw0[0]=PKW(P0,0), pw0[1]=PKW(P0,2), pw0); \
    VRD(4); SBAR(); GAPA(C1=__builtin_amdgcn_mfma_f32_32x32x16_bf16(kf[1],qr[0],C1,0,0,0), P0[6],P0[7],P0[8],P0[9],     pw0[2]=PKW(P0,4), pw0[3]=PKW(P0,6), pw0); \
    VRD(1); SBAR(); GAPA(C0=__builtin_amdgcn_mfma_f32_32x32x16_bf16(kf[2],qr[1],C0,0,0,0),   P0[10],P0[11],P0[12],P0[13], pw1[0]=PKW(P0,8), pw1[1]=PKW(P0,10), pw1); \
    VRD(5); SBAR(); GAPA(C1=__builtin_amdgcn_mfma_f32_32x32x16_bf16(kf[3],qr[1],C1,0,0,0),   P0[14],P0[15],P1[0],P1[1],   pw1[2]=PKW(P0,12),pw1[3]=PKW(P0,14), pw1); \
    VRD(2); SBAR(); GAPA(C0=__builtin_amdgcn_mfma_f32_32x32x16_bf16(kf[4],qr[2],C0,0,0,0),   P1[2],P1[3],P1[4],P1[5],     pw2[0]=PKW(P1,0), pw2[1]=PKW(P1,2), pw2); \
    VRD(6); SBAR(); GAPA(C1=__builtin_amdgcn_mfma_f32_32x32x16_bf16(kf[5],qr[2],C1,0,0,0),   P1[6],P1[7],P1[8],P1[9],     pw2[2]=PKW(P1,4), pw2[3]=PKW(P1,6), pw2); \
    VRD(3); SBAR(); GAPA(C0=__builtin_amdgcn_mfma_f32_32x32x16_bf16(kf[6],qr[3],C0,0,0,0),   P1[10],P1[11],P1[12],P1[13], pw3[0]=PKW(P1,8), pw3[1]=PKW(P1,10), pw3); \
    VRD(7); SBAR(); GAPA(C1=__builtin_amdgcn_mfma_f32_32x32x16_bf16(kf[7],qr[3],C1,0,0,0),   P1[14],P1[15],0.f,0.f,       pw3[2]=PKW(P1,12),pw3[3]=PKW(P1,14), pw3); \
    l_reg+=sacc; \
    if(GK){DMA_K((t)+3,sl_cur);} if(GV){DMA_V((t)+1,sl_next);} \
    CMASK(C0,C1,t); \
    { float a=MX3(C0[0],C0[1],C1[0]),b=MX3(C0[2],C0[3],C1[1]); a=MX3(a,C1[2],C1[3]); \
      _Pragma("unroll") for(int r=4;r<16;r+=4){a=MX3(a,C0[r],C0[r+1]);b=MX3(b,C0[r+2],C0[r+3]);a=MX3(a,C1[r],C1[r+1]);b=MX3(b,C1[r+2],C1[r+3]);} \
      float rm=__builtin_fmaxf(a,b); { auto rr=__builtin_amdgcn_permlane32_swap(__float_as_uint(rm),__float_as_uint(rm),false,false); rm=__builtin_fmaxf(__uint_as_float(rr[0]),__uint_as_float(rr[1])); } \
      resc=false; \
      if(__builtin_expect(__any(rm>(float)THRL),0)){ const float dl=__builtin_fmaxf(rm,0.f); mhat+=dl; \
        _Pragma("unroll") for(int r=0;r<16;++r){C0[r]-=dl;C1[r]-=dl;} \
        const float f=__builtin_amdgcn_exp2f(-dl); l_reg*=f; if(hi==0)wsf[r32]=f; resc=true; } } \
    SBAR(); \
    GAPB(o[0]=__builtin_amdgcn_mfma_f32_32x32x16_bf16(PAF(0),VFR(0),o[0],0,0,0), C0,0); \
    GAPB(o[1]=__builtin_amdgcn_mfma_f32_32x32x16_bf16(PAF(0),VFR(4),o[1],0,0,0), C0,4); \
    KRD(GL,0); GAPB(o[0]=__builtin_amdgcn_mfma_f32_32x32x16_bf16(PAF(1),VFR(1),o[0],0,0,0), C0,8); \
    KRD(GL,1); GAPB(o[1]=__builtin_amdgcn_mfma_f32_32x32x16_bf16(PAF(1),VFR(5),o[1],0,0,0), C0,12); \
    KRD(GL,2); GAPB(o[0]=__builtin_amdgcn_mfma_f32_32x32x16_bf16(PAF(2),VFR(2),o[0],0,0,0), C1,0); \
    KRD(GL,3); GAPB(o[1]=__builtin_amdgcn_mfma_f32_32x32x16_bf16(PAF(2),VFR(6),o[1],0,0,0), C1,4); \
    GAPB(o[0]=__builtin_amdgcn_mfma_f32_32x32x16_bf16(PAF(3),VFR(3),o[0],0,0,0), C1,8); \
    GAPB(o[1]=__builtin_amdgcn_mfma_f32_32x32x16_bf16(PAF(3),VFR(7),o[1],0,0,0), C1,12); \
    }while(0)
  int t=1;
  #undef CMASK
  #define CMASK(P0,P1,t) do{}while(0)
  for(;t+5<NT;t+=2){
    STEP(pB0,pB1,pA0,pA1,t,true,true,true);     WAIT_BAR(2); RESC(); ROT();
    STEP(pA0,pA1,pB0,pB1,t+1,true,true,true);   WAIT_BAR(2); RESC(); ROT();
  }
  #undef CMASK
  #define CMASK(P0,P1,t) do{int jb_=(t)-(NT-4); if(jb_>=0)cmask(P0,P1,jb_,qrel,hi);}while(0)
  #define ENDW(tt) do{ if((tt)+3<NT){WAIT_BAR(2);} else if((tt)+2<NT){WAIT_BAR(1);} else {WAIT_BAR(0);} }while(0)
  for(;t+1<NT;t+=2){
    STEP(pB0,pB1,pA0,pA1,t,(t+3<NT),(t+1<NT),(t+1<NT));       ENDW(t);   RESC(); ROT();
    STEP(pA0,pA1,pB0,pB1,t+1,(t+4<NT),(t+2<NT),(t+2<NT));     ENDW(t+1); RESC(); ROT();
  }
  STEP(pB0,pB1,pA0,pA1,NT-1,false,false,false); RESC();
  { float sacc=pB0[0]+pB0[1]; _Pragma("unroll") for(int r=2;r<16;++r)sacc+=pB0[r]; _Pragma("unroll") for(int r=0;r<16;++r)sacc+=pB1[r]; l_reg+=sacc;
    pw0=(u32x4){PKW(pB0,0),PKW(pB0,2),PKW(pB0,4),PKW(pB0,6)};pw1=(u32x4){PKW(pB0,8),PKW(pB0,10),PKW(pB0,12),PKW(pB0,14)};pw2=(u32x4){PKW(pB1,0),PKW(pB1,2),PKW(pB1,4),PKW(pB1,6)};pw3=(u32x4){PKW(pB1,8),PKW(pB1,10),PKW(pB1,12),PKW(pB1,14)};
    SBAR(); pv(o,vb0+sl_cur,PAF(0),PAF(1),PAF(2),PAF(3)); }
  #undef PKW
  #undef PAF
  #undef VFR
  #undef PIN
  #undef MX3
  #undef GAPA
  #undef GAPB
  #undef EX
  #undef VRD
  #undef KRD
  #undef STEP
  #undef ENDW
  {auto rr=__builtin_amdgcn_permlane32_swap(__float_as_uint(l_reg),__float_as_uint(l_reg),false,false);l_reg=__uint_as_float(rr[0])+__uint_as_float(rr[1]);}
  if(hi==0)wsf[32+r32]=l_reg;asm volatile("s_waitcnt lgkmcnt(0)":::"memory");
  float rli[16];
  #pragma unroll
  for(int r=0;r<16;++r)rli[r]=__builtin_amdgcn_rcpf(wsf[32+crow(r,hi)]);
  bf16*Ow=O+(rowbase+q0+wid*QBLK)*DM+h*D;
  { bf16*stg=(bf16*)(shm+LDS_OST)+wid*2048;
    #pragma unroll
    for(int r=0;r<16;++r){const int orow=crow(r,hi);
      #pragma unroll
      for(int d0=0;d0<2;++d0)stg[orow*64+d0*32+r32]=__float2bfloat16(o[d0][r]*rli[r]);}
    asm volatile("s_waitcnt lgkmcnt(0)":::"memory");
    #pragma unroll
    for(int i=0;i<4;++i){const int row=i*8+(lane>>3),ch=lane&7; const u32x4 v=*(const u32x4*)(stg+row*64+ch*8); ATTN_STORE16(Ow+(long)row*DM+ch*8,v);} }
  asm volatile("s_waitcnt lgkmcnt(0)\n\ts_barrier":::"memory");
  #undef BIASC
  #undef DMA_K
  #undef DMA_V
  #undef CMASK
  #undef START
  #undef RESC
  #undef ROT
}
constexpr int ATTN_LDS_BYTES=LDS_BYTES;
struct AttnTensors { const bf16* Q; const bf16* K; const bf16* V; bf16* O; };
struct AttnUnit { int bh; int qb; };
struct StaticOrder {
  int vcu;
  __device__ __forceinline__ explicit StaticOrder(int grid,int block):vcu((block%8)*(grid/8)+block/8){}
  __device__ __forceinline__ bool next(int i,AttnUnit&u)const{ if(i>=8)return false; const int p=vcu&1; u.bh=vcu>>1; const int base=4*(i>>1); u.qb=(i&1)?base+3-p:base+p; return true; }
  __device__ __forceinline__ void a_ready(const AttnUnit&)const{}
  __device__ __forceinline__ void done(const AttnUnit&)const{}
};
template<class Sched,int THRL=8> __device__ __forceinline__ void attn_phase(char*lds,const AttnTensors&T,const Sched&S){
  AttnUnit u;
  for(int i=0;S.next(i,u);++i){ S.a_ready(u); attn_unit<THRL>(u.bh/NHEAD,u.bh%NHEAD,u.qb,T.Q,T.K,T.V,T.O,lds); S.done(u); }
}
#undef SBAR
#undef WAIT_BAR
}
#define XB_TMO      128
#define XB_XCNT(j)  (256  + 64 * (j))
#define XB_XSUB(j)  (1280 + 64 * (j))
#define XB_XGEN(j)  (2304 + 64 * (j))
#define XB_TOP      3328
#define XB_TOPGEN   3392
#define XCD_BAR_WORDS 3456
#define XB_SPIN_CAP (1u << 18)

__device__ __forceinline__ unsigned xb_ld(unsigned* p)              { return __hip_atomic_load(p, __ATOMIC_RELAXED, __HIP_MEMORY_SCOPE_AGENT); }
__device__ __forceinline__ unsigned xb_add(unsigned* p, unsigned v) { return __hip_atomic_fetch_add(p, v, __ATOMIC_RELAXED, __HIP_MEMORY_SCOPE_AGENT); }
__device__ __forceinline__ unsigned xb_xcc_id() { return (unsigned)__builtin_amdgcn_s_getreg((3 << 11) | 20) & 0xFu; }
#define XB_SPIN(cond, bar) do { unsigned _sp = 0; while (cond) { __builtin_amdgcn_s_sleep(1); \
    if ((++_sp & 255u) == 0u) { if (xb_ld(&(bar)[XB_TMO])) break; if (_sp > XB_SPIN_CAP) { atomicAdd(&(bar)[XB_TMO], 1u); break; } } } } while (0)

struct XcdBarrier {
    unsigned* bar; unsigned x;
    volatile LAS unsigned* st;
};

__device__ __forceinline__ XcdBarrier xcd_barrier_post(unsigned* bar, volatile LAS unsigned* st) {
    XcdBarrier b; b.bar = bar; b.x = xb_xcc_id(); b.st = st;
    if (threadIdx.x == 0) (void)xb_add(&bar[XB_XCNT(b.x)], 1u);
    return b;
}
__device__ __forceinline__ void xcd_barrier_complete(unsigned* bar, unsigned x, unsigned& nloc, unsigned& nx) {
    const unsigned G = gridDim.x * gridDim.y * gridDim.z;
    unsigned sum, cnt, mine, sp = 0u;
    for (;;) {
        sum = 0u; cnt = 0u; mine = 0u;
#pragma unroll
        for (unsigned j = 0; j < 16; ++j) { const unsigned c = xb_ld(&bar[XB_XCNT(j)]); sum += c; cnt += (c > 0u) ? 1u : 0u; mine = (j == x) ? c : mine; }
        if (sum == G) break;
        __builtin_amdgcn_s_sleep(1);
        if ((++sp & 255u) == 0u) { if (xb_ld(&bar[XB_TMO])) break; if (sp > XB_SPIN_CAP) { atomicAdd(&bar[XB_TMO], 1u); break; } }
    }
    nloc = mine > 0u ? mine : 1u; nx = cnt > 0u ? cnt : 1u;
}

__device__ __forceinline__ void xcd_barrier(const XcdBarrier& b) {
    asm volatile("s_waitcnt vmcnt(0)" ::: "memory");
    __syncthreads();
    if (threadIdx.x == 0) {
        unsigned* bar = b.bar;
        __builtin_amdgcn_s_waitcnt(0);
        unsigned nloc = b.st[0], nx = b.st[1];
        if (nloc == 0u) { xcd_barrier_complete(bar, b.x, nloc, nx); b.st[0] = nloc; b.st[1] = nx; }
        const unsigned old = xb_add(&bar[XB_XSUB(b.x)], 1u);
        const unsigned gen = old / nloc;
        if (old + 1u == (gen + 1u) * nloc) {
            __builtin_amdgcn_fence(__ATOMIC_RELEASE, "agent");
            asm volatile("s_waitcnt vmcnt(0)" ::: "memory");
            const unsigned og = xb_add(&bar[XB_TOP], 1u);
            const unsigned tg = og / nx;
            if (og + 1u == (tg + 1u) * nx) xb_add(&bar[XB_TOPGEN], 1u);
            else XB_SPIN(xb_ld(&bar[XB_TOPGEN]) == tg, bar);
            __builtin_amdgcn_fence(__ATOMIC_ACQUIRE, "agent");
            xb_add(&bar[XB_XGEN(b.x)], 1u);
            asm volatile("s_waitcnt vmcnt(0)" ::: "memory");
        } else {
            XB_SPIN(xb_ld(&bar[XB_XGEN(b.x)]) == gen, bar);
            __builtin_amdgcn_fence(__ATOMIC_ACQUIRE, "agent");
            asm volatile("s_waitcnt vmcnt(0)" ::: "memory");
        }
    }
    __syncthreads();
}
constexpr int BATCH = 8, SEQ = 4096, DM = 1024, T = BATCH * SEQ, DFF = 2816, DPLE = 256;
constexpr int NWAVES = 8;
typedef unsigned short bf16;
typedef unsigned v4u __attribute__((ext_vector_type(4)));
typedef unsigned v2u __attribute__((ext_vector_type(2)));
typedef float f32x4 __attribute__((ext_vector_type(4)));
typedef short bf16x8 __attribute__((ext_vector_type(8)));
typedef short v4i16 __attribute__((ext_vector_type(4)));
__device__ __forceinline__ unsigned f2bf(float f) { unsigned u = __builtin_bit_cast(unsigned, f); return (u + 0x7fffu + ((u >> 16) & 1u)) >> 16; }
__device__ __forceinline__ unsigned pk2(float lo, float hi) { return f2bf(lo) | (f2bf(hi) << 16); }

constexpr size_t MiB = 1u << 20;
constexpr size_t WS_SS = 0;
constexpr size_t WS_HSS = 1280 * 1024;
constexpr size_t WS_BAR = 1856 * 1024;
constexpr size_t WS_LOGF = 2 * MiB;
constexpr size_t WS_ROPE = 4 * MiB;
constexpr size_t WS_WFFI = 8 * MiB;
constexpr size_t WS_WFFO = 52 * MiB;
constexpr size_t WS_WRIN = 74 * MiB;
constexpr size_t WS_WRG = 82 * MiB;
constexpr size_t WS_WRO = 86 * MiB;
constexpr size_t WS_WFIN = 90 * MiB;
constexpr size_t WS_WFZ = 96 * MiB;
constexpr size_t WS_WFO = 97 * MiB;
constexpr size_t WS_WPG = 99 * MiB;
constexpr size_t WS_WPP = 103 * MiB;
constexpr size_t WS_HB = 104 * MiB;
constexpr size_t WS_PB = 168 * MiB;
constexpr size_t WS_POOL = 200 * MiB;
constexpr size_t WS_END = 456 * MiB;
constexpr int LDS_BYTES = 147456, RING_BYTES = 131072;

namespace ret {
constexpr int KP = 544, VP = 144, PPI = 144;
constexpr int L_K = 0, L_V = L_K + 64 * KP, L_P = L_V + 64 * VP, L_ST = L_P + 64 * PPI, L_END = L_ST + 64 * KP;
static_assert(L_END <= RING_BYTES, "retention LDS");
#define MFMA16(a, b, c) __builtin_amdgcn_mfma_f32_16x16x32_bf16((a), (b), (c), 0, 0, 0)
__device__ __forceinline__ bf16x8 trfrag(const LAS char* p, int pitch) {
    const v4i16 lo = __builtin_amdgcn_ds_read_tr16_b64_v4i16((LAS v4i16*)p), hi = __builtin_amdgcn_ds_read_tr16_b64_v4i16((LAS v4i16*)(p + 4 * pitch));
    return (bf16x8){lo[0], lo[1], lo[2], lo[3], hi[0], hi[1], hi[2], hi[3]};
}
__device__ __forceinline__ void ret_phase(LAS char* L, const bf16* Qt, const bf16* Kt, bf16* VO, float* hss, int vcu) {
    int tid_ = threadIdx.x; asm volatile("" : "+v"(tid_));
    const int tid = tid_, lane = tid & 63, w = __builtin_amdgcn_readfirstlane(tid >> 6), m16 = lane & 15, g = lane >> 4, q4 = m16 >> 2, p4 = lane & 3;
    const int ib = w >> 1, half = w & 1;
    const int bh = vcu >> 3, es = vcu & 7, b = bh >> 2, h = bh & 3;
    const float lg = log2f(1.0f - exp2f(-5.0f - (float)h)), gC = exp2f(64.0f * lg);
    const size_t tok0 = (size_t)b * SEQ;
    const bf16* kbase = Kt + tok0 * 1024 + h * 256 + (size_t)(tid >> 5) * 1024 + (tid & 31) * 8;
    const bf16* vbase = VO + tok0 * 2048 + h * 512 + es * 64 + (size_t)(tid >> 3) * 2048 + (tid & 7) * 8;
    const bf16* qbase = Qt + tok0 * 1024 + h * 256 + (size_t)(16 * ib + m16) * 1024 + 8 * g;
    for (int i = tid; i < 64 * KP / 16; i += 512) *(LAS v4u*)(L + L_ST + 16 * i) = (v4u){0u, 0u, 0u, 0u};
    f32x4 st[2][4];
#pragma unroll
    for (int a = 0; a < 2; ++a)
#pragma unroll
        for (int e = 0; e < 4; ++e) st[a][e] = (f32x4){0.f, 0.f, 0.f, 0.f};
    v4u kreg[4], vreg; bf16x8 qn[8];
#define RET_LOAD(c) do { _Pragma("unroll") for (int u_ = 0; u_ < 4; ++u_) kreg[u_] = *(const v4u*)(kbase + (size_t)((c) * 64 + 16 * u_) * 1024); \
        vreg = *(const v4u*)(vbase + (size_t)(c) * 64 * 2048); \
        _Pragma("unroll") for (int s_ = 0; s_ < 8; ++s_) qn[s_] = *(const bf16x8*)(qbase + (size_t)(c) * 64 * 1024 + 32 * s_); } while (0)
    RET_LOAD(0);
    const int troff_k = (8 * g + q4) * KP + 8 * p4, troff_v = (8 * g + q4) * VP + 8 * p4;
    for (int c = 0; c < 64; ++c) {
#pragma unroll
        for (int u_ = 0; u_ < 4; ++u_) *(LAS v4u*)(L + L_K + ((tid >> 5) + 16 * u_) * KP + (tid & 31) * 16) = kreg[u_];
        *(LAS v4u*)(L + L_V + (tid >> 3) * VP + (tid & 7) * 16) = vreg;
        bf16x8 qf[8];
#pragma unroll
        for (int s = 0; s < 8; ++s) qf[s] = qn[s];
        __syncthreads();
        if (c + 1 < 64) RET_LOAD(c + 1);
#pragma unroll
        for (int jj = 0; jj < 2; ++jj) { const int jb = 2 * half + jj; f32x4 sa = (f32x4){0.f, 0.f, 0.f, 0.f};
#pragma unroll
            for (int s = 0; s < 8; ++s) { const bf16x8 a = *(const LAS bf16x8*)(L + L_K + (16 * jb + m16) * KP + (32 * s + 8 * g) * 2); sa = MFMA16(a, qf[s], sa); }
            const int il = 16 * ib + m16, j0 = 16 * jb + 4 * g;
            const float s0 = (j0 + 0 <= il) ? sa[0] : 0.f, s1 = (j0 + 1 <= il) ? sa[1] : 0.f, s2 = (j0 + 2 <= il) ? sa[2] : 0.f, s3 = (j0 + 3 <= il) ? sa[3] : 0.f;
            *(LAS v2u*)(L + L_P + il * PPI + j0 * 2) = (v2u){pk2(s0, s1), pk2(s2, s3)}; }
        f32x4 oa[2];
#pragma unroll
        for (int ee = 0; ee < 2; ++ee) { const int eb = 2 * half + ee; oa[ee] = (f32x4){0.f, 0.f, 0.f, 0.f};
#pragma unroll
            for (int s = 0; s < 8; ++s) { const bf16x8 a = *(const LAS bf16x8*)(L + L_ST + (16 * eb + m16) * KP + (32 * s + 8 * g) * 2); oa[ee] = MFMA16(a, qf[s], oa[ee]); } }
        __syncthreads();
        bf16x8 vt[2][4];
#pragma unroll
        for (int ks = 0; ks < 2; ++ks)
#pragma unroll
            for (int eb = 0; eb < 4; ++eb) vt[ks][eb] = trfrag(L + L_V + (32 * ks) * VP + (16 * eb) * 2 + troff_v, VP);
#pragma unroll
        for (int ks = 0; ks < 2; ++ks) { const bf16x8 pf = *(const LAS bf16x8*)(L + L_P + (16 * ib + m16) * PPI + (32 * ks + 8 * g) * 2);
            if (half == 0) { oa[0] = MFMA16(vt[ks][0], pf, oa[0]); oa[1] = MFMA16(vt[ks][1], pf, oa[1]); }
            else           { oa[0] = MFMA16(vt[ks][2], pf, oa[0]); oa[1] = MFMA16(vt[ks][3], pf, oa[1]); } }
        { const size_t tok = tok0 + (size_t)c * 64 + 16 * ib + m16; float sq = 0.f;
#pragma unroll
            for (int ee = 0; ee < 2; ++ee) { const f32x4 o = oa[ee]; sq += (o[0] * o[0] + o[1] * o[1]) + (o[2] * o[2] + o[3] * o[3]);
                *(v2u*)(VO + tok * 2048 + h * 512 + es * 64 + 16 * (2 * half + ee) + 4 * g) = (v2u){pk2(o[0], o[1]), pk2(o[2], o[3])}; }
            sq += __shfl_xor(sq, 16); sq += __shfl_xor(sq, 32); if (g == 0) atomicAdd(hss + tok * 4 + h, sq); }
#pragma unroll
        for (int ks = 0; ks < 2; ++ks)
#pragma unroll
            for (int dd = 0; dd < 2; ++dd) { const bf16x8 kt = trfrag(L + L_K + (32 * ks) * KP + (16 * (2 * w + dd)) * 2 + troff_k, KP);
#pragma unroll
                for (int eb = 0; eb < 4; ++eb) st[dd][eb] = MFMA16(kt, vt[ks][eb], st[dd][eb]); }
#pragma unroll
        for (int dd = 0; dd < 2; ++dd)
#pragma unroll
            for (int eb = 0; eb < 4; ++eb) { st[dd][eb] = st[dd][eb] * gC; const f32x4 s = st[dd][eb];
                *(LAS v2u*)(L + L_ST + (16 * eb + m16) * KP + (16 * (2 * w + dd) + 4 * g) * 2) = (v2u){pk2(s[0], s[1]), pk2(s[2], s[3])}; }
        __syncthreads();
    }
#undef RET_LOAD
}
}

struct Args { const float* in[14]; float* out; unsigned char* ws; };
struct Frame { LAS unsigned char* lds; int tid, lane, wave, vcu, G; };

__device__ __forceinline__ float wave_sum(float v) {
#pragma unroll
    for (int o = 1; o < 64; o <<= 1) v += __shfl_xor(v, o);
    return v;
}
__device__ __forceinline__ void prep_item(const float* W, int K, int Nsrc, bf16* WT, int rows, int mode, int coloff, const float* ks, LAS float* scr, int item, int lane) {
    const int nblk = rows / 32, kb = item / nblk, nb = item % nblk, k0 = 64 * kb, n0 = 32 * nb;
    const int src0 = mode ? (((n0 >> 7) & 1) * DFF + 128 * (n0 >> 8) + (n0 & 127)) : (coloff + n0);
#pragma unroll 8
    for (int i = 0; i < 32; ++i) { const int kk = 2 * i + (lane >> 5); scr[kk * 33 + (lane & 31)] = W[(size_t)(k0 + kk) * Nsrc + src0 + (lane & 31)]; }
    asm volatile("s_waitcnt lgkmcnt(0)" ::: "memory");
    const int c = lane & 7;
    float sc[8];
#pragma unroll
    for (int x = 0; x < 8; ++x) sc[x] = ks ? ks[k0 + 8 * c + x] : 1.0f;
#pragma unroll
    for (int j = 0; j < 4; ++j) { const int n = (lane >> 3) + 8 * j; const LAS float* s = scr + (8 * c) * 33 + n;
        v4u o; o.x = pk2(s[0 * 33] * sc[0], s[1 * 33] * sc[1]); o.y = pk2(s[2 * 33] * sc[2], s[3 * 33] * sc[3]); o.z = pk2(s[4 * 33] * sc[4], s[5 * 33] * sc[5]); o.w = pk2(s[6 * 33] * sc[6], s[7 * 33] * sc[7]);
        *(v4u*)(WT + (size_t)(n0 + n) * K + k0 + 8 * c) = o; }
    asm volatile("s_waitcnt lgkmcnt(0)" ::: "memory");
}
#define PREP(Wp, K_, Nsrc_, WTp, rows_, mode_, coloff_, ksp) do { const int nit_ = ((K_) / 64) * ((rows_) / 32); \
    for (int it_ = gw; it_ < nit_; it_ += NGW) prep_item((Wp), (K_), (Nsrc_), (WTp), (rows_), (mode_), (coloff_), (ksp), scr, it_, F.lane); } while (0)

typedef const volatile __attribute__((address_space(4))) unsigned long long* kargp_t;
#define KARG(i) ((unsigned long long)(*((kargp_t)__builtin_amdgcn_kernarg_segment_ptr() + (i))))
#define KIN(i) ((const float*)KARG(i))
#define KOUT ((float*)KARG(14))
#define KWS ((unsigned char*)KARG(15))
#define SEAM() do { XcdBarrier b_; b_.bar = (unsigned*)(KWS + WS_BAR); b_.x = xb_xcc_id(); b_.st = (volatile LAS unsigned*)(F.lds + RING_BYTES) + 8; xcd_barrier(b_); } while (0)
#define GEMM_PHASE(EpiT, Aop, Bop, N_, K_, Eobj) do { pg8::Gemm g_{(const pg8::bf16_t*)(Aop), (const pg8::bf16_t*)(Bop), T, (N_), (K_)}; pg8::StaticOrder S_; S_.init(T, (N_), F.G, (int)blockIdx.x); \
        pg8::gemm_phase<EpiT, pg8::StaticOrder, true, true>(F.lds, g_, S_, (Eobj)); } while (0)

__device__ __forceinline__ void p0_prologue(const Frame& F) {
    unsigned char* ws = KWS;
    const float* norm_w = KIN(2);
    float* SS = (float*)(ws + WS_SS); float* HSS = (float*)(ws + WS_HSS);
    const int gw = F.vcu * NWAVES + F.wave, NGW = F.G * NWAVES, gtid = gw * 64 + F.lane, NGT = NGW * 64;
    LAS float* scr = (LAS float*)(F.lds + F.wave * 16384);
    for (int i = gtid; i < 8 * T + 4 * T; i += NGT) { if (i < 8 * T) SS[T + i] = 0.f; else HSS[i - 8 * T] = 0.f; }
    { float* ROPE = (float*)(ws + WS_ROPE);
      for (int i = gtid; i < 4096 * 128; i += NGT) { const int pos = i >> 7, j = i & 127;
        const float inv = exp2f(-(float)j * (13.287712379549449f / 128.0f)); const float ang = (float)pos * inv;
        double tr = (double)ang * 0.15915494309189535; tr -= rint(tr); const float tf = (float)tr;
        ROPE[2 * i] = __builtin_amdgcn_cosf(tf); ROPE[2 * i + 1] = __builtin_amdgcn_sinf(tf); } }
    { const float* x = KIN(0); bf16* HB = (bf16*)(ws + WS_HB);
      for (int m = gw; m < T; m += NGW) {
        const f32x4* xr = (const f32x4*)(x + (size_t)m * DM) + F.lane; float s = 0.f; unsigned long long* o8 = (unsigned long long*)(HB + (size_t)m * DM) + F.lane;
#pragma unroll
        for (int j = 0; j < 4; ++j) { const f32x4 v = xr[64 * j]; s += (v.x * v.x + v.y * v.y) + (v.z * v.z + v.w * v.w); o8[64 * j] = (unsigned long long)pk2(v.x, v.y) | ((unsigned long long)pk2(v.z, v.w) << 32); }
        s = wave_sum(s); if (F.lane == 0) SS[m] = s; } }
    { const float* pin = KIN(1); bf16* PB = (bf16*)(ws + WS_PB);
      for (int i = gtid; i < 2 * T * DPLE / 4; i += NGT) { const f32x4 v = ((const f32x4*)pin)[i]; ((unsigned long long*)PB)[i] = (unsigned long long)pk2(v.x, v.y) | ((unsigned long long)pk2(v.z, v.w) << 32); } }
    { const float* fox_w_in = KIN(8); bf16* WFZ = (bf16*)(ws + WS_WFZ);
      for (int i = gtid; i < 16 * 1024; i += NGT) { const int n = i >> 10, k = i & 1023; WFZ[i] = (bf16)f2bf(fox_w_in[(size_t)k * 3088 + 3072 + n] * norm_w[(4 + 1) * DM + k]); } }
#pragma unroll 1
    for (int fi = 0; fi < 4; ++fi) { const int li = fi >> 1, f = fi & 1;
        PREP(KIN(3) + (size_t)fi * DM * 2 * DFF, DM, 2 * DFF, (bf16*)(ws + WS_WFFI) + (size_t)fi * 2 * DFF * DM, 2 * DFF, 1, 0, norm_w + (li * 4 + (f ? 2 : 0)) * DM);
        PREP(KIN(4) + (size_t)fi * DFF * DM, DFF, DM, (bf16*)(ws + WS_WFFO) + (size_t)fi * DM * DFF, DM, 0, 0, (const float*)nullptr); }
    PREP(KIN(5), DM, 6144, (bf16*)(ws + WS_WRIN), 4096, 0, 0, norm_w + 1 * DM);
    PREP(KIN(5), DM, 6144, (bf16*)(ws + WS_WRG), 2048, 0, 4096, norm_w + 1 * DM);
    PREP(KIN(7), 2048, DM, (bf16*)(ws + WS_WRO), DM, 0, 0, (const float*)nullptr);
    PREP(KIN(8), DM, 3088, (bf16*)(ws + WS_WFIN), 3072, 0, 0, norm_w + (4 + 1) * DM);
    PREP(KIN(10), DM, DM, (bf16*)(ws + WS_WFO), DM, 0, 0, (const float*)nullptr);
#pragma unroll 1
    for (int li = 0; li < 2; ++li) {
        PREP(KIN(12) + (size_t)li * DM * DM, DM, DM, (bf16*)(ws + WS_WPG) + (size_t)li * DM * DM, DM, 0, 0, norm_w + (li * 4 + 3) * DM);
        PREP(KIN(11) + (size_t)li * DPLE * DM, DPLE, DM, (bf16*)(ws + WS_WPP) + (size_t)li * DM * DPLE, DM, 0, 0, (const float*)nullptr); }
}

template <int FI, int SITE, bool FIRST, bool WITH_PP> __device__ __forceinline__ void ffn_half(const Frame& F, cg::grid_group& grid) {
    { unsigned char* ws = KWS; pg8::EpiSwiglu E{(pg8::bf16_t*)(ws + WS_POOL), (const float*)(ws + WS_SS) + (size_t)SITE * T};
      GEMM_PHASE(pg8::EpiSwiglu, ws + WS_HB, (bf16*)(ws + WS_WFFI) + (size_t)FI * 2 * DFF * DM, 2 * DFF, DM, E); }
    SEAM();
    { unsigned char* ws = KWS; float* hres = KOUT; pg8::EpiRes E{FIRST ? KIN(0) : (const float*)hres, hres, (pg8::bf16_t*)(ws + WS_HB), (float*)(ws + WS_SS) + (size_t)(SITE + 1) * T, 0.5f};
      GEMM_PHASE(pg8::EpiRes, ws + WS_POOL, (bf16*)(ws + WS_WFFO) + (size_t)FI * DM * DFF, DM, DFF, E); }
    if (WITH_PP) { unsigned char* ws = KWS; constexpr int LI = FI >> 1; pg8::EpiPlain E{(pg8::bf16_t*)(ws + WS_POOL + 176 * MiB), DM, (const float*)nullptr, 0, 0, 1.0f};
      GEMM_PHASE(pg8::EpiPlain, (bf16*)(ws + WS_PB) + (size_t)LI * T * DPLE, (bf16*)(ws + WS_WPP) + (size_t)LI * DM * DPLE, DM, DPLE, E); }
    SEAM();
}
template <int LI> __device__ __forceinline__ void ple_phase(const Frame& F, cg::grid_group& grid) {
    { unsigned char* ws = KWS; float* hres = KOUT; float* SS = (float*)(ws + WS_SS);
      pg8::EpiPle E{hres, hres, (pg8::bf16_t*)(ws + WS_HB), SS + (size_t)(4 * LI + 4) * T, SS + (size_t)(4 * LI + 3) * T, (const pg8::bf16_t*)(ws + WS_POOL + 176 * MiB)};
      GEMM_PHASE(pg8::EpiPle, ws + WS_HB, (bf16*)(ws + WS_WPG) + (size_t)LI * DM * DM, DM, DM, E); }
    SEAM();
}
__device__ __forceinline__ void retention_mixer(const Frame& F, cg::grid_group& grid) {
    { unsigned char* ws = KWS; pg8::EpiRetIn E{(pg8::bf16_t*)(ws + WS_POOL), (pg8::bf16_t*)(ws + WS_POOL + 64 * MiB), (pg8::bf16_t*)(ws + WS_POOL + 128 * MiB), (const float*)(ws + WS_SS) + T, (const float*)(ws + WS_ROPE)};
      GEMM_PHASE(pg8::EpiRetIn, ws + WS_HB, ws + WS_WRIN, 4096, DM, E); }
    SEAM();
    { unsigned char* ws = KWS; ret::ret_phase((LAS char*)F.lds, (const bf16*)(ws + WS_POOL), (const bf16*)(ws + WS_POOL + 64 * MiB), (bf16*)(ws + WS_POOL + 128 * MiB), (float*)(ws + WS_HSS), F.vcu); }
    SEAM();
    { unsigned char* ws = KWS; pg8::EpiRetGate E{(pg8::bf16_t*)(ws + WS_POOL + 128 * MiB), (const float*)(ws + WS_SS) + T, (const float*)(ws + WS_HSS), KIN(6)};
      GEMM_PHASE(pg8::EpiRetGate, ws + WS_HB, ws + WS_WRG, 2048, DM, E); }
    SEAM();
    { unsigned char* ws = KWS; float* hres = KOUT; pg8::EpiRes E{hres, hres, (pg8::bf16_t*)(ws + WS_HB), (float*)(ws + WS_SS) + 2 * (size_t)T, 1.0f};
      GEMM_PHASE(pg8::EpiRes, ws + WS_POOL + 128 * MiB, ws + WS_WRO, DM, 2048, E); }
    SEAM();
}
__device__ __forceinline__ void fox_mixer(const Frame& F, cg::grid_group& grid, unsigned char* lds_generic) {
    { unsigned char* ws = KWS; pg8::EpiPlain E{(pg8::bf16_t*)(ws + WS_POOL), DM, (const float*)(ws + WS_SS) + 5 * (size_t)T, DM, (size_t)(64 * MiB / 2), attn_body::C2};
      GEMM_PHASE(pg8::EpiPlain, ws + WS_HB, ws + WS_WFIN, 3072, DM, E); }
    { unsigned char* ws = KWS; const bf16* HB = (const bf16*)(ws + WS_HB); const bf16* WFZ = (const bf16*)(ws + WS_WFZ); float* LOGF = (float*)(ws + WS_LOGF); const float* ssm = (const float*)(ws + WS_SS) + 5 * (size_t)T; const float* fox_b_f = KIN(9);
      const int gw = F.vcu * NWAVES + F.wave, NGW = F.G * NWAVES;
      for (int task = gw; task < T / 16; task += NGW) {
        const int m16 = F.lane & 15, g = F.lane >> 4; f32x4 a4 = (f32x4){0.f, 0.f, 0.f, 0.f};
        const bf16* ar = HB + (size_t)(16 * task + m16) * DM + 8 * g; const bf16* br = WFZ + (size_t)m16 * DM + 8 * g;
#pragma unroll 8
        for (int s = 0; s < 32; ++s) a4 = __builtin_amdgcn_mfma_f32_16x16x32_bf16(*(const bf16x8*)(ar + 32 * s), *(const bf16x8*)(br + 32 * s), a4, 0, 0, 0);
        const float bfh = fox_b_f[m16];
#pragma unroll
        for (int r = 0; r < 4; ++r) { const int t = 16 * task + 4 * g + r; const float z = a4[r] * pg8::rinv_of(ssm, t) + bfh;
            LOGF[(size_t)t * 16 + m16] = fminf(z, 0.f) - log1pf(__expf(-fabsf(z))); } } }
    SEAM();
    {
        unsigned char* ws = KWS; const float* LOGF = (const float*)(ws + WS_LOGF);
        const int bh = F.vcu >> 1, b = bh >> 4, h = bh & 15; LAS float* nb = (LAS float*)(F.lds + attn_body::LDS_NB); LAS float* wtot = (LAS float*)(F.lds + attn_body::LDS_WS);
        float v[8]; float run = 0.f;
#pragma unroll
        for (int q = 0; q < 8; ++q) { run += LOGF[((size_t)b * SEQ + 8 * F.tid + q) * 16 + h]; v[q] = run; }
        float incl = run;
#pragma unroll
        for (int o = 1; o < 64; o <<= 1) { const float y = __shfl_up(incl, o); if (F.lane >= o) incl += y; }
        if (F.lane == 63) wtot[F.wave] = incl;
        __syncthreads();
        float off = incl - run;
        for (int w2 = 0; w2 < F.wave; ++w2) off += wtot[w2];
#pragma unroll
        for (int q = 0; q < 8; ++q) nb[8 * F.tid + q] = -(off + v[q]) * 1.4426950408889634f;
        __syncthreads();
        const attn_body::bf16* FQ = (const attn_body::bf16*)(ws + WS_POOL);
        const attn_body::AttnTensors AT{FQ, FQ + (size_t)T * DM, FQ + (size_t)2 * T * DM, (attn_body::bf16*)FQ};
        const attn_body::StaticOrder S((int)F.G, (int)blockIdx.x);
        attn_body::attn_phase<attn_body::StaticOrder>((char*)lds_generic, AT, S);
    }
    SEAM();
    { unsigned char* ws = KWS; float* hres = KOUT; pg8::EpiRes E{hres, hres, (pg8::bf16_t*)(ws + WS_HB), (float*)(ws + WS_SS) + 6 * (size_t)T, 1.0f};
      GEMM_PHASE(pg8::EpiRes, ws + WS_POOL, ws + WS_WFO, DM, DM, E); }
    SEAM();
}

__global__ void __launch_bounds__(NWAVES * 64, 2) hybrid_fwd(Args args) {
    extern __shared__ __attribute__((aligned(16))) unsigned char lds[];
    cg::grid_group grid = cg::this_grid();
    Frame F; F.lds = (LAS unsigned char*)lds; F.tid = threadIdx.x; F.lane = F.tid & 63; F.wave = __builtin_amdgcn_readfirstlane(F.tid >> 6);
    F.G = gridDim.x; { const int bx = blockIdx.x; F.vcu = (F.G % 8 == 0) ? (bx % 8) * (F.G / 8) + bx / 8 : bx; }
    if (F.tid < 64) ((LAS unsigned*)(F.lds + RING_BYTES))[F.tid] = 0u;
    __syncthreads();
    (void)xcd_barrier_post((unsigned*)(KWS + WS_BAR), (volatile LAS unsigned*)(F.lds + RING_BYTES) + 8);
    p0_prologue(F);
    grid.sync();
#ifdef PROBE_P0
    p0_prologue(F);
    SEAM();
#endif
    ffn_half<0, 0, true, false>(F, grid);
    retention_mixer(F, grid);
    ffn_half<1, 2, false, true>(F, grid);
    ple_phase<0>(F, grid);
    ffn_half<2, 4, false, false>(F, grid);
    fox_mixer(F, grid, lds);
    ffn_half<3, 6, false, true>(F, grid);
    ple_phase<1>(F, grid);
#ifdef PROBE_SYNC
#pragma unroll 1
    for (int i_ = 0; i_ < PROBE_SYNC; ++i_) grid.sync();
#endif
    { float* hres = KOUT; const float* final_norm_w = KIN(13); const int gw = F.vcu * NWAVES + F.wave, NGW = F.G * NWAVES;
      for (int m = gw; m < T; m += NGW) {
        f32x4* xr = (f32x4*)(hres + (size_t)m * DM) + F.lane; const f32x4* wr = (const f32x4*)final_norm_w + F.lane; f32x4 v[4]; float s = 0.f;
#pragma unroll
        for (int j = 0; j < 4; ++j) { v[j] = xr[64 * j]; s += (v[j].x * v[j].x + v[j].y * v[j].y) + (v[j].z * v[j].z + v[j].w * v[j].w); }
        const float ri = 1.0f / sqrtf(wave_sum(s) * (1.0f / DM) + 1e-6f);
#pragma unroll
        for (int j = 0; j < 4; ++j) xr[64 * j] = v[j] * ri * wr[64 * j];
      } }
}

extern "C" void kernel_launch(void* const* d_in, const int* in_sizes, int n_in, void* d_out, int out_size, void* d_ws, size_t ws_size, hipStream_t stream) {
    static int grid = 0;
    if (grid == 0) {
        if (n_in != 14 || out_size != T * DM || ws_size < WS_END) { fprintf(stderr, "kernel_launch: unexpected shapes (n_in %d out %d ws %zu)\n", n_in, out_size, ws_size); grid = -1; return; }
        int dev = 0, cus = 0, per_cu = 0;
        if (hipGetDevice(&dev) != hipSuccess || hipDeviceGetAttribute(&cus, hipDeviceAttributeMultiprocessorCount, dev) != hipSuccess) { grid = -1; return; }
        if (hipFuncSetAttribute((const void*)hybrid_fwd, hipFuncAttributeMaxDynamicSharedMemorySize, LDS_BYTES) != hipSuccess) { fprintf(stderr, "kernel_launch: hipFuncSetAttribute failed\n"); grid = -1; return; }
        if (hipOccupancyMaxActiveBlocksPerMultiprocessor(&per_cu, (const void*)hybrid_fwd, NWAVES * 64, LDS_BYTES) != hipSuccess || per_cu < 1) { fprintf(stderr, "kernel_launch: occupancy query says %d\n", per_cu); per_cu = 1; }
        (void)hipGetLastError();
        grid = cus * 1;
    }
    if (grid < 0) return;
    if (hipMemsetAsync((char*)d_ws + WS_BAR, 0, 16384, stream) != hipSuccess) { fprintf(stderr, "kernel_launch: memset failed\n"); return; }
    Args a{};
    for (int i = 0; i < 14; ++i) a.in[i] = (const float*)d_in[i];
    a.out = (float*)d_out; a.ws = (unsigned char*)d_ws;
    void* kargs[] = {&a};
    hipError_t e = hipLaunchCooperativeKernel((const void*)hybrid_fwd, dim3(grid), dim3(NWAVES * 64), kargs, LDS_BYTES, stream);
    if (e != hipSuccess) fprintf(stderr, "cooperative launch failed: %s (grid %d)\n", hipGetErrorString(e), grid);
}
```

```cpp
#include <hip/hip_runtime.h>
#include <hip/hip_cooperative_groups.h>
#include <cstdio>
#include <cstdint>
namespace cg = cooperative_groups;
#define GAS __attribute__((address_space(1)))
#define LAS __attribute__((address_space(3)))
namespace pg8 {
#define PG8_LAS __attribute__((address_space(3)))
typedef unsigned short bf16_t;
typedef short bf16x8 __attribute__((ext_vector_type(8)));
typedef float f32x4 __attribute__((ext_vector_type(4)));
typedef unsigned u32x4 __attribute__((ext_vector_type(4)));
constexpr int BM = 256, BK = 64, HALF = 128, HTB = HALF * BK * 2  , STAGE_BYTES = 8 * HTB, NXCD = 8, WGM = 8;

__host__ __device__ __forceinline__ int lds_byte(int r, int c) { const int st = (r >> 4) * 2 + (c >> 5), rr = r & 15, cc = c & 31, ob = rr * 64 + cc * 2; return st * 1024 + (ob ^ (((ob >> 9) & 1) << 5)); }
__host__ __device__ __forceinline__ void stage_rc(int b, int& R, int& C) { const int st = b / 1024, sb = b % 1024, swz = sb ^ (((sb >> 9) & 1) << 5); R = (st >> 1) * 16 + swz / 64; C = (st & 1) * 32 + (swz % 64) / 2; }
__host__ __device__ __forceinline__ int perm32(int rho) { const int n = rho >> 4, i = rho & 15; return 8 * (i >> 2) + 4 * n + (i & 3); }

struct Unit { int pm, pn; };
struct Gemm { const bf16_t* A; const bf16_t* Bt; int M, N, K; };

struct StaticOrder {
    int nM, nN, nwg, G, c;
    __host__ __device__ void init(int M, int N, int G_, int c_) { nM = M / BM; nN = N / BM; nwg = nM * nN; G = G_; c = c_; }
    __host__ __device__ bool next(int i, Unit& u) const {
        const long L = (long)i * G + c; if (L >= nwg) return false;
        int wgid = (int)L; { const int q = nwg / NXCD, r = nwg % NXCD, xcd = wgid % NXCD, off = wgid / NXCD; wgid = (xcd < r ? xcd * (q + 1) : r * (q + 1) + (xcd - r) * q) + off; }
        const int nig = WGM * nN, gid = wgid / nig, fm = gid * WGM, gsz = (nM - fm) < WGM ? (nM - fm) : WGM;
        u.pm = fm + ((wgid % nig) % gsz); u.pn = (wgid % nig) / gsz; return true;
    }
    __device__ __forceinline__ void a_ready(const Unit&) const {}
    __device__ __forceinline__ void done(const Unit&) const {}
};
__device__ __forceinline__ unsigned cvt_pk_bf16(float lo, float hi) { unsigned r; asm volatile("v_cvt_pk_bf16_f32 %0, %1, %2" : "=v"(r) : "v"(lo), "v"(hi)); return r; }
__device__ __forceinline__ u32x4 pack8(const f32x4 v0, const f32x4 v1) { u32x4 w; w.x = cvt_pk_bf16(v0[0], v0[1]); w.y = cvt_pk_bf16(v0[2], v0[3]); w.z = cvt_pk_bf16(v1[0], v1[1]); w.w = cvt_pk_bf16(v1[2], v1[3]); return w; }
__device__ __forceinline__ float bflo(unsigned u) { return __uint_as_float(u << 16); }
__device__ __forceinline__ float bfhi(unsigned u) { return __uint_as_float(u & 0xffff0000u); }
__device__ __forceinline__ void unpack8(const u32x4 w, f32x4& v0, f32x4& v1) { v0 = (f32x4){bflo(w.x), bfhi(w.x), bflo(w.y), bfhi(w.y)}; v1 = (f32x4){bflo(w.z), bfhi(w.z), bflo(w.w), bfhi(w.w)}; }
__device__ __forceinline__ float sigm(float x) { return __builtin_amdgcn_rcpf(1.0f + __builtin_amdgcn_exp2f(-1.4426950408889634f * x)); }
__device__ __forceinline__ f32x4 silu4(const f32x4 x) { return (f32x4){x[0] * sigm(x[0]), x[1] * sigm(x[1]), x[2] * sigm(x[2]), x[3] * sigm(x[3])}; }
__device__ __forceinline__ f32x4 sigm4(const f32x4 x) { return (f32x4){sigm(x[0]), sigm(x[1]), sigm(x[2]), sigm(x[3])}; }
__device__ __forceinline__ float rinv_of(const float* ss, int r) { return 1.0f / sqrtf(ss[r] * (1.0f / 1024.0f) + 1e-6f); }
#define EPI_ARGS const f32x4 (&acc)[2][2][4][2], const Unit& u, int wr, int wc, int fr, int fq
#define EPI_ROWS(ai, m) (u.pm * BM + (ai) * HALF + wr * 64 + (m) * 16 + fr)

struct EpiSwiglu { static constexpr bool PERM = true, AFTER_DRAIN = false; bf16_t* act; const float* ss;
    __device__ __forceinline__ void operator()(EPI_ARGS) const {
        const int col0 = u.pn * HALF + wc * 32 + 8 * fq;
#pragma unroll
        for (int ai = 0; ai < 2; ++ai)
#pragma unroll
            for (int m = 0; m < 4; ++m) { const int r = EPI_ROWS(ai, m); const float ri = rinv_of(ss, r);
                const f32x4 a0 = silu4(acc[ai][0][m][0] * ri) * (acc[ai][1][m][0] * ri), a1 = silu4(acc[ai][0][m][1] * ri) * (acc[ai][1][m][1] * ri);
                *(u32x4*)(act + (size_t)r * 2816 + col0) = pack8(a0, a1); }
    }
};
struct EpiRes { static constexpr bool PERM = true, AFTER_DRAIN = false; const float* hin; float* hout; bf16_t* hb; float* ssn; float scale;
    __device__ __forceinline__ void operator()(EPI_ARGS) const {
#pragma unroll
        for (int ai = 0; ai < 2; ++ai)
#pragma unroll
            for (int m = 0; m < 4; ++m) { const int r = EPI_ROWS(ai, m); float sq = 0.f;
#pragma unroll
                for (int bj = 0; bj < 2; ++bj) { const size_t off = (size_t)r * 1024 + u.pn * BM + bj * HALF + wc * 32 + 8 * fq;
                    const f32x4 v0 = *(const f32x4*)(hin + off) + acc[ai][bj][m][0] * scale, v1 = *(const f32x4*)(hin + off + 4) + acc[ai][bj][m][1] * scale;
                    *(f32x4*)(hout + off) = v0; *(f32x4*)(hout + off + 4) = v1; *(u32x4*)(hb + off) = pack8(v0, v1);
                    sq += (v0[0] * v0[0] + v0[1] * v0[1]) + (v0[2] * v0[2] + v0[3] * v0[3]) + (v1[0] * v1[0] + v1[1] * v1[1]) + (v1[2] * v1[2] + v1[3] * v1[3]); }
                sq += __shfl_xor(sq, 16); sq += __shfl_xor(sq, 32); if (fq == 0) atomicAdd(ssn + r, sq); }
    }
};
struct EpiPle { static constexpr bool PERM = true, AFTER_DRAIN = false; const float* hin; float* hout; bf16_t* hb; float* ssn; const float* ss; const bf16_t* pp;
    __device__ __forceinline__ void operator()(EPI_ARGS) const {
#pragma unroll
        for (int ai = 0; ai < 2; ++ai)
#pragma unroll
            for (int m = 0; m < 4; ++m) { const int r = EPI_ROWS(ai, m); const float ri = rinv_of(ss, r); float sq = 0.f;
#pragma unroll
                for (int bj = 0; bj < 2; ++bj) { const size_t off = (size_t)r * 1024 + u.pn * BM + bj * HALF + wc * 32 + 8 * fq;
                    f32x4 p0, p1; unpack8(*(const u32x4*)(pp + off), p0, p1);
                    const f32x4 v0 = *(const f32x4*)(hin + off) + sigm4(acc[ai][bj][m][0] * ri) * p0, v1 = *(const f32x4*)(hin + off + 4) + sigm4(acc[ai][bj][m][1] * ri) * p1;
                    *(f32x4*)(hout + off) = v0; *(f32x4*)(hout + off + 4) = v1; *(u32x4*)(hb + off) = pack8(v0, v1);
                    sq += (v0[0] * v0[0] + v0[1] * v0[1]) + (v0[2] * v0[2] + v0[3] * v0[3]) + (v1[0] * v1[0] + v1[1] * v1[1]) + (v1[2] * v1[2] + v1[3] * v1[3]); }
                sq += __shfl_xor(sq, 16); sq += __shfl_xor(sq, 32); if (fq == 0) atomicAdd(ssn + r, sq); }
    }
};
struct EpiPlain { static constexpr bool PERM = true, AFTER_DRAIN = false; bf16_t* O; int ldc; const float* ss; int split_cols; size_t split_stride; float scale0;
    __device__ __forceinline__ void operator()(EPI_ARGS) const {
        int colt = u.pn * BM; bf16_t* base = O; float sc = 1.f;
        if (split_cols) { const int t = colt / split_cols; base += (size_t)t * split_stride; colt -= t * split_cols; if (t == 0) sc = scale0; }
        const int col0 = colt + wc * 32 + 8 * fq;
#pragma unroll
        for (int ai = 0; ai < 2; ++ai)
#pragma unroll
            for (int m = 0; m < 4; ++m) { const int r = EPI_ROWS(ai, m); const float ri = (ss ? rinv_of(ss, r) : 1.0f) * sc;
#pragma unroll
                for (int bj = 0; bj < 2; ++bj) *(u32x4*)(base + (size_t)r * ldc + col0 + bj * HALF) = pack8(acc[ai][bj][m][0] * ri, acc[ai][bj][m][1] * ri); }
    }
};
struct EpiRetIn { static constexpr bool PERM = true, AFTER_DRAIN = false; bf16_t* Qt; bf16_t* Kt; bf16_t* V; const float* ss; const float* rope  ;
    __device__ __forceinline__ void operator()(EPI_ARGS) const {
        const int pn = u.pn;
        if (pn >= 8) {
            const int col0 = (pn - 8) * BM + wc * 32 + 8 * fq;
#pragma unroll
            for (int ai = 0; ai < 2; ++ai)
#pragma unroll
                for (int m = 0; m < 4; ++m) { const int r = EPI_ROWS(ai, m); const float ri = rinv_of(ss, r);
#pragma unroll
                    for (int bj = 0; bj < 2; ++bj) *(u32x4*)(V + (size_t)r * 2048 + col0 + bj * HALF) = pack8(acc[ai][bj][m][0] * ri, acc[ai][bj][m][1] * ri); }
            return;
        }
        const bool isk = pn >= 4; const int hd = pn & 3; bf16_t* outp = isk ? Kt : Qt;
        const float lg = log2f(1.0f - exp2f(-5.0f - (float)hd));
        const int j0 = wc * 32 + 8 * fq;
#pragma unroll
        for (int ai = 0; ai < 2; ++ai)
#pragma unroll
            for (int m = 0; m < 4; ++m) { const int r = EPI_ROWS(ai, m); const int pos = r & 4095; const float e1 = (float)((pos & 63) + 1) * lg;
                const float f = rinv_of(ss, r) * (isk ? 0.0625f * exp2f(-e1) : exp2f(e1));
                const f32x4* cs = (const f32x4*)(rope + ((size_t)pos * 128 + j0) * 2);
                const f32x4 c01 = cs[0], c23 = cs[1], c45 = cs[2], c67 = cs[3];
                const f32x4 x10 = acc[ai][0][m][0] * f, x11 = acc[ai][0][m][1] * f, x20 = acc[ai][1][m][0] * f, x21 = acc[ai][1][m][1] * f;
                const f32x4 cc0 = (f32x4){c01[0], c01[2], c23[0], c23[2]}, sn0 = (f32x4){c01[1], c01[3], c23[1], c23[3]};
                const f32x4 cc1 = (f32x4){c45[0], c45[2], c67[0], c67[2]}, sn1 = (f32x4){c45[1], c45[3], c67[1], c67[3]};
                const f32x4 y10 = x10 * cc0 - x20 * sn0, y11 = x11 * cc1 - x21 * sn1, y20 = x10 * sn0 + x20 * cc0, y21 = x11 * sn1 + x21 * cc1;
                bf16_t* rowp = outp + (size_t)r * 1024 + hd * 256 + j0;
                *(u32x4*)(rowp) = pack8(y10, y11); *(u32x4*)(rowp + HALF) = pack8(y20, y21); }
    }
};
struct EpiRetGate { static constexpr bool PERM = true, AFTER_DRAIN = false; bf16_t* Y; const float* ss; const float* hss; const float* gnw;
    __device__ __forceinline__ void operator()(EPI_ARGS) const {
        const int hd = u.pn >> 1;
#pragma unroll
        for (int ai = 0; ai < 2; ++ai)
#pragma unroll
            for (int m = 0; m < 4; ++m) { const int r = EPI_ROWS(ai, m); const float ri = rinv_of(ss, r); const float hr = 1.0f / sqrtf(hss[(size_t)r * 4 + hd] * (1.0f / 512.0f) + 1e-6f);
#pragma unroll
                for (int bj = 0; bj < 2; ++bj) { const int c = u.pn * BM + bj * HALF + wc * 32 + 8 * fq; bf16_t* p = Y + (size_t)r * 2048 + c;
                    f32x4 o0, o1; unpack8(*(const u32x4*)p, o0, o1);
                    const f32x4 g0 = *(const f32x4*)(gnw + c) * hr, g1 = *(const f32x4*)(gnw + c + 4) * hr;
                    *(u32x4*)p = pack8(silu4(acc[ai][bj][m][0] * ri) * o0 * g0, silu4(acc[ai][bj][m][1] * ri) * o1 * g1); }
            }
    }
};
template <class Epi, class Sched, bool ALIGN_EPI = false, bool SP2 = false>
__device__ __forceinline__ void gemm_phase(PG8_LAS unsigned char* lds, const Gemm g, const Sched& S, const Epi& E) {
    int tid_ = threadIdx.x; asm volatile("" : "+v"(tid_));
    const int tid = tid_, wid = __builtin_amdgcn_readfirstlane(tid >> 6), lane = tid & 63, wr = wid >> 2, wc = wid & 3, fr = lane & 15, fq = lane >> 4;
    const int K = g.K, nt = K / BK;
    unsigned voffA[2], voffB[2];
#pragma unroll
    for (int i = 0; i < 2; ++i) { int R, C; stage_rc(tid * 16 + i * 8192, R, C); const int Rb = Epi::PERM ? ((R & ~31) + perm32(R & 31)) : R;
        voffA[i] = (unsigned)(R * K + C) * 2u; voffB[i] = (unsigned)(Rb * K + C) * 2u; }
    const size_t kstep = (size_t)(BK * 2);
    const size_t hstep = (size_t)HALF * K * 2;
    const size_t tstep = 2 * hstep;
    const unsigned ldsw = (unsigned)wid * 1024u;
    const int aoff = lds_byte(wr * 64 + fr, fq * 8), boff = lds_byte(wc * 32 + fr, fq * 8);
#define PG8_SA(b, h) (((b) * 2 + (h)) * HTB)
#define PG8_SB(b, h) ((4 + (b) * 2 + (h)) * HTB)
#define PG8_STAGE(bufoff, gbase, voff) do { _Pragma("unroll") for (int _i = 0; _i < 2; ++_i) \
        __builtin_amdgcn_global_load_lds((const unsigned*)((const char*)(gbase) + (voff)[_i]), (PG8_LAS unsigned*)(lds + (bufoff) + ldsw + _i * 8192), 16, 0, 0); } while (0)
#define PG8_LDA(dst, b, h) do { _Pragma("unroll") for (int m = 0; m < 4; ++m) _Pragma("unroll") for (int k = 0; k < 2; ++k) dst[m][k] = *(const PG8_LAS bf16x8*)(lds + PG8_SA(b, h) + aoff + m * 2048 + k * 1024); } while (0)
#define PG8_LDB(dst, b, h) do { _Pragma("unroll") for (int n = 0; n < 2; ++n) _Pragma("unroll") for (int k = 0; k < 2; ++k) dst[n][k] = *(const PG8_LAS bf16x8*)(lds + PG8_SB(b, h) + boff + n * 2048 + k * 1024); } while (0)
#define PG8_MMA(ai, bj, At, Bt) do { __builtin_amdgcn_s_setprio(1); _Pragma("unroll") for (int m = 0; m < 4; ++m) _Pragma("unroll") for (int n = 0; n < 2; ++n) _Pragma("unroll") for (int k = 0; k < 2; ++k) \
        acc[ai][bj][m][n] = __builtin_amdgcn_mfma_f32_16x16x32_bf16(Bt[n][k], At[m][k], acc[ai][bj][m][n], 0, 0, 0); __builtin_amdgcn_s_setprio(0); } while (0)
#define PG8_WAIT_V(n) asm volatile("s_waitcnt vmcnt(" #n ")" ::: "memory")
#define PG8_WAIT_L(n) asm volatile("s_waitcnt lgkmcnt(" #n ")" ::: "memory")
#define PG8_BAR __builtin_amdgcn_s_barrier()
#define PG8_SCHED __builtin_amdgcn_sched_barrier(0)
    Unit cur, nxt; int ui = 0;
    if (!S.next(0, cur)) return;
    f32x4 acc[2][2][4][2];
#pragma unroll
    for (int a = 0; a < 2; ++a)
#pragma unroll
        for (int b = 0; b < 2; ++b)
#pragma unroll
            for (int m = 0; m < 4; ++m)
#pragma unroll
                for (int n = 0; n < 2; ++n) acc[a][b][m][n] = (f32x4){0.f, 0.f, 0.f, 0.f};
    bf16x8 At[4][2], B0[2][2], B1[2][2];
    const char* cA = (const char*)g.A + (size_t)cur.pm * tstep; const char* cB = (const char*)g.Bt + (size_t)cur.pn * tstep;
    S.a_ready(cur);
    if constexpr (SP2) {
        PG8_STAGE(PG8_SB(0, 0), cB, voffB); PG8_STAGE(PG8_SB(0, 1), cB + hstep, voffB); PG8_STAGE(PG8_SA(0, 0), cA, voffA); PG8_STAGE(PG8_SA(0, 1), cA + hstep, voffA);
        if (wr == 1) PG8_BAR;
        PG8_WAIT_V(2); PG8_BAR;
        PG8_STAGE(PG8_SB(1, 0), cB + kstep, voffB); PG8_STAGE(PG8_SA(1, 0), cA + kstep, voffA); PG8_STAGE(PG8_SB(1, 1), cB + hstep + kstep, voffB);
        PG8_WAIT_V(6); PG8_BAR;
    } else {
        PG8_STAGE(PG8_SB(0, 0), cB, voffB); PG8_STAGE(PG8_SA(0, 0), cA, voffA); PG8_STAGE(PG8_SB(0, 1), cB + hstep, voffB); PG8_STAGE(PG8_SA(0, 1), cA + hstep, voffA);
        if (wr == 1) PG8_BAR;
        PG8_WAIT_V(4); PG8_BAR;
        PG8_STAGE(PG8_SB(1, 0), cB + kstep, voffB); PG8_STAGE(PG8_SA(1, 0), cA + kstep, voffA); PG8_STAGE(PG8_SB(1, 1), cB + hstep + kstep, voffB);
        PG8_WAIT_V(6); PG8_BAR;
    }
    for (;;) {
        const bool has_next = S.next(ui + 1, nxt);
        const char* nA = has_next ? (const char*)g.A + (size_t)nxt.pm * tstep : cA; const char* nB = has_next ? (const char*)g.Bt + (size_t)nxt.pn * tstep : cB;
        for (int t = 0; t < nt; t += 2) {
            const bool last = (t == nt - 2);
            const char* a1 = cA + (size_t)(t + 1) * kstep;
            const char* a2 = last ? nA : cA + (size_t)(t + 2) * kstep; const char* b2 = last ? nB : cB + (size_t)(t + 2) * kstep;
            const char* a3 = a2 + kstep; const char* b3 = b2 + kstep;
            if (last && has_next) S.a_ready(nxt);
            if constexpr (SP2) {
            PG8_LDB(B0, 0, 0); PG8_LDB(B1, 0, 1); PG8_SCHED; PG8_LDA(At, 0, 0); PG8_STAGE(PG8_SA(1, 1), a1 + hstep, voffA);
            PG8_WAIT_V(8); PG8_WAIT_L(0); PG8_BAR; PG8_MMA(0, 0, At, B0); PG8_MMA(0, 1, At, B1); PG8_BAR; PG8_SCHED;
            PG8_LDA(At, 0, 1); PG8_STAGE(PG8_SB(0, 0), b2, voffB); PG8_STAGE(PG8_SB(0, 1), b2 + hstep, voffB); PG8_STAGE(PG8_SA(0, 0), a2, voffA);
            PG8_WAIT_V(8); PG8_WAIT_L(0); PG8_BAR; PG8_MMA(1, 0, At, B0); PG8_MMA(1, 1, At, B1); PG8_BAR; PG8_SCHED;
            PG8_LDB(B0, 1, 0); PG8_LDB(B1, 1, 1); PG8_SCHED; PG8_LDA(At, 1, 0); PG8_STAGE(PG8_SA(0, 1), a2 + hstep, voffA);
            PG8_WAIT_V(8); PG8_WAIT_L(0); PG8_BAR; PG8_MMA(0, 0, At, B0); PG8_MMA(0, 1, At, B1); PG8_BAR; PG8_SCHED;
            PG8_LDA(At, 1, 1); PG8_STAGE(PG8_SB(1, 0), b3, voffB); PG8_STAGE(PG8_SB(1, 1), b3 + hstep, voffB); PG8_STAGE(PG8_SA(1, 0), a3, voffA);
            PG8_WAIT_V(8); PG8_WAIT_L(0); PG8_BAR; PG8_MMA(1, 0, At, B0); PG8_MMA(1, 1, At, B1); PG8_BAR; PG8_SCHED;
            } else {
            PG8_LDB(B0, 0, 0); PG8_SCHED; PG8_LDA(At, 0, 0); PG8_STAGE(PG8_SA(1, 1), a1 + hstep, voffA);
            PG8_WAIT_L(8); PG8_BAR; PG8_WAIT_L(0); PG8_MMA(0, 0, At, B0); PG8_BAR; PG8_SCHED;
            PG8_LDB(B1, 0, 1); PG8_STAGE(PG8_SB(0, 0), b2, voffB);
            PG8_BAR; PG8_WAIT_L(0); PG8_MMA(0, 1, At, B1); PG8_BAR;
            PG8_LDA(At, 0, 1); PG8_STAGE(PG8_SA(0, 0), a2, voffA);
            PG8_BAR; PG8_WAIT_L(0); PG8_MMA(1, 0, At, B0); PG8_BAR; PG8_SCHED;
            PG8_STAGE(PG8_SB(0, 1), b2 + hstep, voffB);
            PG8_WAIT_V(6); PG8_BAR; PG8_MMA(1, 1, At, B1); PG8_BAR;
            PG8_LDB(B0, 1, 0); PG8_SCHED; PG8_LDA(At, 1, 0); PG8_STAGE(PG8_SA(0, 1), a2 + hstep, voffA);
            PG8_WAIT_L(8); PG8_BAR; PG8_WAIT_L(0); PG8_MMA(0, 0, At, B0); PG8_BAR; PG8_SCHED;
            PG8_LDB(B1, 1, 1); PG8_STAGE(PG8_SB(1, 0), b3, voffB);
            PG8_BAR; PG8_WAIT_L(0); PG8_MMA(0, 1, At, B1); PG8_BAR;
            PG8_LDA(At, 1, 1); PG8_STAGE(PG8_SA(1, 0), a3, voffA);
            PG8_BAR; PG8_WAIT_L(0); PG8_MMA(1, 0, At, B0); PG8_BAR; PG8_SCHED;
            PG8_STAGE(PG8_SB(1, 1), b3 + hstep, voffB);
            PG8_WAIT_V(6); PG8_BAR; PG8_MMA(1, 1, At, B1); PG8_BAR;
            }
        }
        if constexpr (ALIGN_EPI) { if (wr == 0) PG8_BAR; }
        if constexpr (!Epi::AFTER_DRAIN) { E(acc, cur, wr, wc, fr, fq); S.done(cur); }
        if (!has_next) break;
#pragma unroll
        for (int a = 0; a < 2; ++a)
#pragma unroll
            for (int b = 0; b < 2; ++b)
#pragma unroll
                for (int m = 0; m < 4; ++m)
#pragma unroll
                    for (int n = 0; n < 2; ++n) acc[a][b][m][n] = (f32x4){0.f, 0.f, 0.f, 0.f};
        cur = nxt; cA = nA; cB = nB; ++ui;
        if constexpr (ALIGN_EPI) { if (wr == 1) PG8_BAR; }
    }
    PG8_WAIT_V(0);
    if constexpr (!ALIGN_EPI) { if (wr == 0) PG8_BAR; }
    PG8_BAR;
    if constexpr (Epi::AFTER_DRAIN) { E.fused(acc, cur, wr, wc, fr, fq, lds, wid, lane); S.done(cur); }
#undef PG8_SA
#undef PG8_SB
#undef PG8_STAGE
#undef PG8_LDA
#undef PG8_LDB
#undef PG8_MMA
#undef PG8_WAIT_V
#undef PG8_WAIT_L
#undef PG8_BAR
#undef PG8_SCHED
}
}
#include <hip/hip_bf16.h>
#include <cmath>
namespace attn_body {
using bf16=__hip_bfloat16;
using bf16x8=__attribute__((ext_vector_type(8)))short;
using s16x4=__attribute__((ext_vector_type(4)))short;
using f32x16=__attribute__((ext_vector_type(16)))float;
using u32x4=__attribute__((ext_vector_type(4)))unsigned;
constexpr int BATCH=8,NHEAD=16,SEQ=4096,D=64,DM=NHEAD*D;
constexpr int NW=8,QBLK=32,QB=QBLK*NW,KVBLK=64,NQB=SEQ/QB;
constexpr int ATTN_PITCH=DM, ATTN_UNIT_ROWS=QB;
__device__ __forceinline__ int crow(int r,int hi){return (r&3)+8*(r>>2)+4*hi;}
#define SBAR() __builtin_amdgcn_sched_barrier(0)
__device__ __forceinline__ void cmask(f32x16&p0,f32x16&p1,int jb,int qrel,int hi){
  const float NEG=-INFINITY; int kb=64*jb+4*hi;
  #pragma unroll
  for(int r=0;r<16;++r){int kv=kb+(r&3)+8*(r>>2); if(kv>qrel)p0[r]=NEG; if(kv+32>qrel)p1[r]=NEG;}
}

constexpr int NSLOT=3, SLOTB=8192;
typedef float f32x4_t __attribute__((ext_vector_type(4)));
constexpr int LDS_K=0, LDS_V=NSLOT*SLOTB, LDS_WS=2*NSLOT*SLOTB, LDS_OST=LDS_WS+NW*64*4, LDS_NB=LDS_OST+NW*4096, LDS_BYTES=LDS_NB+SEQ*4;
constexpr float C2=0.125f*1.4426950408889634f;
__device__ __forceinline__ void glds16(const void*gsrc,unsigned lds_dst){unsigned keep;
  asm volatile("s_mov_b32 %0, m0\n\ts_mov_b32 m0, %2\n\ts_nop 0\n\tglobal_load_lds_dwordx4 %1, off\n\ts_mov_b32 m0, %0":"=&s"(keep):"v"(gsrc),"s"(lds_dst):"memory");}
__device__ __forceinline__ float max3f(float a,float b,float c){float r;asm("v_max3_f32 %0, %1, %2, %3":"=v"(r):"v"(a),"v"(b),"v"(c));return r;}
__device__ __forceinline__ float max2f(float a,float b){float r;asm("v_max_f32_e32 %0, %1, %2":"=v"(r):"v"(a),"v"(b));return r;}
__device__ __forceinline__ float fadd_s(float a,float b){float r;asm("v_add_f32_e32 %0, %1, %2":"=v"(r):"v"(a),"v"(b));return r;}
__device__ __forceinline__ float fsub_s(float a,float b){float r;asm("v_sub_f32_e32 %0, %1, %2":"=v"(r):"v"(a),"v"(b));return r;}
typedef float f32x2_t __attribute__((ext_vector_type(2))); typedef __bf16 bf16x2_t __attribute__((ext_vector_type(2)));
__device__ __forceinline__ unsigned cvtpk_s(float lo,float hi){f32x2_t v={lo,hi};bf16x2_t b=__builtin_convertvector(v,bf16x2_t);return __builtin_bit_cast(unsigned,b);}
#define WAIT_BAR(N) asm volatile("s_waitcnt vmcnt(" #N ") lgkmcnt(0)\n\ts_barrier":::"memory")

__device__ __forceinline__ void qkt(f32x16&p0,f32x16&p1,const char*Kslot,const bf16x8*qr,int r32,int hi){
  const char*kb=Kslot+hi*1024+r32*16;
  #pragma unroll
  for(int d0=0;d0<4;++d0){
    const bf16x8 b0=*reinterpret_cast<const bf16x8*>(kb+d0*2048);
    const bf16x8 b1=*reinterpret_cast<const bf16x8*>(kb+d0*2048+512);
    p0=__builtin_amdgcn_mfma_f32_32x32x16_bf16(b0,qr[d0],p0,0,0,0);p1=__builtin_amdgcn_mfma_f32_32x32x16_bf16(b1,qr[d0],p1,0,0,0);}
}
typedef __attribute__((address_space(3))) const char* lds_cptr;
typedef short v4i16_t __attribute__((ext_vector_type(4)));
__device__ __forceinline__ void kload8(bf16x8*kf,lds_cptr kp){
  kf[0]=*(const __attribute__((address_space(3))) bf16x8*)(kp);      kf[1]=*(const __attribute__((address_space(3))) bf16x8*)(kp+512);
  kf[2]=*(const __attribute__((address_space(3))) bf16x8*)(kp+2048); kf[3]=*(const __attribute__((address_space(3))) bf16x8*)(kp+2560);
  kf[4]=*(const __attribute__((address_space(3))) bf16x8*)(kp+4096); kf[5]=*(const __attribute__((address_space(3))) bf16x8*)(kp+4608);
  kf[6]=*(const __attribute__((address_space(3))) bf16x8*)(kp+6144); kf[7]=*(const __attribute__((address_space(3))) bf16x8*)(kp+6656);
}
__device__ __forceinline__ void kload2(bf16x8*kf,lds_cptr kp,int j){ kf[2*j]=*(const __attribute__((address_space(3))) bf16x8*)(kp+j*2048); kf[2*j+1]=*(const __attribute__((address_space(3))) bf16x8*)(kp+j*2048+512); }
__device__ __forceinline__ s16x4 vtr(lds_cptr p){ return __builtin_bit_cast(s16x4,__builtin_amdgcn_ds_read_tr16_b64_v4i16((__attribute__((address_space(3))) v4i16_t*)p)); }
__device__ __forceinline__ float rowmax(const f32x16&p0,const f32x16&p1){
  float a=max3f(p0[0],p0[1],p1[0]),b=max3f(p0[2],p0[3],p1[1]);a=max3f(a,p1[2],p1[3]);
  #pragma unroll
  for(int r=4;r<16;r+=4){a=max3f(a,p0[r],p0[r+1]);b=max3f(b,p0[r+2],p0[r+3]);a=max3f(a,p1[r],p1[r+1]);b=max3f(b,p1[r+2],p1[r+3]);}
  const float m=max2f(a,b);
  auto rr=__builtin_amdgcn_permlane32_swap(__float_as_uint(m),__float_as_uint(m),false,false);
  return max2f(__uint_as_float(rr[0]),__uint_as_float(rr[1]));
}
__device__ __forceinline__ void pv(f32x16*o,int vb,bf16x8 pa0,bf16x8 pa1,bf16x8 pa2,bf16x8 pa3){
  #pragma unroll
  for(int d0=0;d0<2;++d0){s16x4 lo[4],hi[4];
    #pragma unroll
    for(int ks=0;ks<4;++ks){
      asm volatile("ds_read_b64_tr_b16 %0,%1 offset:%c2":"=&v"(lo[ks]):"v"(vb),"i"(d0*4096+ks*1024):"memory");
      asm volatile("ds_read_b64_tr_b16 %0,%1 offset:%c2":"=&v"(hi[ks]):"v"(vb),"i"(d0*4096+ks*1024+512):"memory");}
    asm volatile("s_waitcnt lgkmcnt(0)":::"memory");SBAR();
    #define PK(k) (bf16x8){lo[k][0],lo[k][1],lo[k][2],lo[k][3],hi[k][0],hi[k][1],hi[k][2],hi[k][3]}
    o[d0]=__builtin_amdgcn_mfma_f32_32x32x16_bf16(pa0,PK(0),o[d0],0,0,0);
    o[d0]=__builtin_amdgcn_mfma_f32_32x32x16_bf16(pa1,PK(1),o[d0],0,0,0);
    o[d0]=__builtin_amdgcn_mfma_f32_32x32x16_bf16(pa2,PK(2),o[d0],0,0,0);
    o[d0]=__builtin_amdgcn_mfma_f32_32x32x16_bf16(pa3,PK(3),o[d0],0,0,0);
    #undef PK
  }
}

#ifndef ATTN_STORE16
#define ATTN_STORE16(p,v) (*(u32x4*)(p)=(v))
#endif
template<int THRL> __device__ __forceinline__ void attn_unit(int b,int h,int qb,const bf16*Q,const bf16*__restrict__ K,const bf16*__restrict__ V,bf16*O,char*shm){
  const __attribute__((address_space(3))) float* nbp=(const __attribute__((address_space(3))) float*)(lds_cptr)(shm+LDS_NB);
  #define BIASC(C0,C1,t) do{ const __attribute__((address_space(3))) float* bp_=nbp+(t)*64+4*hi; \
    _Pragma("unroll") for(int g_=0;g_<4;++g_){ const f32x4_t a_=*(const __attribute__((address_space(3))) f32x4_t*)(bp_+8*g_); const f32x4_t b_=*(const __attribute__((address_space(3))) f32x4_t*)(bp_+32+8*g_); \
      C0[4*g_]=a_[0]-mhat;C0[4*g_+1]=a_[1]-mhat;C0[4*g_+2]=a_[2]-mhat;C0[4*g_+3]=a_[3]-mhat; C1[4*g_]=b_[0]-mhat;C1[4*g_+1]=b_[1]-mhat;C1[4*g_+2]=b_[2]-mhat;C1[4*g_+3]=b_[3]-mhat; } }while(0)

  int tid_=threadIdx.x; asm volatile("":"+v"(tid_)); const int tid=tid_,lane=tid&63,r32=lane&31,hi=lane>>5; const int wid=__builtin_amdgcn_readfirstlane(tid>>6);
  const long rowbase=(long)b*SEQ; const int q0=qb*QB;
  const bf16*Qw=Q+(rowbase+q0+wid*QBLK)*DM+h*D;
  const bf16*Kh=K+rowbase*DM+h*D,*Vh=V+rowbase*DM+h*D;
  const unsigned lds0=(unsigned)(uintptr_t)shm;
  float*wsf=(float*)(shm+LDS_WS)+wid*64;
  const bf16*ksrc=Kh+(long)lane*DM+wid*8;
  const bf16*vsrc=Vh+(long)(16*(wid&3)+(lane>>2))*DM+(wid>>2)*32+(lane&3)*8;
  const unsigned kdst=lds0+LDS_K+wid*1024, vdst=lds0+LDS_V+wid*1024;
  #define DMA_K(t,slot) glds16(ksrc+(long)(t)*KVBLK*DM,(unsigned)__builtin_amdgcn_readfirstlane(kdst+(slot)))
  #define DMA_V(t,slot) glds16(vsrc+(long)(t)*KVBLK*DM,(unsigned)__builtin_amdgcn_readfirstlane(vdst+(slot)))
  const int vb0=(int)(lds0+LDS_V)+((lane>>4)&1)*32+(lane&3)*8+(4*hi+((lane&15)>>2))*64;
  const char*Kbase=shm+LDS_K; bf16x8 kf[8];
  const lds_cptr shm3=(lds_cptr)shm; const lds_cptr kp0=shm3+LDS_K+hi*1024+r32*16; const lds_cptr vp0=shm3+LDS_V+((lane>>4)&1)*32+(lane&3)*8+(4*hi+((lane&15)>>2))*64;
  const int NT=(q0+QB)/KVBLK;
  DMA_K(0,0);DMA_V(0,0);DMA_K(1,SLOTB);
  bf16x8 qr[4];
  #pragma unroll
  for(int d0=0;d0<4;++d0)qr[d0]=*reinterpret_cast<const bf16x8*>(&Qw[(long)r32*DM+d0*16+hi*8]);
  float mhat=0.f,l_reg=0.f;f32x16 o[2];o[0]=f32x16{};o[1]=f32x16{};
  const int qrel=wid*QBLK+r32;
  #define CMASK(P0,P1,t) do{int jb_=(t)-(NT-4); if(jb_>=0)cmask(P0,P1,jb_,qrel,hi);}while(0)
  bool resc=false;
  #define START(P0,P1) do{ const float rm=rowmax(P0,P1); resc=false; \
    { const float dl=rm; mhat=fadd_s(mhat,dl); \
      _Pragma("unroll") for(int r=0;r<16;++r){P0[r]=fsub_s(P0[r],dl);P1[r]=fsub_s(P1[r],dl);} \
      } \
    _Pragma("unroll") for(int r=0;r<16;++r)P0[r]=__builtin_amdgcn_exp2f(P0[r]); }while(0)
  #define RESC() do{ if(resc){ asm volatile("s_waitcnt lgkmcnt(0)":::"memory"); \
      _Pragma("unroll") for(int d_=0;d_<2;++d_) _Pragma("unroll") for(int r=0;r<16;++r)o[d_][r]*=wsf[crow(r,hi)]; } }while(0)
  f32x16 pA0,pA1,pB0,pB1;
  int sl_prev=0,sl_cur=0,sl_next=SLOTB;
  #define ROT() do{sl_prev=sl_cur;sl_cur=sl_next;sl_next=(sl_next==(NSLOT-1)*SLOTB)?0:sl_next+SLOTB;}while(0)
  DMA_K(2,2*SLOTB);
  WAIT_BAR(3);
  BIASC(pA0,pA1,0); qkt(pA0,pA1,Kbase,qr,r32,hi);asm volatile("s_nop 15\n\ts_nop 7":"+v"(pA0),"+v"(pA1));CMASK(pA0,pA1,0);
  START(pA0,pA1);
  _Pragma("unroll") for(int r=0;r<16;++r)pA1[r]=__builtin_amdgcn_exp2f(pA1[r]);
  WAIT_BAR(0);
  DMA_K(3,0);DMA_V(1,SLOTB);
  ROT();
  kload8(kf,kp0+sl_cur);
  WAIT_BAR(2);
  s16x4 vlo[8],vhi[8]; u32x4 pw0,pw1,pw2,pw3;
  #define PKW(P,B) cvtpk_s(P[B],P[B+1])
  #define PAF(k) __builtin_bit_cast(bf16x8,pw##k)
  #define VFR(i) (bf16x8){vlo[i][0],vlo[i][1],vlo[i][2],vlo[i][3],vhi[i][0],vhi[i][1],vhi[i][2],vhi[i][3]}
  #define PIN(x) asm volatile("":"+v"(x))
  #define MX3(a,b,c) __builtin_fmaxf(__builtin_fmaxf((a),(b)),(c))
  #define GAPA(MF,A0,A1,A2,A3,W0,W1,PW) do{ MF; sacc+=A0; sacc+=A1; sacc+=A2; sacc+=A3; PIN(sacc); W0; W1; PIN(PW); SBAR(); }while(0)
  #define EX(v) __builtin_amdgcn_exp2f(v)
  #define GAPB(MF,X,B) do{ MF; X[B]=EX(X[B]); X[B+1]=EX(X[B+1]); X[B+2]=EX(X[B+2]); X[B+3]=EX(X[B+3]); PIN(X); SBAR(); }while(0)
  #define VRD(i) do{ vlo[i]=vtr(vp_+(((i)>>2)*4096+((i)&3)*1024)); vhi[i]=vtr(vp_+(((i)>>2)*4096+((i)&3)*1024+512)); }while(0)
  #define KRD(G,j) do{ if(G){ kload2(kf,kp0+sl_next,j); SBAR(); } }while(0)
  #define STEP(C0,C1,P0,P1,t,GK,GV,GL) do{ SBAR(); BIASC(C0,C1,t); SBAR(); \
    const lds_cptr vp_=vp0+sl_prev; \
    VRD(0); SBAR(); float sacc=(P0[0]+P0[1]); \
    GAPA(C0=__builtin_amdgcn_mfma_f32_32x32x16_bf16(kf[0],qr[0],C0,0,0,0), P0[2],P0[3],P0[4],P0[5],     pw0[0]=PKW(P0,0), pw0[1]=PKW(P0,2), pw0); \
    VRD(4); SBAR(); GAPA(C1=__builtin_amdgcn_mfma_f32_32x32x16_bf16(kf[1],qr[0],C1,0,0,0), P0[6],P0[7],P0[8],P0[9],     pw0[2]=PKW(P0,4), pw0[3]=PKW(P0,6), pw0); \
    VRD(1); SBAR(); GAPA(C0=__builtin_amdgcn_mfma_f32_32x32x16_bf16(kf[2],qr[1],C0,0,0,0),   P0[10],P0[11],P0[12],P0[13], pw1[0]=PKW(P0,8), pw1[1]=PKW(P0,10), pw1); \
    VRD(5); SBAR(); GAPA(C1=__builtin_amdgcn_mfma_f32_32x32x16_bf16(kf[3],qr[1],C1,0,0,0),   P0[14],P0[15],P1[0],P1[1],   pw1[2]=PKW(P0,12),pw1[3]=PKW(P0,14), pw1); \
    VRD(2); SBAR(); GAPA(C0=__builtin_amdgcn_mfma_f32_32x32x16_bf16(kf[4],qr[2],C0,0,0,0),   P1[2],P1[3],P1[4],P1[5],     pw2[0]=PKW(P1,0), pw2[1]=PKW(P1,2), pw2); \
    VRD(6); SBAR(); GAPA(C1=__builtin_amdgcn_mfma_f32_32x32x16_bf16(kf[5],qr[2],C1,0,0,0),   P1[6],P1[7],P1[8],P1[9],     pw2[2]=PKW(P1,4), pw2[3]=PKW(P1,6), pw2); \
    VRD(3); SBAR(); GAPA(C0=__builtin_amdgcn_mfma_f32_32x32x16_bf16(kf[6],qr[3],C0,0,0,0),   P1[10],P1[11],P1[12],P1[13], pw3[0]=PKW(P1,8), pw3[1]=PKW(P1,10), pw3); \
    VRD(7); SBAR(); GAPA(C1=__builtin_amdgcn_mfma_f32_32x32x16_bf16(kf[7],qr[3],C1,0,0,0),   P1[14],P1[15],0.f,0.f,       pw3[2]=PKW(P1,12),pw3[3]=PKW(P1,14), pw3); \
    l_reg+=sacc; \
    if(GK){DMA_K((t)+3,sl_cur);} if(GV){DMA_V((t)+1,sl_next);} \
    CMASK(C0,C1,t); \
    { float a=MX3(C0[0],C0[1],C1[0]),b=MX3(C0[2],C0[3],C1[1]); a=MX3(a,C1[2],C1[3]); \
      _Pragma("unroll") for(int r=4;r<16;r+=4){a=MX3(a,C0[r],C0[r+1]);b=MX3(b,C0[r+2],C0[r+3]);a=MX3(a,C1[r],C1[r+1]);b=MX3(b,C1[r+2],C1[r+3]);} \
      float rm=__builtin_fmaxf(a,b); { auto rr=__builtin_amdgcn_permlane32_swap(__float_as_uint(rm),__float_as_uint(rm),false,false); rm=__builtin_fmaxf(__uint_as_float(rr[0]),__uint_as_float(rr[1])); } \
      resc=false; \
      if(__builtin_expect(__any(rm>(float)THRL),0)){ const float dl=__builtin_fmaxf(rm,0.f); mhat+=dl; \
        _Pragma("unroll") for(int r=0;r<16;++r){C0[r]-=dl;C1[r]-=dl;} \
        const float f=__builtin_amdgcn_exp2f(-dl); l_reg*=f; if(hi==0)wsf[r32]=f; resc=true; } } \
    SBAR(); \
    GAPB(o[0]=__builtin_amdgcn_mfma_f32_32x32x16_bf16(PAF(0),VFR(0),o[0],0,0,0), C0,0); \
    GAPB(o[1]=__builtin_amdgcn_mfma_f32_32x32x16_bf16(PAF(0),VFR(4),o[1],0,0,0), C0,4); \
    KRD(GL,0); GAPB(o[0]=__builtin_amdgcn_mfma_f32_32x32x16_bf16(PAF(1),VFR(1),o[0],0,0,0), C0,8); \
    KRD(GL,1); GAPB(o[1]=__builtin_amdgcn_mfma_f32_32x32x16_bf16(PAF(1),VFR(5),o[1],0,0,0), C0,12); \
    KRD(GL,2); GAPB(o[0]=__builtin_amdgcn_mfma_f32_32x32x16_bf16(PAF(2),VFR(2),o[0],0,0,0), C1,0); \
    KRD(GL,3); GAPB(o[1]=__builtin_amdgcn_mfma_f32_32x32x16_bf16(PAF(2),VFR(6),o[1],0,0,0), C1,4); \
    GAPB(o[0]=__builtin_amdgcn_mfma_f32_32x32x16_bf16(PAF(3),VFR(3),o[0],0,0,0), C1,8); \
    GAPB(o[1]=__builtin_amdgcn_mfma_f32_32x32x16_bf16(PAF(3),VFR(7),o[1],0,0,0), C1,12); \
    }while(0)
  int t=1;
  #undef CMASK
  #define CMASK(P0,P1,t) do{}while(0)
  for(;t+5<NT;t+=2){
    STEP(pB0,pB1,pA0,pA1,t,true,true,true);     WAIT_BAR(2); RESC(); ROT();
    STEP(pA0,pA1,pB0,pB1,t+1,true,true,true);   WAIT_BAR(2); RESC(); ROT();
  }
  #undef CMASK
  #define CMASK(P0,P1,t) do{int jb_=(t)-(NT-4); if(jb_>=0)cmask(P0,P1,jb_,qrel,hi);}while(0)
  #define ENDW(tt) do{ if((tt)+3<NT){WAIT_BAR(2);} else if((tt)+2<NT){WAIT_BAR(1);} else {WAIT_BAR(0);} }while(0)
  for(;t+1<NT;t+=2){
    STEP(pB0,pB1,pA0,pA1,t,(t+3<NT),(t+1<NT),(t+1<NT));       ENDW(t);   RESC(); ROT();
    STEP(pA0,pA1,pB0,pB1,t+1,(t+4<NT),(t+2<NT),(t+2<NT));     ENDW(t+1); RESC(); ROT();
  }
  STEP(pB0,pB1,pA0,pA1,NT-1,false,false,false); RESC();
  { float sacc=pB0[0]+pB0[1]; _Pragma("unroll") for(int r=2;r<16;++r)sacc+=pB0[r]; _Pragma("unroll") for(int r=0;r<16;++r)sacc+=pB1[r]; l_reg+=sacc;
    pw0=(u32x4){PKW(pB0,0),PKW(pB0,2),PKW(pB0,4),PKW(pB0,6)};pw1=(u32x4){PKW(pB0,8),PKW(pB0,10),PKW(pB0,12),PKW(pB0,14)};pw2=(u32x4){PKW(pB1,0),PKW(pB1,2),PKW(pB1,4),PKW(pB1,6)};pw3=(u32x4){PKW(pB1,8),PKW(pB1,10),PKW(pB1,12),PKW(pB1,14)};
    SBAR(); pv(o,vb0+sl_cur,PAF(0),PAF(1),PAF(2),PAF(3)); }
  #undef PKW
  #undef PAF
  #undef VFR
  #undef PIN
  #undef MX3
  #undef GAPA
  #undef GAPB
  #undef EX
  #undef VRD
  #undef KRD
  #undef STEP
  #undef ENDW
  {auto rr=__builtin_amdgcn_permlane32_swap(__float_as_uint(l_reg),__float_as_uint(l_reg),false,false);l_reg=__uint_as_float(rr[0])+__uint_as_float(rr[1]);}
  if(hi==0)wsf[32+r32]=l_reg;asm volatile("s_waitcnt lgkmcnt(0)":::"memory");
  float rli[16];
  #pragma unroll
  for(int r=0;r<16;++r)rli[r]=__builtin_amdgcn_rcpf(wsf[32+crow(r,hi)]);
  bf16*Ow=O+(rowbase+q0+wid*QBLK)*DM+h*D;
  { bf16*stg=(bf16*)(shm+LDS_OST)+wid*2048;
    #pragma unroll
    for(int r=0;r<16;++r){const int orow=crow(r,hi);
      #pragma unroll
      for(int d0=0;d0<2;++d0)stg[orow*64+d0*32+r32]=__float2bfloat16(o[d0][r]*rli[r]);}
    asm volatile("s_waitcnt lgkmcnt(0)":::"memory");
    #pragma unroll
    for(int i=0;i<4;++i){const int row=i*8+(lane>>3),ch=lane&7; const u32x4 v=*(const u32x4*)(stg+row*64+ch*8); ATTN_STORE16(Ow+(long)row*DM+ch*8,v);} }
  asm volatile("s_waitcnt lgkmcnt(0)\n\ts_barrier":::"memory");
  #undef BIASC
  #undef DMA_K
  #undef DMA_V
  #undef CMASK
  #undef START
  #undef RESC
  #undef ROT
}
constexpr int ATTN_LDS_BYTES=LDS_BYTES;
struct AttnTensors { const bf16* Q; const bf16* K; const bf16* V; bf16* O; };
struct AttnUnit { int bh; int qb; };
struct StaticOrder {
  int vcu;
  __device__ __forceinline__ explicit StaticOrder(int grid,int block):vcu((block%8)*(grid/8)+block/8){}
  __device__ __forceinline__ bool next(int i,AttnUnit&u)const{ if(i>=8)return false; const int p=vcu&1; u.bh=vcu>>1; const int base=4*(i>>1); u.qb=(i&1)?base+3-p:base+p; return true; }
  __device__ __forceinline__ void a_ready(const AttnUnit&)const{}
  __device__ __forceinline__ void done(const AttnUnit&)const{}
};
template<class Sched,int THRL=8> __device__ __forceinline__ void attn_phase(char*lds,const AttnTensors&T,const Sched&S){
  AttnUnit u;
  for(int i=0;S.next(i,u);++i){ S.a_ready(u); attn_unit<THRL>(u.bh/NHEAD,u.bh%NHEAD,u.qb,T.Q,T.K,T.V,T.O,lds); S.done(u); }
}
#undef SBAR
#undef WAIT_BAR
}
#define XB_TMO      128
#define XB_XCNT(j)  (256  + 64 * (j))
#define XB_XSUB(j)  (1280 + 64 * (j))
#define XB_XGEN(j)  (2304 + 64 * (j))
#define XB_TOP      3328
#define XB_TOPGEN   3392
#define XCD_BAR_WORDS 3456
#define XB_SPIN_CAP (1u << 18)

__device__ __forceinline__ unsigned xb_ld(unsigned* p)              { return __hip_atomic_load(p, __ATOMIC_RELAXED, __HIP_MEMORY_SCOPE_AGENT); }
__device__ __forceinline__ unsigned xb_add(unsigned* p, unsigned v) { return __hip_atomic_fetch_add(p, v, __ATOMIC_RELAXED, __HIP_MEMORY_SCOPE_AGENT); }
__device__ __forceinline__ unsigned xb_xcc_id() { return (unsigned)__builtin_amdgcn_s_getreg((3 << 11) | 20) & 0xFu; }
#define XB_SPIN(cond, bar) do { unsigned _sp = 0; while (cond) { __builtin_amdgcn_s_sleep(1); \
    if ((++_sp & 255u) == 0u) { if (xb_ld(&(bar)[XB_TMO])) break; if (_sp > XB_SPIN_CAP) { atomicAdd(&(bar)[XB_TMO], 1u); break; } } } } while (0)

struct XcdBarrier {
    unsigned* bar; unsigned x;
    volatile LAS unsigned* st;
};

__device__ __forceinline__ XcdBarrier xcd_barrier_post(unsigned* bar, volatile LAS unsigned* st) {
    XcdBarrier b; b.bar = bar; b.x = xb_xcc_id(); b.st = st;
    if (threadIdx.x == 0) (void)xb_add(&bar[XB_XCNT(b.x)], 1u);
    return b;
}
__device__ __forceinline__ void xcd_barrier_complete(unsigned* bar, unsigned x, unsigned& nloc, unsigned& nx) {
    const unsigned G = gridDim.x * gridDim.y * gridDim.z;
    unsigned sum, cnt, mine, sp = 0u;
    for (;;) {
        sum = 0u; cnt = 0u; mine = 0u;
#pragma unroll
        for (unsigned j = 0; j < 16; ++j) { const unsigned c = xb_ld(&bar[XB_XCNT(j)]); sum += c; cnt += (c > 0u) ? 1u : 0u; mine = (j == x) ? c : mine; }
        if (sum == G) break;
        __builtin_amdgcn_s_sleep(1);
        if ((++sp & 255u) == 0u) { if (xb_ld(&bar[XB_TMO])) break; if (sp > XB_SPIN_CAP) { atomicAdd(&bar[XB_TMO], 1u); break; } }
    }
    nloc = mine > 0u ? mine : 1u; nx = cnt > 0u ? cnt : 1u;
}

__device__ __forceinline__ void xcd_barrier(const XcdBarrier& b) {
    asm volatile("s_waitcnt vmcnt(0)" ::: "memory");
    __syncthreads();
    if (threadIdx.x == 0) {
        unsigned* bar = b.bar;
        __builtin_amdgcn_s_waitcnt(0);
        unsigned nloc = b.st[0], nx = b.st[1];
        if (nloc == 0u) { xcd_barrier_complete(bar, b.x, nloc, nx); b.st[0] = nloc; b.st[1] = nx; }
        const unsigned old = xb_add(&bar[XB_XSUB(b.x)], 1u);
        const unsigned gen = old / nloc;
        if (old + 1u == (gen + 1u) * nloc) {
            __builtin_amdgcn_fence(__ATOMIC_RELEASE, "agent");
            asm volatile("s_waitcnt vmcnt(0)" ::: "memory");
            const unsigned og = xb_add(&bar[XB_TOP], 1u);
            const unsigned tg = og / nx;
            if (og + 1u == (tg + 1u) * nx) xb_add(&bar[XB_TOPGEN], 1u);
            else XB_SPIN(xb_ld(&bar[XB_TOPGEN]) == tg, bar);
            __builtin_amdgcn_fence(__ATOMIC_ACQUIRE, "agent");
            xb_add(&bar[XB_XGEN(b.x)], 1u);
            asm volatile("s_waitcnt vmcnt(0)" ::: "memory");
        } else {
            XB_SPIN(xb_ld(&bar[XB_XGEN(b.x)]) == gen, bar);
            __builtin_amdgcn_fence(__ATOMIC_ACQUIRE, "agent");
            asm volatile("s_waitcnt vmcnt(0)" ::: "memory");
        }
    }
    __syncthreads();
}
constexpr int BATCH = 8, SEQ = 4096, DM = 1024, T = BATCH * SEQ, DFF = 2816, DPLE = 256;
constexpr int NWAVES = 8;
typedef unsigned short bf16;
typedef unsigned v4u __attribute__((ext_vector_type(4)));
typedef unsigned v2u __attribute__((ext_vector_type(2)));
typedef float f32x4 __attribute__((ext_vector_type(4)));
typedef short bf16x8 __attribute__((ext_vector_type(8)));
typedef short v4i16 __attribute__((ext_vector_type(4)));
__device__ __forceinline__ unsigned f2bf(float f) { unsigned u = __builtin_bit_cast(unsigned, f); return (u + 0x7fffu + ((u >> 16) & 1u)) >> 16; }
__device__ __forceinline__ unsigned pk2(float lo, float hi) { return f2bf(lo) | (f2bf(hi) << 16); }

constexpr size_t MiB = 1u << 20;
constexpr size_t WS_SS = 0;
constexpr size_t WS_HSS = 1280 * 1024;
constexpr size_t WS_BAR = 1856 * 1024;
constexpr size_t WS_LOGF = 2 * MiB;
constexpr size_t WS_ROPE = 4 * MiB;
constexpr size_t WS_WFFI = 8 * MiB;
constexpr size_t WS_WFFO = 52 * MiB;
constexpr size_t WS_WRIN = 74 * MiB;
constexpr size_t WS_WRG = 82 * MiB;
constexpr size_t WS_WRO = 86 * MiB;
constexpr size_t WS_WFIN = 90 * MiB;
constexpr size_t WS_WFZ = 96 * MiB;
constexpr size_t WS_WFO = 97 * MiB;
constexpr size_t WS_WPG = 99 * MiB;
constexpr size_t WS_WPP = 103 * MiB;
constexpr size_t WS_HB = 104 * MiB;
constexpr size_t WS_PB = 168 * MiB;
constexpr size_t WS_POOL = 200 * MiB;
constexpr size_t WS_END = 456 * MiB;
constexpr int LDS_BYTES = 147456, RING_BYTES = 131072;

namespace ret {
constexpr int KP = 544, VP = 144, PPI = 144;
constexpr int L_K = 0, L_V = L_K + 64 * KP, L_P = L_V + 64 * VP, L_ST = L_P + 64 * PPI, L_END = L_ST + 64 * KP;
static_assert(L_END <= RING_BYTES, "retention LDS");
#define MFMA16(a, b, c) __builtin_amdgcn_mfma_f32_16x16x32_bf16((a), (b), (c), 0, 0, 0)
__device__ __forceinline__ bf16x8 trfrag(const LAS char* p, int pitch) {
    const v4i16 lo = __builtin_amdgcn_ds_read_tr16_b64_v4i16((LAS v4i16*)p), hi = __builtin_amdgcn_ds_read_tr16_b64_v4i16((LAS v4i16*)(p + 4 * pitch));
    return (bf16x8){lo[0], lo[1], lo[2], lo[3], hi[0], hi[1], hi[2], hi[3]};
}
__device__ __forceinline__ void ret_phase(LAS char* L, const bf16* Qt, const bf16* Kt, bf16* VO, float* hss, int vcu, bool live = true) {
    int tid_ = threadIdx.x; asm volatile("" : "+v"(tid_));
    const int tid = tid_, lane = tid & 63, w = __builtin_amdgcn_readfirstlane(tid >> 6), m16 = lane & 15, g = lane >> 4, q4 = m16 >> 2, p4 = lane & 3;
    const int ib = w >> 1, half = w & 1;
    const int bh = vcu >> 3, es = vcu & 7, b = bh >> 2, h = bh & 3;
    const float lg = log2f(1.0f - exp2f(-5.0f - (float)h)), gC = exp2f(64.0f * lg);
    const size_t tok0 = (size_t)b * SEQ;
    const bf16* kbase = Kt + tok0 * 1024 + h * 256 + (size_t)(tid >> 5) * 1024 + (tid & 31) * 8;
    const bf16* vbase = VO + tok0 * 2048 + h * 512 + es * 64 + (size_t)(tid >> 3) * 2048 + (tid & 7) * 8;
    const bf16* qbase = Qt + tok0 * 1024 + h * 256 + (size_t)(16 * ib + m16) * 1024 + 8 * g;
    for (int i = tid; i < 64 * KP / 16; i += 512) *(LAS v4u*)(L + L_ST + 16 * i) = (v4u){0u, 0u, 0u, 0u};
    f32x4 st[2][4];
#pragma unroll
    for (int a = 0; a < 2; ++a)
#pragma unroll
        for (int e = 0; e < 4; ++e) st[a][e] = (f32x4){0.f, 0.f, 0.f, 0.f};
    v4u kreg[4], vreg; bf16x8 qn[8];
#define RET_LOAD(c) do { _Pragma("unroll") for (int u_ = 0; u_ < 4; ++u_) kreg[u_] = *(const v4u*)(kbase + (size_t)((c) * 64 + 16 * u_) * 1024); \
        vreg = *(const v4u*)(vbase + (size_t)(c) * 64 * 2048); \
        _Pragma("unroll") for (int s_ = 0; s_ < 8; ++s_) qn[s_] = *(const bf16x8*)(qbase + (size_t)(c) * 64 * 1024 + 32 * s_); } while (0)
    RET_LOAD(0);
    const int troff_k = (8 * g + q4) * KP + 8 * p4, troff_v = (8 * g + q4) * VP + 8 * p4;
    for (int c = 0; c < 64; ++c) {
#pragma unroll
        for (int u_ = 0; u_ < 4; ++u_) *(LAS v4u*)(L + L_K + ((tid >> 5) + 16 * u_) * KP + (tid & 31) * 16) = kreg[u_];
        *(LAS v4u*)(L + L_V + (tid >> 3) * VP + (tid & 7) * 16) = vreg;
        bf16x8 qf[8];
#pragma unroll
        for (int s = 0; s < 8; ++s) qf[s] = qn[s];
        __syncthreads();
        if (c + 1 < 64) RET_LOAD(c + 1);
#pragma unroll
        for (int jj = 0; jj < 2; ++jj) { const int jb = 2 * half + jj; f32x4 sa = (f32x4){0.f, 0.f, 0.f, 0.f};
#pragma unroll
            for (int s = 0; s < 8; ++s) { const bf16x8 a = *(const LAS bf16x8*)(L + L_K + (16 * jb + m16) * KP + (32 * s + 8 * g) * 2); sa = MFMA16(a, qf[s], sa); }
            const int il = 16 * ib + m16, j0 = 16 * jb + 4 * g;
            const float s0 = (j0 + 0 <= il) ? sa[0] : 0.f, s1 = (j0 + 1 <= il) ? sa[1] : 0.f, s2 = (j0 + 2 <= il) ? sa[2] : 0.f, s3 = (j0 + 3 <= il) ? sa[3] : 0.f;
            *(LAS v2u*)(L + L_P + il * PPI + j0 * 2) = (v2u){pk2(s0, s1), pk2(s2, s3)}; }
        f32x4 oa[2];
#pragma unroll
        for (int ee = 0; ee < 2; ++ee) { const int eb = 2 * half + ee; oa[ee] = (f32x4){0.f, 0.f, 0.f, 0.f};
#pragma unroll
            for (int s = 0; s < 8; ++s) { const bf16x8 a = *(const LAS bf16x8*)(L + L_ST + (16 * eb + m16) * KP + (32 * s + 8 * g) * 2); oa[ee] = MFMA16(a, qf[s], oa[ee]); } }
        __syncthreads();
        bf16x8 vt[2][4];
#pragma unroll
        for (int ks = 0; ks < 2; ++ks)
#pragma unroll
            for (int eb = 0; eb < 4; ++eb) vt[ks][eb] = trfrag(L + L_V + (32 * ks) * VP + (16 * eb) * 2 + troff_v, VP);
#pragma unroll
        for (int ks = 0; ks < 2; ++ks) { const bf16x8 pf = *(const LAS bf16x8*)(L + L_P + (16 * ib + m16) * PPI + (32 * ks + 8 * g) * 2);
            if (half == 0) { oa[0] = MFMA16(vt[ks][0], pf, oa[0]); oa[1] = MFMA16(vt[ks][1], pf, oa[1]); }
            else           { oa[0] = MFMA16(vt[ks][2], pf, oa[0]); oa[1] = MFMA16(vt[ks][3], pf, oa[1]); } }
        { const size_t tok = tok0 + (size_t)c * 64 + 16 * ib + m16; float sq = 0.f;
#pragma unroll
            for (int ee = 0; ee < 2; ++ee) { const f32x4 o = oa[ee]; sq += (o[0] * o[0] + o[1] * o[1]) + (o[2] * o[2] + o[3] * o[3]);
                if (live) *(v2u*)(VO + tok * 2048 + h * 512 + es * 64 + 16 * (2 * half + ee) + 4 * g) = (v2u){pk2(o[0], o[1]), pk2(o[2], o[3])}; }
            sq += __shfl_xor(sq, 16); sq += __shfl_xor(sq, 32); if (g == 0 && live) atomicAdd(hss + tok * 4 + h, sq); }
#pragma unroll
        for (int ks = 0; ks < 2; ++ks)
#pragma unroll
            for (int dd = 0; dd < 2; ++dd) { const bf16x8 kt = trfrag(L + L_K + (32 * ks) * KP + (16 * (2 * w + dd)) * 2 + troff_k, KP);
#pragma unroll
                for (int eb = 0; eb < 4; ++eb) st[dd][eb] = MFMA16(kt, vt[ks][eb], st[dd][eb]); }
#pragma unroll
        for (int dd = 0; dd < 2; ++dd)
#pragma unroll
            for (int eb = 0; eb < 4; ++eb) { st[dd][eb] = st[dd][eb] * gC; const f32x4 s = st[dd][eb];
                *(LAS v2u*)(L + L_ST + (16 * eb + m16) * KP + (16 * (2 * w + dd) + 4 * g) * 2) = (v2u){pk2(s[0], s[1]), pk2(s[2], s[3])}; }
        __syncthreads();
    }
#undef RET_LOAD
}
}

struct Args { const float* in[14]; float* out; unsigned char* ws; };
struct Frame { LAS unsigned char* lds; int tid, lane, wave, vcu, G; };

__device__ __forceinline__ float wave_sum(float v) {
#pragma unroll
    for (int o = 1; o < 64; o <<= 1) v += __shfl_xor(v, o);
    return v;
}
__device__ __forceinline__ void prep_item(const float* W, int K, int Nsrc, bf16* WT, int rows, int mode, int coloff, const float* ks, LAS float* scr, int item, int lane) {
    const int nblk = rows / 32, kb = item / nblk, nb = item % nblk, k0 = 64 * kb, n0 = 32 * nb;
    const int src0 = mode ? (((n0 >> 7) & 1) * DFF + 128 * (n0 >> 8) + (n0 & 127)) : (coloff + n0);
    float wv[32];
#pragma unroll
    for (int i = 0; i < 32; ++i) { const int kk = 2 * i + (lane >> 5); wv[i] = __builtin_nontemporal_load(W + (size_t)(k0 + kk) * Nsrc + src0 + (lane & 31)); }
#pragma unroll
    for (int i = 0; i < 32; ++i) { const int kk = 2 * i + (lane >> 5); scr[kk * 33 + (lane & 31)] = wv[i]; }
    asm volatile("s_waitcnt lgkmcnt(0)" ::: "memory");
    const int c = lane & 7;
    float sc[8];
#pragma unroll
    for (int x = 0; x < 8; ++x) sc[x] = ks ? ks[k0 + 8 * c + x] : 1.0f;
#pragma unroll
    for (int j = 0; j < 4; ++j) { const int n = (lane >> 3) + 8 * j; const LAS float* s = scr + (8 * c) * 33 + n;
        v4u o; o.x = pk2(s[0 * 33] * sc[0], s[1 * 33] * sc[1]); o.y = pk2(s[2 * 33] * sc[2], s[3 * 33] * sc[3]); o.z = pk2(s[4 * 33] * sc[4], s[5 * 33] * sc[5]); o.w = pk2(s[6 * 33] * sc[6], s[7 * 33] * sc[7]);
        *(v4u*)(WT + (size_t)(n0 + n) * K + k0 + 8 * c) = o; }
    asm volatile("s_waitcnt lgkmcnt(0)" ::: "memory");
}
#define PREP(Wp, K_, Nsrc_, WTp, rows_, mode_, coloff_, ksp) do { const int nit_ = ((K_) / 64) * ((rows_) / 32); \
    for (int it_ = gw; it_ < nit_; it_ += NGW) prep_item((Wp), (K_), (Nsrc_), (WTp), (rows_), (mode_), (coloff_), (ksp), scr, it_, F.lane); } while (0)

typedef const volatile __attribute__((address_space(4))) unsigned long long* kargp_t;
#define KARG(i) ((unsigned long long)(*((kargp_t)__builtin_amdgcn_kernarg_segment_ptr() + (i))))
#define KIN(i) ((const float*)KARG(i))
#define KOUT ((float*)KARG(14))
#define KWS ((unsigned char*)KARG(15))
#define SEAM() do { XcdBarrier b_; b_.bar = (unsigned*)(KWS + WS_BAR); b_.x = xb_xcc_id(); b_.st = (volatile LAS unsigned*)(F.lds + RING_BYTES) + 8; xcd_barrier(b_); } while (0)
#define GEMM_PHASE(EpiT, Aop, Bop, N_, K_, Eobj) do { pg8::Gemm g_{(const pg8::bf16_t*)(Aop), (const pg8::bf16_t*)(Bop), T, (N_), (K_)}; pg8::StaticOrder S_; S_.init(T, (N_), F.G, (int)blockIdx.x); \
        pg8::gemm_phase<EpiT, pg8::StaticOrder, true, true>(F.lds, g_, S_, (Eobj)); } while (0)

__device__ __forceinline__ void p0_prologue(const Frame& F) {
    unsigned char* ws = KWS;
    const float* norm_w = KIN(2);
    float* SS = (float*)(ws + WS_SS); float* HSS = (float*)(ws + WS_HSS);
    const int gw = F.vcu * NWAVES + F.wave, NGW = F.G * NWAVES, gtid = gw * 64 + F.lane, NGT = NGW * 64;
    LAS float* scr = (LAS float*)(F.lds + F.wave * 16384);
    for (int i = gtid; i < 8 * T + 4 * T; i += NGT) { if (i < 8 * T) SS[T + i] = 0.f; else HSS[i - 8 * T] = 0.f; }
    { float* ROPE = (float*)(ws + WS_ROPE);
      for (int i = gtid; i < 4096 * 128; i += NGT) { const int pos = i >> 7, j = i & 127;
        const float inv = exp2f(-(float)j * (13.287712379549449f / 128.0f)); const float ang = (float)pos * inv;
        double tr = (double)ang * 0.15915494309189535; tr -= rint(tr); const float tf = (float)tr;
        ROPE[2 * i] = __builtin_amdgcn_cosf(tf); ROPE[2 * i + 1] = __builtin_amdgcn_sinf(tf); } }
    { const float* x = KIN(0); bf16* HB = (bf16*)(ws + WS_HB);
      for (int m = gw; m < T / 2; m += NGW) {
        f32x4 v[2][4];
#pragma unroll
        for (int rr = 0; rr < 2; ++rr)
#pragma unroll
            for (int j = 0; j < 4; ++j) v[rr][j] = __builtin_nontemporal_load((const f32x4*)(x + (size_t)(m + rr * (T / 2)) * DM) + F.lane + 64 * j);
#pragma unroll
        for (int rr = 0; rr < 2; ++rr) { float s = 0.f; unsigned long long* o8 = (unsigned long long*)(HB + (size_t)(m + rr * (T / 2)) * DM) + F.lane;
#pragma unroll
            for (int j = 0; j < 4; ++j) { const f32x4 q = v[rr][j]; s += (q.x * q.x + q.y * q.y) + (q.z * q.z + q.w * q.w); o8[64 * j] = (unsigned long long)pk2(q.x, q.y) | ((unsigned long long)pk2(q.z, q.w) << 32); }
            s = wave_sum(s); if (F.lane == 0) SS[m + rr * (T / 2)] = s; } } }
    { const float* pin = KIN(1); bf16* PB = (bf16*)(ws + WS_PB);
      for (int i = gtid; i < 2 * T * DPLE / 16; i += NGT) { f32x4 v[4];
#pragma unroll
        for (int j = 0; j < 4; ++j) v[j] = __builtin_nontemporal_load((const f32x4*)pin + (size_t)j * (2 * T * DPLE / 16) + i);
#pragma unroll
        for (int j = 0; j < 4; ++j) ((unsigned long long*)PB)[(size_t)j * (2 * T * DPLE / 16) + i] = (unsigned long long)pk2(v[j].x, v[j].y) | ((unsigned long long)pk2(v[j].z, v[j].w) << 32); } }
    { const float* fox_w_in = KIN(8); bf16* WFZ = (bf16*)(ws + WS_WFZ);
      for (int i = gtid; i < 16 * 1024; i += NGT) { const int n = i >> 10, k = i & 1023; WFZ[i] = (bf16)f2bf(fox_w_in[(size_t)k * 3088 + 3072 + n] * norm_w[(4 + 1) * DM + k]); } }
#pragma unroll 1
    for (int fi = 0; fi < 4; ++fi) { const int li = fi >> 1, f = fi & 1;
        PREP(KIN(3) + (size_t)fi * DM * 2 * DFF, DM, 2 * DFF, (bf16*)(ws + WS_WFFI) + (size_t)fi * 2 * DFF * DM, 2 * DFF, 1, 0, norm_w + (li * 4 + (f ? 2 : 0)) * DM);
        PREP(KIN(4) + (size_t)fi * DFF * DM, DFF, DM, (bf16*)(ws + WS_WFFO) + (size_t)fi * DM * DFF, DM, 0, 0, (const float*)nullptr); }
    PREP(KIN(5), DM, 6144, (bf16*)(ws + WS_WRIN), 4096, 0, 0, norm_w + 1 * DM);
    PREP(KIN(5), DM, 6144, (bf16*)(ws + WS_WRG), 2048, 0, 4096, norm_w + 1 * DM);
    PREP(KIN(7), 2048, DM, (bf16*)(ws + WS_WRO), DM, 0, 0, (const float*)nullptr);
    PREP(KIN(8), DM, 3088, (bf16*)(ws + WS_WFIN), 3072, 0, 0, norm_w + (4 + 1) * DM);
    PREP(KIN(10), DM, DM, (bf16*)(ws + WS_WFO), DM, 0, 0, (const float*)nullptr);
#pragma unroll 1
    for (int li = 0; li < 2; ++li) {
        PREP(KIN(12) + (size_t)li * DM * DM, DM, DM, (bf16*)(ws + WS_WPG) + (size_t)li * DM * DM, DM, 0, 0, norm_w + (li * 4 + 3) * DM);
        PREP(KIN(11) + (size_t)li * DPLE * DM, DPLE, DM, (bf16*)(ws + WS_WPP) + (size_t)li * DM * DPLE, DM, 0, 0, (const float*)nullptr); }
}

template <int FI, int SITE, bool FIRST, bool WITH_PP> __device__ __forceinline__ void ffn_half(const Frame& F, cg::grid_group& grid) {
#ifdef PROBE_FFI
    { unsigned char* ws = KWS; pg8::EpiSwiglu E{(pg8::bf16_t*)(ws + WS_POOL), (const float*)(ws + WS_SS) + (size_t)SITE * T};
      GEMM_PHASE(pg8::EpiSwiglu, ws + WS_HB, (bf16*)(ws + WS_WFFI) + (size_t)FI * 2 * DFF * DM, 2 * DFF, DM, E); }
    SEAM();
#endif
    { unsigned char* ws = KWS; pg8::EpiSwiglu E{(pg8::bf16_t*)(ws + WS_POOL), (const float*)(ws + WS_SS) + (size_t)SITE * T};
      GEMM_PHASE(pg8::EpiSwiglu, ws + WS_HB, (bf16*)(ws + WS_WFFI) + (size_t)FI * 2 * DFF * DM, 2 * DFF, DM, E); }
    SEAM();
    { unsigned char* ws = KWS; float* hres = KOUT; pg8::EpiRes E{FIRST ? KIN(0) : (const float*)hres, hres, (pg8::bf16_t*)(ws + WS_HB), (float*)(ws + WS_SS) + (size_t)(SITE + 1) * T, 0.5f};
      GEMM_PHASE(pg8::EpiRes, ws + WS_POOL, (bf16*)(ws + WS_WFFO) + (size_t)FI * DM * DFF, DM, DFF, E); }
    if (WITH_PP) { unsigned char* ws = KWS; constexpr int LI = FI >> 1; pg8::EpiPlain E{(pg8::bf16_t*)(ws + WS_POOL + 176 * MiB), DM, (const float*)nullptr, 0, 0, 1.0f};
      GEMM_PHASE(pg8::EpiPlain, (bf16*)(ws + WS_PB) + (size_t)LI * T * DPLE, (bf16*)(ws + WS_WPP) + (size_t)LI * DM * DPLE, DM, DPLE, E); }
    SEAM();
}
template <int LI> __device__ __forceinline__ void ple_phase(const Frame& F, cg::grid_group& grid) {
    { unsigned char* ws = KWS; float* hres = KOUT; float* SS = (float*)(ws + WS_SS);
      pg8::EpiPle E{hres, hres, (pg8::bf16_t*)(ws + WS_HB), SS + (size_t)(4 * LI + 4) * T, SS + (size_t)(4 * LI + 3) * T, (const pg8::bf16_t*)(ws + WS_POOL + 176 * MiB)};
      GEMM_PHASE(pg8::EpiPle, ws + WS_HB, (bf16*)(ws + WS_WPG) + (size_t)LI * DM * DM, DM, DM, E); }
    SEAM();
}
__device__ __forceinline__ void retention_mixer(const Frame& F, cg::grid_group& grid) {
    { unsigned char* ws = KWS; pg8::EpiRetIn E{(pg8::bf16_t*)(ws + WS_POOL), (pg8::bf16_t*)(ws + WS_POOL + 64 * MiB), (pg8::bf16_t*)(ws + WS_POOL + 128 * MiB), (const float*)(ws + WS_SS) + T, (const float*)(ws + WS_ROPE)};
      GEMM_PHASE(pg8::EpiRetIn, ws + WS_HB, ws + WS_WRIN, 4096, DM, E); }
    SEAM();
#ifdef PROBE_RET
    { unsigned char* ws = KWS; ret::ret_phase((LAS char*)F.lds, (const bf16*)(ws + WS_POOL), (const bf16*)(ws + WS_POOL + 64 * MiB), (bf16*)(ws + WS_POOL + 128 * MiB), (float*)(ws + WS_HSS), F.vcu, KARG(15) == 1ull); }
    SEAM();
#endif
    { unsigned char* ws = KWS; ret::ret_phase((LAS char*)F.lds, (const bf16*)(ws + WS_POOL), (const bf16*)(ws + WS_POOL + 64 * MiB), (bf16*)(ws + WS_POOL + 128 * MiB), (float*)(ws + WS_HSS), F.vcu); }
    SEAM();
    { unsigned char* ws = KWS; pg8::EpiRetGate E{(pg8::bf16_t*)(ws + WS_POOL + 128 * MiB), (const float*)(ws + WS_SS) + T, (const float*)(ws + WS_HSS), KIN(6)};
      GEMM_PHASE(pg8::EpiRetGate, ws + WS_HB, ws + WS_WRG, 2048, DM, E); }
    SEAM();
    { unsigned char* ws = KWS; float* hres = KOUT; pg8::EpiRes E{hres, hres, (pg8::bf16_t*)(ws + WS_HB), (float*)(ws + WS_SS) + 2 * (size_t)T, 1.0f};
      GEMM_PHASE(pg8::EpiRes, ws + WS_POOL + 128 * MiB, ws + WS_WRO, DM, 2048, E); }
    SEAM();
}
__device__ __forceinline__ void fox_mixer(const Frame& F, cg::grid_group& grid, unsigned char* lds_generic) {
    { unsigned char* ws = KWS; pg8::EpiPlain E{(pg8::bf16_t*)(ws + WS_POOL), DM, (const float*)(ws + WS_SS) + 5 * (size_t)T, DM, (size_t)(64 * MiB / 2), attn_body::C2};
      GEMM_PHASE(pg8::EpiPlain, ws + WS_HB, ws + WS_WFIN, 3072, DM, E); }
    { unsigned char* ws = KWS; const bf16* HB = (const bf16*)(ws + WS_HB); const bf16* WFZ = (const bf16*)(ws + WS_WFZ); float* LOGF = (float*)(ws + WS_LOGF); const float* ssm = (const float*)(ws + WS_SS) + 5 * (size_t)T; const float* fox_b_f = KIN(9);
      const int gw = F.vcu * NWAVES + F.wave, NGW = F.G * NWAVES;
      for (int task = gw; task < T / 16; task += NGW) {
        const int m16 = F.lane & 15, g = F.lane >> 4; f32x4 a4 = (f32x4){0.f, 0.f, 0.f, 0.f};
        const bf16* ar = HB + (size_t)(16 * task + m16) * DM + 8 * g; const bf16* br = WFZ + (size_t)m16 * DM + 8 * g;
#pragma unroll 8
        for (int s = 0; s < 32; ++s) a4 = __builtin_amdgcn_mfma_f32_16x16x32_bf16(*(const bf16x8*)(ar + 32 * s), *(const bf16x8*)(br + 32 * s), a4, 0, 0, 0);
        const float bfh = fox_b_f[m16];
#pragma unroll
        for (int r = 0; r < 4; ++r) { const int t = 16 * task + 4 * g + r; const float z = a4[r] * pg8::rinv_of(ssm, t) + bfh;
            LOGF[(size_t)t * 16 + m16] = fminf(z, 0.f) - log1pf(__expf(-fabsf(z))); } } }
    SEAM();
    {
        unsigned char* ws = KWS; const float* LOGF = (const float*)(ws + WS_LOGF);
        const int bh = F.vcu >> 1, b = bh >> 4, h = bh & 15; LAS float* nb = (LAS float*)(F.lds + attn_body::LDS_NB); LAS float* wtot = (LAS float*)(F.lds + attn_body::LDS_WS);
        float v[8]; float run = 0.f;
#pragma unroll
        for (int q = 0; q < 8; ++q) { run += LOGF[((size_t)b * SEQ + 8 * F.tid + q) * 16 + h]; v[q] = run; }
        float incl = run;
#pragma unroll
        for (int o = 1; o < 64; o <<= 1) { const float y = __shfl_up(incl, o); if (F.lane >= o) incl += y; }
        if (F.lane == 63) wtot[F.wave] = incl;
        __syncthreads();
        float off = incl - run;
        for (int w2 = 0; w2 < F.wave; ++w2) off += wtot[w2];
#pragma unroll
        for (int q = 0; q < 8; ++q) nb[8 * F.tid + q] = -(off + v[q]) * 1.4426950408889634f;
        __syncthreads();
        const attn_body::bf16* FQ = (const attn_body::bf16*)(ws + WS_POOL);
        const attn_body::AttnTensors AT{FQ, FQ + (size_t)T * DM, FQ + (size_t)2 * T * DM, (attn_body::bf16*)FQ};
        const attn_body::StaticOrder S((int)F.G, (int)blockIdx.x);
        attn_body::attn_phase<attn_body::StaticOrder>((char*)lds_generic, AT, S);
    }
    SEAM();
    { unsigned char* ws = KWS; float* hres = KOUT; pg8::EpiRes E{hres, hres, (pg8::bf16_t*)(ws + WS_HB), (float*)(ws + WS_SS) + 6 * (size_t)T, 1.0f};
      GEMM_PHASE(pg8::EpiRes, ws + WS_POOL, ws + WS_WFO, DM, DM, E); }
    SEAM();
}

__global__ void __launch_bounds__(NWAVES * 64, 2) hybrid_fwd(Args args) {
    extern __shared__ __attribute__((aligned(16))) unsigned char lds[];
    cg::grid_group grid = cg::this_grid();
    Frame F; F.lds = (LAS unsigned char*)lds; F.tid = threadIdx.x; F.lane = F.tid & 63; F.wave = __builtin_amdgcn_readfirstlane(F.tid >> 6);
    F.G = gridDim.x; { const int bx = blockIdx.x; F.vcu = (F.G % 8 == 0) ? (bx % 8) * (F.G / 8) + bx / 8 : bx; }
    if (F.tid < 64) ((LAS unsigned*)(F.lds + RING_BYTES))[F.tid] = 0u;
    __syncthreads();
    (void)xcd_barrier_post((unsigned*)(KWS + WS_BAR), (volatile LAS unsigned*)(F.lds + RING_BYTES) + 8);
    p0_prologue(F);
    grid.sync();
#ifdef PROBE_P0
    p0_prologue(F);
    SEAM();
#endif
    ffn_half<0, 0, true, false>(F, grid);
    retention_mixer(F, grid);
    ffn_half<1, 2, false, true>(F, grid);
    ple_phase<0>(F, grid);
    ffn_half<2, 4, false, false>(F, grid);
    fox_mixer(F, grid, lds);
    ffn_half<3, 6, false, true>(F, grid);
    ple_phase<1>(F, grid);
#ifdef PROBE_SYNC
#pragma unroll 1
    for (int i_ = 0; i_ < PROBE_SYNC; ++i_) grid.sync();
#endif
    { float* hres = KOUT; const float* final_norm_w = KIN(13); const int gw = F.vcu * NWAVES + F.wave, NGW = F.G * NWAVES;
      for (int m = gw; m < T; m += NGW) {
        f32x4* xr = (f32x4*)(hres + (size_t)m * DM) + F.lane; const f32x4* wr = (const f32x4*)final_norm_w + F.lane; f32x4 v[4]; float s = 0.f;
#pragma unroll
        for (int j = 0; j < 4; ++j) { v[j] = xr[64 * j]; s += (v[j].x * v[j].x + v[j].y * v[j].y) + (v[j].z * v[j].z + v[j].w * v[j].w); }
        const float ri = 1.0f / sqrtf(wave_sum(s) * (1.0f / DM) + 1e-6f);
#pragma unroll
        for (int j = 0; j < 4; ++j) xr[64 * j] = v[j] * ri * wr[64 * j];
      } }
}

extern "C" void kernel_launch(void* const* d_in, const int* in_sizes, int n_in, void* d_out, int out_size, void* d_ws, size_t ws_size, hipStream_t stream) {
    static int grid = 0;
    if (grid == 0) {
        if (n_in != 14 || out_size != T * DM || ws_size < WS_END) { fprintf(stderr, "kernel_launch: unexpected shapes (n_in %d out %d ws %zu)\n", n_in, out_size, ws_size); grid = -1; return; }
        int dev = 0, cus = 0, per_cu = 0;
        if (hipGetDevice(&dev) != hipSuccess || hipDeviceGetAttribute(&cus, hipDeviceAttributeMultiprocessorCount, dev) != hipSuccess) { grid = -1; return; }
        if (hipFuncSetAttribute((const void*)hybrid_fwd, hipFuncAttributeMaxDynamicSharedMemorySize, LDS_BYTES) != hipSuccess) { fprintf(stderr, "kernel_launch: hipFuncSetAttribute failed\n"); grid = -1; return; }
        if (hipOccupancyMaxActiveBlocksPerMultiprocessor(&per_cu, (const void*)hybrid_fwd, NWAVES * 64, LDS_BYTES) != hipSuccess || per_cu < 1) { fprintf(stderr, "kernel_launch: occupancy query says %d\n", per_cu); per_cu = 1; }
        (void)hipGetLastError();
        grid = cus * 1;
    }
    if (grid < 0) return;
    if (hipMemsetAsync((char*)d_ws + WS_BAR, 0, 16384, stream) != hipSuccess) { fprintf(stderr, "kernel_launch: memset failed\n"); return; }
    Args a{};
    for (int i = 0; i < 14; ++i) a.in[i] = (const float*)d_in[i];
    a.out = (float*)d_out; a.ws = (unsigned char*)d_ws;
    void* kargs[] = {&a};
    hipError_t e = hipLaunchCooperativeKernel((const void*)hybrid_fwd, dim3(grid), dim3(NWAVES * 64), kargs, LDS_BYTES, stream);
    if (e != hipSuccess) fprintf(stderr, "cooperative launch failed: %s (grid %d)\n", hipGetErrorString(e), grid);
}
```

```cpp
#include <hip/hip_runtime.h>
#include <hip/hip_cooperative_groups.h>
#include <cstdio>
#include <cstdint>
namespace cg = cooperative_groups;
#define GAS __attribute__((address_space(1)))
#define LAS __attribute__((address_space(3)))
namespace pg8 {
#define PG8_LAS __attribute__((address_space(3)))
typedef unsigned short bf16_t;
typedef short bf16x8 __attribute__((ext_vector_type(8)));
typedef float f32x4 __attribute__((ext_vector_type(4)));
typedef unsigned u32x4 __attribute__((ext_vector_type(4)));
constexpr int BM = 256, BK = 64, HALF = 128, HTB = HALF * BK * 2  , STAGE_BYTES = 8 * HTB, NXCD = 8, WGM = 8;

__host__ __device__ __forceinline__ int lds_byte(int r, int c) { const int st = (r >> 4) * 2 + (c >> 5), rr = r & 15, cc = c & 31, ob = rr * 64 + cc * 2; return st * 1024 + (ob ^ (((ob >> 9) & 1) << 5)); }
__host__ __device__ __forceinline__ void stage_rc(int b, int& R, int& C) { const int st = b / 1024, sb = b % 1024, swz = sb ^ (((sb >> 9) & 1) << 5); R = (st >> 1) * 16 + swz / 64; C = (st & 1) * 32 + (swz % 64) / 2; }
__host__ __device__ __forceinline__ int perm32(int rho) { const int n = rho >> 4, i = rho & 15; return 8 * (i >> 2) + 4 * n + (i & 3); }

struct Unit { int pm, pn; };
struct Gemm { const bf16_t* A; const bf16_t* Bt; int M, N, K; };

struct StaticOrder {
    int nM, nN, nwg, G, c;
    __host__ __device__ void init(int M, int N, int G_, int c_) { nM = M / BM; nN = N / BM; nwg = nM * nN; G = G_; c = c_; }
    __host__ __device__ bool next(int i, Unit& u) const {
        const long L = (long)i * G + c; if (L >= nwg) return false;
        int wgid = (int)L; { const int q = nwg / NXCD, r = nwg % NXCD, xcd = wgid % NXCD, off = wgid / NXCD; wgid = (xcd < r ? xcd * (q + 1) : r * (q + 1) + (xcd - r) * q) + off; }
        const int nig = WGM * nN, gid = wgid / nig, fm = gid * WGM, gsz = (nM - fm) < WGM ? (nM - fm) : WGM;
        u.pm = fm + ((wgid % nig) % gsz); u.pn = (wgid % nig) / gsz; return true;
    }
    __device__ __forceinline__ void a_ready(const Unit&) const {}
    __device__ __forceinline__ void done(const Unit&) const {}
};
__device__ __forceinline__ unsigned cvt_pk_bf16(float lo, float hi) { unsigned r; asm volatile("v_cvt_pk_bf16_f32 %0, %1, %2" : "=v"(r) : "v"(lo), "v"(hi)); return r; }
__device__ __forceinline__ u32x4 pack8(const f32x4 v0, const f32x4 v1) { u32x4 w; w.x = cvt_pk_bf16(v0[0], v0[1]); w.y = cvt_pk_bf16(v0[2], v0[3]); w.z = cvt_pk_bf16(v1[0], v1[1]); w.w = cvt_pk_bf16(v1[2], v1[3]); return w; }
__device__ __forceinline__ float bflo(unsigned u) { return __uint_as_float(u << 16); }
__device__ __forceinline__ float bfhi(unsigned u) { return __uint_as_float(u & 0xffff0000u); }
__device__ __forceinline__ void unpack8(const u32x4 w, f32x4& v0, f32x4& v1) { v0 = (f32x4){bflo(w.x), bfhi(w.x), bflo(w.y), bfhi(w.y)}; v1 = (f32x4){bflo(w.z), bfhi(w.z), bflo(w.w), bfhi(w.w)}; }
__device__ __forceinline__ float sigm(float x) { return __builtin_amdgcn_rcpf(1.0f + __builtin_amdgcn_exp2f(-1.4426950408889634f * x)); }
__device__ __forceinline__ f32x4 silu4(const f32x4 x) { return (f32x4){x[0] * sigm(x[0]), x[1] * sigm(x[1]), x[2] * sigm(x[2]), x[3] * sigm(x[3])}; }
__device__ __forceinline__ f32x4 sigm4(const f32x4 x) { return (f32x4){sigm(x[0]), sigm(x[1]), sigm(x[2]), sigm(x[3])}; }
__device__ __forceinline__ float sum16(const float* p) { const f32x4* q = (const f32x4*)p; const f32x4 a = q[0], b = q[1], c = q[2], d = q[3];
    return (((a[0] + a[1]) + (a[2] + a[3])) + ((b[0] + b[1]) + (b[2] + b[3]))) + (((c[0] + c[1]) + (c[2] + c[3])) + ((d[0] + d[1]) + (d[2] + d[3]))); }
__device__ __forceinline__ float rinv_of(const float* ss, int r) { return 1.0f / sqrtf(sum16(ss + (size_t)r * 16) * (1.0f / 1024.0f) + 1e-6f); }
#define EPI_ARGS const f32x4 (&acc)[2][2][4][2], const Unit& u, int wr, int wc, int fr, int fq
#define EPI_ROWS(ai, m) (u.pm * BM + (ai) * HALF + wr * 64 + (m) * 16 + fr)

struct EpiSwiglu { static constexpr bool PERM = true, AFTER_DRAIN = false; bf16_t* act; const float* ss;
    __device__ __forceinline__ void operator()(EPI_ARGS) const {
        const int col0 = u.pn * HALF + wc * 32 + 8 * fq;
#pragma unroll
        for (int ai = 0; ai < 2; ++ai)
#pragma unroll
            for (int m = 0; m < 4; ++m) { const int r = EPI_ROWS(ai, m); const float ri = rinv_of(ss, r);
                const f32x4 a0 = silu4(acc[ai][0][m][0] * ri) * (acc[ai][1][m][0] * ri), a1 = silu4(acc[ai][0][m][1] * ri) * (acc[ai][1][m][1] * ri);
                *(u32x4*)(act + (size_t)r * 2816 + col0) = pack8(a0, a1); }
    }
};
struct EpiRes { static constexpr bool PERM = true, AFTER_DRAIN = false; const bf16_t* rin; bf16_t* rout; float* ssn; float scale;
    __device__ __forceinline__ void operator()(EPI_ARGS) const {
#pragma unroll
        for (int ai = 0; ai < 2; ++ai)
#pragma unroll
            for (int m = 0; m < 4; ++m) { const int r = EPI_ROWS(ai, m); float sq = 0.f;
#pragma unroll
                for (int bj = 0; bj < 2; ++bj) { const size_t off = (size_t)r * 1024 + u.pn * BM + bj * HALF + wc * 32 + 8 * fq;
                    f32x4 h0, h1; unpack8(*(const u32x4*)(rin + off), h0, h1);
                    const f32x4 v0 = h0 + acc[ai][bj][m][0] * scale, v1 = h1 + acc[ai][bj][m][1] * scale;
                    *(u32x4*)(rout + off) = pack8(v0, v1);
                    sq += (v0[0] * v0[0] + v0[1] * v0[1]) + (v0[2] * v0[2] + v0[3] * v0[3]) + (v1[0] * v1[0] + v1[1] * v1[1]) + (v1[2] * v1[2] + v1[3] * v1[3]); }
                sq += __shfl_xor(sq, 16); sq += __shfl_xor(sq, 32); if (fq == 0) ssn[(size_t)r * 16 + u.pn * 4 + wc] = sq; }
    }
};
template <bool F32OUT> struct EpiPle { static constexpr bool PERM = true, AFTER_DRAIN = false; const bf16_t* rin; bf16_t* rout; float* fout; float* ssn; const float* ss; const bf16_t* pp;
    __device__ __forceinline__ void operator()(EPI_ARGS) const {
#pragma unroll
        for (int ai = 0; ai < 2; ++ai)
#pragma unroll
            for (int m = 0; m < 4; ++m) { const int r = EPI_ROWS(ai, m); const float ri = rinv_of(ss, r); float sq = 0.f;
#pragma unroll
                for (int bj = 0; bj < 2; ++bj) { const size_t off = (size_t)r * 1024 + u.pn * BM + bj * HALF + wc * 32 + 8 * fq;
                    f32x4 p0, p1, h0, h1; unpack8(*(const u32x4*)(pp + off), p0, p1); unpack8(*(const u32x4*)(rin + off), h0, h1);
                    const f32x4 v0 = h0 + sigm4(acc[ai][bj][m][0] * ri) * p0, v1 = h1 + sigm4(acc[ai][bj][m][1] * ri) * p1;
                    if (F32OUT) { *(f32x4*)(fout + off) = v0; *(f32x4*)(fout + off + 4) = v1; }
                    else { *(u32x4*)(rout + off) = pack8(v0, v1);
                        sq += (v0[0] * v0[0] + v0[1] * v0[1]) + (v0[2] * v0[2] + v0[3] * v0[3]) + (v1[0] * v1[0] + v1[1] * v1[1]) + (v1[2] * v1[2] + v1[3] * v1[3]); } }
                if (!F32OUT) { sq += __shfl_xor(sq, 16); sq += __shfl_xor(sq, 32); if (fq == 0) ssn[(size_t)r * 16 + u.pn * 4 + wc] = sq; } }
    }
};
struct EpiPlain { static constexpr bool PERM = true, AFTER_DRAIN = false; bf16_t* O; int ldc; const float* ss; int split_cols; size_t split_stride; float scale0;
    __device__ __forceinline__ void operator()(EPI_ARGS) const {
        int colt = u.pn * BM; bf16_t* base = O; float sc = 1.f;
        if (split_cols) { const int t = colt / split_cols; base += (size_t)t * split_stride; colt -= t * split_cols; if (t == 0) sc = scale0; }
        const int col0 = colt + wc * 32 + 8 * fq;
#pragma unroll
        for (int ai = 0; ai < 2; ++ai)
#pragma unroll
            for (int m = 0; m < 4; ++m) { const int r = EPI_ROWS(ai, m); const float ri = (ss ? rinv_of(ss, r) : 1.0f) * sc;
#pragma unroll
                for (int bj = 0; bj < 2; ++bj) *(u32x4*)(base + (size_t)r * ldc + col0 + bj * HALF) = pack8(acc[ai][bj][m][0] * ri, acc[ai][bj][m][1] * ri); }
    }
};
struct EpiRetIn { static constexpr bool PERM = true, AFTER_DRAIN = false; bf16_t* Qt; bf16_t* Kt; bf16_t* V; const float* ss; const float* rope  ;
    __device__ __forceinline__ void operator()(EPI_ARGS) const {
        const int pn = u.pn;
        if (pn >= 8) {
            const int col0 = (pn - 8) * BM + wc * 32 + 8 * fq;
#pragma unroll
            for (int ai = 0; ai < 2; ++ai)
#pragma unroll
                for (int m = 0; m < 4; ++m) { const int r = EPI_ROWS(ai, m); const float ri = rinv_of(ss, r);
#pragma unroll
                    for (int bj = 0; bj < 2; ++bj) *(u32x4*)(V + (size_t)r * 2048 + col0 + bj * HALF) = pack8(acc[ai][bj][m][0] * ri, acc[ai][bj][m][1] * ri); }
            return;
        }
        const bool isk = pn >= 4; const int hd = pn & 3; bf16_t* outp = isk ? Kt : Qt;
        const float lg = log2f(1.0f - exp2f(-5.0f - (float)hd));
        const int j0 = wc * 32 + 8 * fq;
#pragma unroll
        for (int ai = 0; ai < 2; ++ai)
#pragma unroll
            for (int m = 0; m < 4; ++m) { const int r = EPI_ROWS(ai, m); const int pos = r & 4095; const float e1 = (float)((pos & 63) + 1) * lg;
                const float f = rinv_of(ss, r) * (isk ? 0.0625f * exp2f(-e1) : exp2f(e1));
                const f32x4* cs = (const f32x4*)(rope + ((size_t)pos * 128 + j0) * 2);
                const f32x4 c01 = cs[0], c23 = cs[1], c45 = cs[2], c67 = cs[3];
                const f32x4 x10 = acc[ai][0][m][0] * f, x11 = acc[ai][0][m][1] * f, x20 = acc[ai][1][m][0] * f, x21 = acc[ai][1][m][1] * f;
                const f32x4 cc0 = (f32x4){c01[0], c01[2], c23[0], c23[2]}, sn0 = (f32x4){c01[1], c01[3], c23[1], c23[3]};
                const f32x4 cc1 = (f32x4){c45[0], c45[2], c67[0], c67[2]}, sn1 = (f32x4){c45[1], c45[3], c67[1], c67[3]};
                const f32x4 y10 = x10 * cc0 - x20 * sn0, y11 = x11 * cc1 - x21 * sn1, y20 = x10 * sn0 + x20 * cc0, y21 = x11 * sn1 + x21 * cc1;
                bf16_t* rowp = outp + (size_t)r * 1024 + hd * 256 + j0;
                *(u32x4*)(rowp) = pack8(y10, y11); *(u32x4*)(rowp + HALF) = pack8(y20, y21); }
    }
};
struct EpiRetGate { static constexpr bool PERM = true, AFTER_DRAIN = false; bf16_t* Y; const float* ss; const float* hss; const float* gnw;
    __device__ __forceinline__ void operator()(EPI_ARGS) const {
        const int hd = u.pn >> 1;
#pragma unroll
        for (int ai = 0; ai < 2; ++ai)
#pragma unroll
            for (int m = 0; m < 4; ++m) { const int r = EPI_ROWS(ai, m); const float ri = rinv_of(ss, r); const float hr = 1.0f / sqrtf(sum16(hss + ((size_t)r * 4 + hd) * 16) * (1.0f / 512.0f) + 1e-6f);
#pragma unroll
                for (int bj = 0; bj < 2; ++bj) { const int c = u.pn * BM + bj * HALF + wc * 32 + 8 * fq; bf16_t* p = Y + (size_t)r * 2048 + c;
                    f32x4 o0, o1; unpack8(*(const u32x4*)p, o0, o1);
                    const f32x4 g0 = *(const f32x4*)(gnw + c) * hr, g1 = *(const f32x4*)(gnw + c + 4) * hr;
                    *(u32x4*)p = pack8(silu4(acc[ai][bj][m][0] * ri) * o0 * g0, silu4(acc[ai][bj][m][1] * ri) * o1 * g1); }
            }
    }
};
template <class Epi, class Sched, bool ALIGN_EPI = false, bool SP2 = false>
__device__ __forceinline__ void gemm_phase(PG8_LAS unsigned char* lds, const Gemm g, const Sched& S, const Epi& E) {
    int tid_ = threadIdx.x; asm volatile("" : "+v"(tid_));
    const int tid = tid_, wid = __builtin_amdgcn_readfirstlane(tid >> 6), lane = tid & 63, wr = wid >> 2, wc = wid & 3, fr = lane & 15, fq = lane >> 4;
    const int K = g.K, nt = K / BK;
    unsigned voffA[2], voffB[2];
#pragma unroll
    for (int i = 0; i < 2; ++i) { int R, C; stage_rc(tid * 16 + i * 8192, R, C); const int Rb = Epi::PERM ? ((R & ~31) + perm32(R & 31)) : R;
        voffA[i] = (unsigned)(R * K + C) * 2u; voffB[i] = (unsigned)(Rb * K + C) * 2u; }
    const size_t kstep = (size_t)(BK * 2);
    const size_t hstep = (size_t)HALF * K * 2;
    const size_t tstep = 2 * hstep;
    const unsigned ldsw = (unsigned)wid * 1024u;
    const int aoff = lds_byte(wr * 64 + fr, fq * 8), boff = lds_byte(wc * 32 + fr, fq * 8);
#define PG8_SA(b, h) (((b) * 2 + (h)) * HTB)
#define PG8_SB(b, h) ((4 + (b) * 2 + (h)) * HTB)
#define PG8_STAGE(bufoff, gbase, voff) do { _Pragma("unroll") for (int _i = 0; _i < 2; ++_i) \
        __builtin_amdgcn_global_load_lds((const unsigned*)((const char*)(gbase) + (voff)[_i]), (PG8_LAS unsigned*)(lds + (bufoff) + ldsw + _i * 8192), 16, 0, 0); } while (0)
#define PG8_LDA(dst, b, h) do { _Pragma("unroll") for (int m = 0; m < 4; ++m) _Pragma("unroll") for (int k = 0; k < 2; ++k) dst[m][k] = *(const PG8_LAS bf16x8*)(lds + PG8_SA(b, h) + aoff + m * 2048 + k * 1024); } while (0)
#define PG8_LDB(dst, b, h) do { _Pragma("unroll") for (int n = 0; n < 2; ++n) _Pragma("unroll") for (int k = 0; k < 2; ++k) dst[n][k] = *(const PG8_LAS bf16x8*)(lds + PG8_SB(b, h) + boff + n * 2048 + k * 1024); } while (0)
#define PG8_MMA(ai, bj, At, Bt) do { __builtin_amdgcn_s_setprio(1); _Pragma("unroll") for (int m = 0; m < 4; ++m) _Pragma("unroll") for (int n = 0; n < 2; ++n) _Pragma("unroll") for (int k = 0; k < 2; ++k) \
        acc[ai][bj][m][n] = __builtin_amdgcn_mfma_f32_16x16x32_bf16(Bt[n][k], At[m][k], acc[ai][bj][m][n], 0, 0, 0); __builtin_amdgcn_s_setprio(0); } while (0)
#define PG8_WAIT_V(n) asm volatile("s_waitcnt vmcnt(" #n ")" ::: "memory")
#define PG8_WAIT_L(n) asm volatile("s_waitcnt lgkmcnt(" #n ")" ::: "memory")
#define PG8_BAR __builtin_amdgcn_s_barrier()
#define PG8_SCHED __builtin_amdgcn_sched_barrier(0)
    Unit cur, nxt; int ui = 0;
    if (!S.next(0, cur)) return;
    f32x4 acc[2][2][4][2];
#pragma unroll
    for (int a = 0; a < 2; ++a)
#pragma unroll
        for (int b = 0; b < 2; ++b)
#pragma unroll
            for (int m = 0; m < 4; ++m)
#pragma unroll
                for (int n = 0; n < 2; ++n) acc[a][b][m][n] = (f32x4){0.f, 0.f, 0.f, 0.f};
    bf16x8 At[4][2], B0[2][2], B1[2][2];
    const char* cA = (const char*)g.A + (size_t)cur.pm * tstep; const char* cB = (const char*)g.Bt + (size_t)cur.pn * tstep;
    S.a_ready(cur);
    if constexpr (SP2) {
        PG8_STAGE(PG8_SB(0, 0), cB, voffB); PG8_STAGE(PG8_SB(0, 1), cB + hstep, voffB); PG8_STAGE(PG8_SA(0, 0), cA, voffA); PG8_STAGE(PG8_SA(0, 1), cA + hstep, voffA);
        if (wr == 1) PG8_BAR;
        PG8_WAIT_V(2); PG8_BAR;
        PG8_STAGE(PG8_SB(1, 0), cB + kstep, voffB); PG8_STAGE(PG8_SA(1, 0), cA + kstep, voffA); PG8_STAGE(PG8_SB(1, 1), cB + hstep + kstep, voffB);
        PG8_WAIT_V(6); PG8_BAR;
    } else {
        PG8_STAGE(PG8_SB(0, 0), cB, voffB); PG8_STAGE(PG8_SA(0, 0), cA, voffA); PG8_STAGE(PG8_SB(0, 1), cB + hstep, voffB); PG8_STAGE(PG8_SA(0, 1), cA + hstep, voffA);
        if (wr == 1) PG8_BAR;
        PG8_WAIT_V(4); PG8_BAR;
        PG8_STAGE(PG8_SB(1, 0), cB + kstep, voffB); PG8_STAGE(PG8_SA(1, 0), cA + kstep, voffA); PG8_STAGE(PG8_SB(1, 1), cB + hstep + kstep, voffB);
        PG8_WAIT_V(6); PG8_BAR;
    }
    for (;;) {
        const bool has_next = S.next(ui + 1, nxt);
        const char* nA = has_next ? (const char*)g.A + (size_t)nxt.pm * tstep : cA; const char* nB = has_next ? (const char*)g.Bt + (size_t)nxt.pn * tstep : cB;
        for (int t = 0; t < nt; t += 2) {
            const bool last = (t == nt - 2);
            const char* a1 = cA + (size_t)(t + 1) * kstep;
            const char* a2 = last ? nA : cA + (size_t)(t + 2) * kstep; const char* b2 = last ? nB : cB + (size_t)(t + 2) * kstep;
            const char* a3 = a2 + kstep; const char* b3 = b2 + kstep;
            if (last && has_next) S.a_ready(nxt);
            if constexpr (SP2) {
            PG8_LDB(B0, 0, 0); PG8_LDB(B1, 0, 1); PG8_SCHED; PG8_LDA(At, 0, 0); PG8_STAGE(PG8_SA(1, 1), a1 + hstep, voffA);
            PG8_WAIT_V(8); PG8_WAIT_L(0); PG8_BAR; PG8_MMA(0, 0, At, B0); PG8_MMA(0, 1, At, B1); PG8_BAR; PG8_SCHED;
            PG8_LDA(At, 0, 1); PG8_STAGE(PG8_SB(0, 0), b2, voffB); PG8_STAGE(PG8_SB(0, 1), b2 + hstep, voffB); PG8_STAGE(PG8_SA(0, 0), a2, voffA);
            PG8_WAIT_V(8); PG8_WAIT_L(0); PG8_BAR; PG8_MMA(1, 0, At, B0); PG8_MMA(1, 1, At, B1); PG8_BAR; PG8_SCHED;
            PG8_LDB(B0, 1, 0); PG8_LDB(B1, 1, 1); PG8_SCHED; PG8_LDA(At, 1, 0); PG8_STAGE(PG8_SA(0, 1), a2 + hstep, voffA);
            PG8_WAIT_V(8); PG8_WAIT_L(0); PG8_BAR; PG8_MMA(0, 0, At, B0); PG8_MMA(0, 1, At, B1); PG8_BAR; PG8_SCHED;
            PG8_LDA(At, 1, 1); PG8_STAGE(PG8_SB(1, 0), b3, voffB); PG8_STAGE(PG8_SB(1, 1), b3 + hstep, voffB); PG8_STAGE(PG8_SA(1, 0), a3, voffA);
            PG8_WAIT_V(8); PG8_WAIT_L(0); PG8_BAR; PG8_MMA(1, 0, At, B0); PG8_MMA(1, 1, At, B1); PG8_BAR; PG8_SCHED;
            } else {
            PG8_LDB(B0, 0, 0); PG8_SCHED; PG8_LDA(At, 0, 0); PG8_STAGE(PG8_SA(1, 1), a1 + hstep, voffA);
            PG8_WAIT_L(8); PG8_BAR; PG8_WAIT_L(0); PG8_MMA(0, 0, At, B0); PG8_BAR; PG8_SCHED;
            PG8_LDB(B1, 0, 1); PG8_STAGE(PG8_SB(0, 0), b2, voffB);
            PG8_BAR; PG8_WAIT_L(0); PG8_MMA(0, 1, At, B1); PG8_BAR;
            PG8_LDA(At, 0, 1); PG8_STAGE(PG8_SA(0, 0), a2, voffA);
            PG8_BAR; PG8_WAIT_L(0); PG8_MMA(1, 0, At, B0); PG8_BAR; PG8_SCHED;
            PG8_STAGE(PG8_SB(0, 1), b2 + hstep, voffB);
            PG8_WAIT_V(6); PG8_BAR; PG8_MMA(1, 1, At, B1); PG8_BAR;
            PG8_LDB(B0, 1, 0); PG8_SCHED; PG8_LDA(At, 1, 0); PG8_STAGE(PG8_SA(0, 1), a2 + hstep, voffA);
            PG8_WAIT_L(8); PG8_BAR; PG8_WAIT_L(0); PG8_MMA(0, 0, At, B0); PG8_BAR; PG8_SCHED;
            PG8_LDB(B1, 1, 1); PG8_STAGE(PG8_SB(1, 0), b3, voffB);
            PG8_BAR; PG8_WAIT_L(0); PG8_MMA(0, 1, At, B1); PG8_BAR;
            PG8_LDA(At, 1, 1); PG8_STAGE(PG8_SA(1, 0), a3, voffA);
            PG8_BAR; PG8_WAIT_L(0); PG8_MMA(1, 0, At, B0); PG8_BAR; PG8_SCHED;
            PG8_STAGE(PG8_SB(1, 1), b3 + hstep, voffB);
            PG8_WAIT_V(6); PG8_BAR; PG8_MMA(1, 1, At, B1); PG8_BAR;
            }
        }
        if constexpr (ALIGN_EPI) { if (wr == 0) PG8_BAR; }
        if constexpr (!Epi::AFTER_DRAIN) { E(acc, cur, wr, wc, fr, fq); S.done(cur); }
        if (!has_next) break;
#pragma unroll
        for (int a = 0; a < 2; ++a)
#pragma unroll
            for (int b = 0; b < 2; ++b)
#pragma unroll
                for (int m = 0; m < 4; ++m)
#pragma unroll
                    for (int n = 0; n < 2; ++n) acc[a][b][m][n] = (f32x4){0.f, 0.f, 0.f, 0.f};
        cur = nxt; cA = nA; cB = nB; ++ui;
        if constexpr (ALIGN_EPI) { if (wr == 1) PG8_BAR; }
    }
    PG8_WAIT_V(0);
    if constexpr (!ALIGN_EPI) { if (wr == 0) PG8_BAR; }
    PG8_BAR;
    if constexpr (Epi::AFTER_DRAIN) { E.fused(acc, cur, wr, wc, fr, fq, lds, wid, lane); S.done(cur); }
#undef PG8_SA
#undef PG8_SB
#undef PG8_STAGE
#undef PG8_LDA
#undef PG8_LDB
#undef PG8_MMA
#undef PG8_WAIT_V
#undef PG8_WAIT_L
#undef PG8_BAR
#undef PG8_SCHED
}
}
#include <hip/hip_bf16.h>
#include <cmath>
namespace attn_body {
using bf16=__hip_bfloat16;
using bf16x8=__attribute__((ext_vector_type(8)))short;
using s16x4=__attribute__((ext_vector_type(4)))short;
using f32x16=__attribute__((ext_vector_type(16)))float;
using u32x4=__attribute__((ext_vector_type(4)))unsigned;
constexpr int BATCH=8,NHEAD=16,SEQ=4096,D=64,DM=NHEAD*D;
constexpr int NW=8,QBLK=32,QB=QBLK*NW,KVBLK=64,NQB=SEQ/QB;
constexpr int ATTN_PITCH=DM, ATTN_UNIT_ROWS=QB;
__device__ __forceinline__ int crow(int r,int hi){return (r&3)+8*(r>>2)+4*hi;}
#define SBAR() __builtin_amdgcn_sched_barrier(0)
__device__ __forceinline__ void cmask(f32x16&p0,f32x16&p1,int jb,int qrel,int hi){
  const float NEG=-INFINITY; int kb=64*jb+4*hi;
  #pragma unroll
  for(int r=0;r<16;++r){int kv=kb+(r&3)+8*(r>>2); if(kv>qrel)p0[r]=NEG; if(kv+32>qrel)p1[r]=NEG;}
}

constexpr int NSLOT=3, SLOTB=8192;
typedef float f32x4_t __attribute__((ext_vector_type(4)));
constexpr int LDS_K=0, LDS_V=NSLOT*SLOTB, LDS_WS=2*NSLOT*SLOTB, LDS_OST=LDS_WS+NW*64*4, LDS_NB=LDS_OST+NW*4096, LDS_BYTES=LDS_NB+SEQ*4;
constexpr float C2=0.125f*1.4426950408889634f;
__device__ __forceinline__ void glds16(const void*gsrc,unsigned lds_dst){unsigned keep;
  asm volatile("s_mov_b32 %0, m0\n\ts_mov_b32 m0, %2\n\ts_nop 0\n\tglobal_load_lds_dwordx4 %1, off\n\ts_mov_b32 m0, %0":"=&s"(keep):"v"(gsrc),"s"(lds_dst):"memory");}
__device__ __forceinline__ float max3f(float a,float b,float c){float r;asm("v_max3_f32 %0, %1, %2, %3":"=v"(r):"v"(a),"v"(b),"v"(c));return r;}
__device__ __forceinline__ float max2f(float a,float b){float r;asm("v_max_f32_e32 %0, %1, %2":"=v"(r):"v"(a),"v"(b));return r;}
__device__ __forceinline__ float fadd_s(float a,float b){float r;asm("v_add_f32_e32 %0, %1, %2":"=v"(r):"v"(a),"v"(b));return r;}
__device__ __forceinline__ float fsub_s(float a,float b){float r;asm("v_sub_f32_e32 %0, %1, %2":"=v"(r):"v"(a),"v"(b));return r;}
typedef float f32x2_t __attribute__((ext_vector_type(2))); typedef __bf16 bf16x2_t __attribute__((ext_vector_type(2)));
__device__ __forceinline__ unsigned cvtpk_s(float lo,float hi){f32x2_t v={lo,hi};bf16x2_t b=__builtin_convertvector(v,bf16x2_t);return __builtin_bit_cast(unsigned,b);}
#define WAIT_BAR(N) asm volatile("s_waitcnt vmcnt(" #N ") lgkmcnt(0)\n\ts_barrier":::"memory")

__device__ __forceinline__ void qkt(f32x16&p0,f32x16&p1,const char*Kslot,const bf16x8*qr,int r32,int hi){
  const char*kb=Kslot+hi*1024+r32*16;
  #pragma unroll
  for(int d0=0;d0<4;++d0){
    const bf16x8 b0=*reinterpret_cast<const bf16x8*>(kb+d0*2048);
    const bf16x8 b1=*reinterpret_cast<const bf16x8*>(kb+d0*2048+512);
    p0=__builtin_amdgcn_mfma_f32_32x32x16_bf16(b0,qr[d0],p0,0,0,0);p1=__builtin_amdgcn_mfma_f32_32x32x16_bf16(b1,qr[d0],p1,0,0,0);}
}
typedef __attribute__((address_space(3))) const char* lds_cptr;
typedef short v4i16_t __attribute__((ext_vector_type(4)));
__device__ __forceinline__ void kload8(bf16x8*kf,lds_cptr kp){
  kf[0]=*(const __attribute__((address_space(3))) bf16x8*)(kp);      kf[1]=*(const __attribute__((address_space(3))) bf16x8*)(kp+512);
  kf[2]=*(const __attribute__((address_space(3))) bf16x8*)(kp+2048); kf[3]=*(const __attribute__((address_space(3))) bf16x8*)(kp+2560);
  kf[4]=*(const __attribute__((address_space(3))) bf16x8*)(kp+4096); kf[5]=*(const __attribute__((address_space(3))) bf16x8*)(kp+4608);
  kf[6]=*(const __attribute__((address_space(3))) bf16x8*)(kp+6144); kf[7]=*(const __attribute__((address_space(3))) bf16x8*)(kp+6656);
}
__device__ __forceinline__ void kload2(bf16x8*kf,lds_cptr kp,int j){ kf[2*j]=*(const __attribute__((address_space(3))) bf16x8*)(kp+j*2048); kf[2*j+1]=*(const __attribute__((address_space(3))) bf16x8*)(kp+j*2048+512); }
__device__ __forceinline__ s16x4 vtr(lds_cptr p){ return __builtin_bit_cast(s16x4,__builtin_amdgcn_ds_read_tr16_b64_v4i16((__attribute__((address_space(3))) v4i16_t*)p)); }
__device__ __forceinline__ float rowmax(const f32x16&p0,const f32x16&p1){
  float a=max3f(p0[0],p0[1],p1[0]),b=max3f(p0[2],p0[3],p1[1]);a=max3f(a,p1[2],p1[3]);
  #pragma unroll
  for(int r=4;r<16;r+=4){a=max3f(a,p0[r],p0[r+1]);b=max3f(b,p0[r+2],p0[r+3]);a=max3f(a,p1[r],p1[r+1]);b=max3f(b,p1[r+2],p1[r+3]);}
  const float m=max2f(a,b);
  auto rr=__builtin_amdgcn_permlane32_swap(__float_as_uint(m),__float_as_uint(m),false,false);
  return max2f(__uint_as_float(rr[0]),__uint_as_float(rr[1]));
}
__device__ __forceinline__ void pv(f32x16*o,int vb,bf16x8 pa0,bf16x8 pa1,bf16x8 pa2,bf16x8 pa3){
  #pragma unroll
  for(int d0=0;d0<2;++d0){s16x4 lo[4],hi[4];
    #pragma unroll
    for(int ks=0;ks<4;++ks){
      asm volatile("ds_read_b64_tr_b16 %0,%1 offset:%c2":"=&v"(lo[ks]):"v"(vb),"i"(d0*4096+ks*1024):"memory");
      asm volatile("ds_read_b64_tr_b16 %0,%1 offset:%c2":"=&v"(hi[ks]):"v"(vb),"i"(d0*4096+ks*1024+512):"memory");}
    asm volatile("s_waitcnt lgkmcnt(0)":::"memory");SBAR();
    #define PK(k) (bf16x8){lo[k][0],lo[k][1],lo[k][2],lo[k][3],hi[k][0],hi[k][1],hi[k][2],hi[k][3]}
    o[d0]=__builtin_amdgcn_mfma_f32_32x32x16_bf16(pa0,PK(0),o[d0],0,0,0);
    o[d0]=__builtin_amdgcn_mfma_f32_32x32x16_bf16(pa1,PK(1),o[d0],0,0,0);
    o[d0]=__builtin_amdgcn_mfma_f32_32x32x16_bf16(pa2,PK(2),o[d0],0,0,0);
    o[d0]=__builtin_amdgcn_mfma_f32_32x32x16_bf16(pa3,PK(3),o[d0],0,0,0);
    #undef PK
  }
}

#ifndef ATTN_STORE16
#define ATTN_STORE16(p,v) (*(u32x4*)(p)=(v))
#endif
template<int THRL> __device__ __forceinline__ void attn_unit(int b,int h,int qb,const bf16*Q,const bf16*__restrict__ K,const bf16*__restrict__ V,bf16*O,char*shm){
  const __attribute__((address_space(3))) float* nbp=(const __attribute__((address_space(3))) float*)(lds_cptr)(shm+LDS_NB);
  #define BIASC(C0,C1,t) do{ const __attribute__((address_space(3))) float* bp_=nbp+(t)*64+4*hi; \
    _Pragma("unroll") for(int g_=0;g_<4;++g_){ const f32x4_t a_=*(const __attribute__((address_space(3))) f32x4_t*)(bp_+8*g_); const f32x4_t b_=*(const __attribute__((address_space(3))) f32x4_t*)(bp_+32+8*g_); \
      C0[4*g_]=a_[0]-mhat;C0[4*g_+1]=a_[1]-mhat;C0[4*g_+2]=a_[2]-mhat;C0[4*g_+3]=a_[3]-mhat; C1[4*g_]=b_[0]-mhat;C1[4*g_+1]=b_[1]-mhat;C1[4*g_+2]=b_[2]-mhat;C1[4*g_+3]=b_[3]-mhat; } }while(0)

  int tid_=threadIdx.x; asm volatile("":"+v"(tid_)); const int tid=tid_,lane=tid&63,r32=lane&31,hi=lane>>5; const int wid=__builtin_amdgcn_readfirstlane(tid>>6);
  const long rowbase=(long)b*SEQ; const int q0=qb*QB;
  const bf16*Qw=Q+(rowbase+q0+wid*QBLK)*DM+h*D;
  const bf16*Kh=K+rowbase*DM+h*D,*Vh=V+rowbase*DM+h*D;
  const unsigned lds0=(unsigned)(uintptr_t)shm;
  float*wsf=(float*)(shm+LDS_WS)+wid*64;
  const bf16*ksrc=Kh+(long)lane*DM+wid*8;
  const bf16*vsrc=Vh+(long)(16*(wid&3)+(lane>>2))*DM+(wid>>2)*32+(lane&3)*8;
  const unsigned kdst=lds0+LDS_K+wid*1024, vdst=lds0+LDS_V+wid*1024;
  #define DMA_K(t,slot) glds16(ksrc+(long)(t)*KVBLK*DM,(unsigned)__builtin_amdgcn_readfirstlane(kdst+(slot)))
  #define DMA_V(t,slot) glds16(vsrc+(long)(t)*KVBLK*DM,(unsigned)__builtin_amdgcn_readfirstlane(vdst+(slot)))
  const int vb0=(int)(lds0+LDS_V)+((lane>>4)&1)*32+(lane&3)*8+(4*hi+((lane&15)>>2))*64;
  const char*Kbase=shm+LDS_K; bf16x8 kf[8];
  const lds_cptr shm3=(lds_cptr)shm; const lds_cptr kp0=shm3+LDS_K+hi*1024+r32*16; const lds_cptr vp0=shm3+LDS_V+((lane>>4)&1)*32+(lane&3)*8+(4*hi+((lane&15)>>2))*64;
  const int NT=(q0+QB)/KVBLK;
  DMA_K(0,0);DMA_V(0,0);DMA_K(1,SLOTB);
  bf16x8 qr[4];
  #pragma unroll
  for(int d0=0;d0<4;++d0)qr[d0]=*reinterpret_cast<const bf16x8*>(&Qw[(long)r32*DM+d0*16+hi*8]);
  float mhat=0.f,l_reg=0.f;f32x16 o[2];o[0]=f32x16{};o[1]=f32x16{};
  const int qrel=wid*QBLK+r32;
  #define CMASK(P0,P1,t) do{int jb_=(t)-(NT-4); if(jb_>=0)cmask(P0,P1,jb_,qrel,hi);}while(0)
  bool resc=false;
  #define START(P0,P1) do{ const float rm=rowmax(P0,P1); resc=false; \
    { const float dl=rm; mhat=fadd_s(mhat,dl); \
      _Pragma("unroll") for(int r=0;r<16;++r){P0[r]=fsub_s(P0[r],dl);P1[r]=fsub_s(P1[r],dl);} \
      } \
    _Pragma("unroll") for(int r=0;r<16;++r)P0[r]=__builtin_amdgcn_exp2f(P0[r]); }while(0)
  #define RESC() do{ if(resc){ asm volatile("s_waitcnt lgkmcnt(0)":::"memory"); \
      _Pragma("unroll") for(int d_=0;d_<2;++d_) _Pragma("unroll") for(int r=0;r<16;++r)o[d_][r]*=wsf[crow(r,hi)]; } }while(0)
  f32x16 pA0,pA1,pB0,pB1;
  int sl_prev=0,sl_cur=0,sl_next=SLOTB;
  #define ROT() do{sl_prev=sl_cur;sl_cur=sl_next;sl_next=(sl_next==(NSLOT-1)*SLOTB)?0:sl_next+SLOTB;}while(0)
  DMA_K(2,2*SLOTB);
  WAIT_BAR(3);
  BIASC(pA0,pA1,0); qkt(pA0,pA1,Kbase,qr,r32,hi);asm volatile("s_nop 15\n\ts_nop 7":"+v"(pA0),"+v"(pA1));CMASK(pA0,pA1,0);
  START(pA0,pA1);
  _Pragma("unroll") for(int r=0;r<16;++r)pA1[r]=__builtin_amdgcn_exp2f(pA1[r]);
  WAIT_BAR(0);
  DMA_K(3,0);DMA_V(1,SLOTB);
  ROT();
  kload8(kf,kp0+sl_cur);
  WAIT_BAR(2);
  s16x4 vlo[8],vhi[8]; u32x4 pw0,pw1,pw2,pw3;
  #define PKW(P,B) cvtpk_s(P[B],P[B+1])
  #define PAF(k) __builtin_bit_cast(bf16x8,pw##k)
  #define VFR(i) (bf16x8){vlo[i][0],vlo[i][1],vlo[i][2],vlo[i][3],vhi[i][0],vhi[i][1],vhi[i][2],vhi[i][3]}
  #define PIN(x) asm volatile("":"+v"(x))
  #define MX3(a,b,c) __builtin_fmaxf(__builtin_fmaxf((a),(b)),(c))
  #define GAPA(MF,A0,A1,A2,A3,W0,W1,PW) do{ MF; sacc+=A0; sacc+=A1; sacc+=A2; sacc+=A3; PIN(sacc); W0; W1; PIN(PW); SBAR(); }while(0)
  #define EX(v) __builtin_amdgcn_exp2f(v)
  #define GAPB(MF,X,B) do{ MF; X[B]=EX(X[B]); X[B+1]=EX(X[B+1]); X[B+2]=EX(X[B+2]); X[B+3]=EX(X[B+3]); PIN(X); SBAR(); }while(0)
  #define VRD(i) do{ vlo[i]=vtr(vp_+(((i)>>2)*4096+((i)&3)*1024)); vhi[i]=vtr(vp_+(((i)>>2)*4096+((i)&3)*1024+512)); }while(0)
  #define KRD(G,j) do{ if(G){ kload2(kf,kp0+sl_next,j); SBAR(); } }while(0)
  #define STEP(C0,C1,P0,P1,t,GK,GV,GL) do{ SBAR(); BIASC(C0,C1,t); SBAR(); \
    const lds_cptr vp_=vp0+sl_prev; \
    VRD(0); SBAR(); float sacc=(P0[0]+P0[1]); \
    GAPA(C0=__builtin_amdgcn_mfma_f32_32x32x16_bf16(kf[0],qr[0],C0,0,0,0), P0[2],P0[3],P0[4],P0[5],     pw0[0]=PKW(P0,0), pw0[1]=PKW(P0,2), pw0); \
    VRD(4); SBAR(); GAPA(C1=__builtin_amdgcn_mfma_f32_32x32x16_bf16(kf[1],qr[0],C1,0,0,0), P0[6],P0[7],P0[8],P0[9],     pw0[2]=PKW(P0,4), pw0[3]=PKW(P0,6), pw0); \
    VRD(1); SBAR(); GAPA(C0=__builtin_amdgcn_mfma_f32_32x32x16_bf16(kf[2],qr[1],C0,0,0,0),   P0[10],P0[11],P0[12],P0[13], pw1[0]=PKW(P0,8), pw1[1]=PKW(P0,10), pw1); \
    VRD(5); SBAR(); GAPA(C1=__builtin_amdgcn_mfma_f32_32x32x16_bf16(kf[3],qr[1],C1,0,0,0),   P0[14],P0[15],P1[0],P1[1],   pw1[2]=PKW(P0,12),pw1[3]=PKW(P0,14), pw1); \
    VRD(2); SBAR(); GAPA(C0=__builtin_amdgcn_mfma_f32_32x32x16_bf16(kf[4],qr[2],C0,0,0,0),   P1[2],P1[3],P1[4],P1[5],     pw2[0]=PKW(P1,0), pw2[1]=PKW(P1,2), pw2); \
    VRD(6); SBAR(); GAPA(C1=__builtin_amdgcn_mfma_f32_32x32x16_bf16(kf[5],qr[2],C1,0,0,0),   P1[6],P1[7],P1[8],P1[9],     pw2[2]=PKW(P1,4), pw2[3]=PKW(P1,6), pw2); \
    VRD(3); SBAR(); GAPA(C0=__builtin_amdgcn_mfma_f32_32x32x16_bf16(kf[6],qr[3],C0,0,0,0),   P1[10],P1[11],P1[12],P1[13], pw3[0]=PKW(P1,8), pw3[1]=PKW(P1,10), pw3); \
    VRD(7); SBAR(); GAPA(C1=__builtin_amdgcn_mfma_f32_32x32x16_bf16(kf[7],qr[3],C1,0,0,0),   P1[14],P1[15],0.f,0.f,       pw3[2]=PKW(P1,12),pw3[3]=PKW(P1,14), pw3); \
    l_reg+=sacc; \
    if(GK){DMA_K((t)+3,sl_cur);} if(GV){DMA_V((t)+1,sl_next);} \
    CMASK(C0,C1,t); \
    { float a=MX3(C0[0],C0[1],C1[0]),b=MX3(C0[2],C0[3],C1[1]); a=MX3(a,C1[2],C1[3]); \
      _Pragma("unroll") for(int r=4;r<16;r+=4){a=MX3(a,C0[r],C0[r+1]);b=MX3(b,C0[r+2],C0[r+3]);a=MX3(a,C1[r],C1[r+1]);b=MX3(b,C1[r+2],C1[r+3]);} \
      float rm=__builtin_fmaxf(a,b); { auto rr=__builtin_amdgcn_permlane32_swap(__float_as_uint(rm),__float_as_uint(rm),false,false); rm=__builtin_fmaxf(__uint_as_float(rr[0]),__uint_as_float(rr[1])); } \
      resc=false; \
      if(__builtin_expect(__any(rm>(float)THRL),0)){ const float dl=__builtin_fmaxf(rm,0.f); mhat+=dl; \
        _Pragma("unroll") for(int r=0;r<16;++r){C0[r]-=dl;C1[r]-=dl;} \
        const float f=__builtin_amdgcn_exp2f(-dl); l_reg*=f; if(hi==0)wsf[r32]=f; resc=true; } } \
    SBAR(); \
    GAPB(o[0]=__builtin_amdgcn_mfma_f32_32x32x16_bf16(PAF(0),VFR(0),o[0],0,0,0), C0,0); \
    GAPB(o[1]=__builtin_amdgcn_mfma_f32_32x32x16_bf16(PAF(0),VFR(4),o[1],0,0,0), C0,4); \
    KRD(GL,0); GAPB(o[0]=__builtin_amdgcn_mfma_f32_32x32x16_bf16(PAF(1),VFR(1),o[0],0,0,0), C0,8); \
    KRD(GL,1); GAPB(o[1]=__builtin_amdgcn_mfma_f32_32x32x16_bf16(PAF(1),VFR(5),o[1],0,0,0), C0,12); \
    KRD(GL,2); GAPB(o[0]=__builtin_amdgcn_mfma_f32_32x32x16_bf16(PAF(2),VFR(2),o[0],0,0,0), C1,0); \
    KRD(GL,3); GAPB(o[1]=__builtin_amdgcn_mfma_f32_32x32x16_bf16(PAF(2),VFR(6),o[1],0,0,0), C1,4); \
    GAPB(o[0]=__builtin_amdgcn_mfma_f32_32x32x16_bf16(PAF(3),VFR(3),o[0],0,0,0), C1,8); \
    GAPB(o[1]=__builtin_amdgcn_mfma_f32_32x32x16_bf16(PAF(3),VFR(7),o[1],0,0,0), C1,12); \
    }while(0)
  int t=1;
  #undef CMASK
  #define CMASK(P0,P1,t) do{}while(0)
  for(;t+5<NT;t+=2){
    STEP(pB0,pB1,pA0,pA1,t,true,true,true);     WAIT_BAR(2); RESC(); ROT();
    STEP(pA0,pA1,pB0,pB1,t+1,true,true,true);   WAIT_BAR(2); RESC(); ROT();
  }
  #undef CMASK
  #define CMASK(P0,P1,t) do{int jb_=(t)-(NT-4); if(jb_>=0)cmask(P0,P1,jb_,qrel,hi);}while(0)
  #define ENDW(tt) do{ if((tt)+3<NT){WAIT_BAR(2);} else if((tt)+2<NT){WAIT_BAR(1);} else {WAIT_BAR(0);} }while(0)
  for(;t+1<NT;t+=2){
    STEP(pB0,pB1,pA0,pA1,t,(t+3<NT),(t+1<NT),(t+1<NT));       ENDW(t);   RESC(); ROT();
    STEP(pA0,pA1,pB0,pB1,t+1,(t+4<NT),(t+2<NT),(t+2<NT));     ENDW(t+1); RESC(); ROT();
  }
  STEP(pB0,pB1,pA0,pA1,NT-1,false,false,false); RESC();
  { float sacc=pB0[0]+pB0[1]; _Pragma("unroll") for(int r=2;r<16;++r)sacc+=pB0[r]; _Pragma("unroll") for(int r=0;r<16;++r)sacc+=pB1[r]; l_reg+=sacc;
    pw0=(u32x4){PKW(pB0,0),PKW(pB0,2),PKW(pB0,4),PKW(pB0,6)};pw1=(u32x4){PKW(pB0,8),PKW(pB0,10),PKW(pB0,12),PKW(pB0,14)};pw2=(u32x4){PKW(pB1,0),PKW(pB1,2),PKW(pB1,4),PKW(pB1,6)};pw3=(u32x4){PKW(pB1,8),PKW(pB1,10),PKW(pB1,12),PKW(pB1,14)};
    SBAR(); pv(o,vb0+sl_cur,PAF(0),PAF(1),PAF(2),PAF(3)); }
  #undef PKW
  #undef PAF
  #undef VFR
  #undef PIN
  #undef MX3
  #undef GAPA
  #undef GAPB
  #undef EX
  #undef VRD
  #undef KRD
  #undef STEP
  #undef ENDW
  {auto rr=__builtin_amdgcn_permlane32_swap(__float_as_uint(l_reg),__float_as_uint(l_reg),false,false);l_reg=__uint_as_float(rr[0])+__uint_as_float(rr[1]);}
  if(hi==0)wsf[32+r32]=l_reg;asm volatile("s_waitcnt lgkmcnt(0)":::"memory");
  float rli[16];
  #pragma unroll
  for(int r=0;r<16;++r)rli[r]=__builtin_amdgcn_rcpf(wsf[32+crow(r,hi)]);
  bf16*Ow=O+(rowbase+q0+wid*QBLK)*DM+h*D;
  { bf16*stg=(bf16*)(shm+LDS_OST)+wid*2048;
    #pragma unroll
    for(int r=0;r<16;++r){const int orow=crow(r,hi);
      #pragma unroll
      for(int d0=0;d0<2;++d0)stg[orow*64+d0*32+r32]=__float2bfloat16(o[d0][r]*rli[r]);}
    asm volatile("s_waitcnt lgkmcnt(0)":::"memory");
    #pragma unroll
    for(int i=0;i<4;++i){const int row=i*8+(lane>>3),ch=lane&7; const u32x4 v=*(const u32x4*)(stg+row*64+ch*8); ATTN_STORE16(Ow+(long)row*DM+ch*8,v);} }
  asm volatile("s_waitcnt lgkmcnt(0)\n\ts_barrier":::"memory");
  #undef BIASC
  #undef DMA_K
  #undef DMA_V
  #undef CMASK
  #undef START
  #undef RESC
  #undef ROT
}
constexpr int ATTN_LDS_BYTES=LDS_BYTES;
struct AttnTensors { const bf16* Q; const bf16* K; const bf16* V; bf16* O; };
struct AttnUnit { int bh; int qb; };
struct StaticOrder {
  int vcu;
  __device__ __forceinline__ explicit StaticOrder(int grid,int block):vcu((block%8)*(grid/8)+block/8){}
  __device__ __forceinline__ bool next(int i,AttnUnit&u)const{ if(i>=8)return false; const int p=vcu&1; u.bh=vcu>>1; const int base=4*(i>>1); u.qb=(i&1)?base+3-p:base+p; return true; }
  __device__ __forceinline__ void a_ready(const AttnUnit&)const{}
  __device__ __forceinline__ void done(const AttnUnit&)const{}
};
template<class Sched,int THRL=8> __device__ __forceinline__ void attn_phase(char*lds,const AttnTensors&T,const Sched&S){
  AttnUnit u;
  for(int i=0;S.next(i,u);++i){ S.a_ready(u); attn_unit<THRL>(u.bh/NHEAD,u.bh%NHEAD,u.qb,T.Q,T.K,T.V,T.O,lds); S.done(u); }
}
#undef SBAR
#undef WAIT_BAR
}
#define XB_TMO      128
#define XB_XCNT(j)  (256  + 64 * (j))
#define XB_XSUB(j)  (1280 + 64 * (j))
#define XB_XGEN(j)  (2304 + 64 * (j))
#define XB_TOP      3328
#define XB_TOPGEN   3392
#define XCD_BAR_WORDS 3456
#define XB_SPIN_CAP (1u << 18)

__device__ __forceinline__ unsigned xb_ld(unsigned* p)              { return __hip_atomic_load(p, __ATOMIC_RELAXED, __HIP_MEMORY_SCOPE_AGENT); }
__device__ __forceinline__ unsigned xb_add(unsigned* p, unsigned v) { return __hip_atomic_fetch_add(p, v, __ATOMIC_RELAXED, __HIP_MEMORY_SCOPE_AGENT); }
__device__ __forceinline__ unsigned xb_xcc_id() { return (unsigned)__builtin_amdgcn_s_getreg((3 << 11) | 20) & 0xFu; }
#define XB_SPIN(cond, bar) do { unsigned _sp = 0; while (cond) { __builtin_amdgcn_s_sleep(1); \
    if ((++_sp & 255u) == 0u) { if (xb_ld(&(bar)[XB_TMO])) break; if (_sp > XB_SPIN_CAP) { atomicAdd(&(bar)[XB_TMO], 1u); break; } } } } while (0)

struct XcdBarrier {
    unsigned* bar; unsigned x;
    volatile LAS unsigned* st;
};

__device__ __forceinline__ XcdBarrier xcd_barrier_post(unsigned* bar, volatile LAS unsigned* st) {
    XcdBarrier b; b.bar = bar; b.x = xb_xcc_id(); b.st = st;
    if (threadIdx.x == 0) (void)xb_add(&bar[XB_XCNT(b.x)], 1u);
    return b;
}
__device__ __forceinline__ void xcd_barrier_complete(unsigned* bar, unsigned x, unsigned& nloc, unsigned& nx) {
    const unsigned G = gridDim.x * gridDim.y * gridDim.z;
    unsigned sum, cnt, mine, sp = 0u;
    for (;;) {
        sum = 0u; cnt = 0u; mine = 0u;
#pragma unroll
        for (unsigned j = 0; j < 16; ++j) { const unsigned c = xb_ld(&bar[XB_XCNT(j)]); sum += c; cnt += (c > 0u) ? 1u : 0u; mine = (j == x) ? c : mine; }
        if (sum == G) break;
        __builtin_amdgcn_s_sleep(1);
        if ((++sp & 255u) == 0u) { if (xb_ld(&bar[XB_TMO])) break; if (sp > XB_SPIN_CAP) { atomicAdd(&bar[XB_TMO], 1u); break; } }
    }
    nloc = mine > 0u ? mine : 1u; nx = cnt > 0u ? cnt : 1u;
}

__device__ __forceinline__ void xcd_barrier(const XcdBarrier& b) {
    asm volatile("s_waitcnt vmcnt(0)" ::: "memory");
    __syncthreads();
    if (threadIdx.x == 0) {
        unsigned* bar = b.bar;
        __builtin_amdgcn_s_waitcnt(0);
        unsigned nloc = b.st[0], nx = b.st[1];
        if (nloc == 0u) { xcd_barrier_complete(bar, b.x, nloc, nx); b.st[0] = nloc; b.st[1] = nx; }
        const unsigned old = xb_add(&bar[XB_XSUB(b.x)], 1u);
        const unsigned gen = old / nloc;
        if (old + 1u == (gen + 1u) * nloc) {
            __builtin_amdgcn_fence(__ATOMIC_RELEASE, "agent");
            asm volatile("s_waitcnt vmcnt(0)" ::: "memory");
            const unsigned og = xb_add(&bar[XB_TOP], 1u);
            const unsigned tg = og / nx;
            if (og + 1u == (tg + 1u) * nx) xb_add(&bar[XB_TOPGEN], 1u);
            else XB_SPIN(xb_ld(&bar[XB_TOPGEN]) == tg, bar);
            __builtin_amdgcn_fence(__ATOMIC_ACQUIRE, "agent");
            xb_add(&bar[XB_XGEN(b.x)], 1u);
            asm volatile("s_waitcnt vmcnt(0)" ::: "memory");
        } else {
            XB_SPIN(xb_ld(&bar[XB_XGEN(b.x)]) == gen, bar);
            __builtin_amdgcn_fence(__ATOMIC_ACQUIRE, "agent");
            asm volatile("s_waitcnt vmcnt(0)" ::: "memory");
        }
    }
    __syncthreads();
}
constexpr int BATCH = 8, SEQ = 4096, DM = 1024, T = BATCH * SEQ, DFF = 2816, DPLE = 256;
constexpr int NWAVES = 8;
typedef unsigned short bf16;
typedef unsigned v4u __attribute__((ext_vector_type(4)));
typedef unsigned v2u __attribute__((ext_vector_type(2)));
typedef float f32x4 __attribute__((ext_vector_type(4)));
typedef short bf16x8 __attribute__((ext_vector_type(8)));
typedef short v4i16 __attribute__((ext_vector_type(4)));
__device__ __forceinline__ unsigned f2bf(float f) { unsigned u = __builtin_bit_cast(unsigned, f); return (u + 0x7fffu + ((u >> 16) & 1u)) >> 16; }
__device__ __forceinline__ unsigned pk2(float lo, float hi) { return f2bf(lo) | (f2bf(hi) << 16); }

constexpr size_t MiB = 1u << 20;
constexpr size_t WS_SS = 456 * MiB;
constexpr size_t WS_HSS = 474 * MiB;
constexpr size_t WS_BAR = 1856 * 1024;
constexpr size_t WS_LOGF = 2 * MiB;
constexpr size_t WS_ROPE = 4 * MiB;
constexpr size_t WS_WFFI = 8 * MiB;
constexpr size_t WS_WFFO = 52 * MiB;
constexpr size_t WS_WRIN = 74 * MiB;
constexpr size_t WS_WRG = 82 * MiB;
constexpr size_t WS_WRO = 86 * MiB;
constexpr size_t WS_WFIN = 90 * MiB;
constexpr size_t WS_WFZ = 96 * MiB;
constexpr size_t WS_WFO = 97 * MiB;
constexpr size_t WS_WPG = 99 * MiB;
constexpr size_t WS_WPP = 103 * MiB;
constexpr size_t WS_HB = 104 * MiB;
constexpr size_t WS_PB = 168 * MiB;
constexpr size_t WS_POOL = 200 * MiB;
constexpr size_t WS_END = 482 * MiB;
constexpr int LDS_BYTES = 147456, RING_BYTES = 131072;

namespace ret {
constexpr int KP = 544, VP = 144, PPI = 144;
constexpr int L_K = 0, L_V = L_K + 64 * KP, L_P = L_V + 64 * VP, L_ST = L_P + 64 * PPI, L_END = L_ST + 64 * KP;
static_assert(L_END <= RING_BYTES, "retention LDS");
#define MFMA16(a, b, c) __builtin_amdgcn_mfma_f32_16x16x32_bf16((a), (b), (c), 0, 0, 0)
__device__ __forceinline__ bf16x8 trfrag(const LAS char* p, int pitch) {
    const v4i16 lo = __builtin_amdgcn_ds_read_tr16_b64_v4i16((LAS v4i16*)p), hi = __builtin_amdgcn_ds_read_tr16_b64_v4i16((LAS v4i16*)(p + 4 * pitch));
    return (bf16x8){lo[0], lo[1], lo[2], lo[3], hi[0], hi[1], hi[2], hi[3]};
}
__device__ __forceinline__ void ret_phase(LAS char* L, const bf16* Qt, const bf16* Kt, bf16* VO, float* hss, int vcu, bool live = true) {
    int tid_ = threadIdx.x; asm volatile("" : "+v"(tid_));
    const int tid = tid_, lane = tid & 63, w = __builtin_amdgcn_readfirstlane(tid >> 6), m16 = lane & 15, g = lane >> 4, q4 = m16 >> 2, p4 = lane & 3;
    const int ib = w >> 1, half = w & 1;
    const int bh = vcu >> 3, es = vcu & 7, b = bh >> 2, h = bh & 3;
    const float lg = log2f(1.0f - exp2f(-5.0f - (float)h)), gC = exp2f(64.0f * lg);
    const size_t tok0 = (size_t)b * SEQ;
    const bf16* kbase = Kt + tok0 * 1024 + h * 256 + (size_t)(tid >> 5) * 1024 + (tid & 31) * 8;
    const bf16* vbase = VO + tok0 * 2048 + h * 512 + es * 64 + (size_t)(tid >> 3) * 2048 + (tid & 7) * 8;
    const bf16* qbase = Qt + tok0 * 1024 + h * 256 + (size_t)(16 * ib + m16) * 1024 + 8 * g;
    for (int i = tid; i < 64 * KP / 16; i += 512) *(LAS v4u*)(L + L_ST + 16 * i) = (v4u){0u, 0u, 0u, 0u};
    f32x4 st[2][4];
#pragma unroll
    for (int a = 0; a < 2; ++a)
#pragma unroll
        for (int e = 0; e < 4; ++e) st[a][e] = (f32x4){0.f, 0.f, 0.f, 0.f};
    v4u kreg[4], vreg; bf16x8 qn[8];
#define RET_LOAD(c) do { _Pragma("unroll") for (int u_ = 0; u_ < 4; ++u_) kreg[u_] = *(const v4u*)(kbase + (size_t)((c) * 64 + 16 * u_) * 1024); \
        vreg = *(const v4u*)(vbase + (size_t)(c) * 64 * 2048); \
        _Pragma("unroll") for (int s_ = 0; s_ < 8; ++s_) qn[s_] = *(const bf16x8*)(qbase + (size_t)(c) * 64 * 1024 + 32 * s_); } while (0)
    RET_LOAD(0);
    const int troff_k = (8 * g + q4) * KP + 8 * p4, troff_v = (8 * g + q4) * VP + 8 * p4;
    for (int c = 0; c < 64; ++c) {
#pragma unroll
        for (int u_ = 0; u_ < 4; ++u_) *(LAS v4u*)(L + L_K + ((tid >> 5) + 16 * u_) * KP + (tid & 31) * 16) = kreg[u_];
        *(LAS v4u*)(L + L_V + (tid >> 3) * VP + (tid & 7) * 16) = vreg;
        bf16x8 qf[8];
#pragma unroll
        for (int s = 0; s < 8; ++s) qf[s] = qn[s];
        __syncthreads();
        if (c + 1 < 64) RET_LOAD(c + 1);
#pragma unroll
        for (int jj = 0; jj < 2; ++jj) { const int jb = 2 * half + jj; f32x4 sa = (f32x4){0.f, 0.f, 0.f, 0.f};
#pragma unroll
            for (int s = 0; s < 8; ++s) { const bf16x8 a = *(const LAS bf16x8*)(L + L_K + (16 * jb + m16) * KP + (32 * s + 8 * g) * 2); sa = MFMA16(a, qf[s], sa); }
            const int il = 16 * ib + m16, j0 = 16 * jb + 4 * g;
            const float s0 = (j0 + 0 <= il) ? sa[0] : 0.f, s1 = (j0 + 1 <= il) ? sa[1] : 0.f, s2 = (j0 + 2 <= il) ? sa[2] : 0.f, s3 = (j0 + 3 <= il) ? sa[3] : 0.f;
            *(LAS v2u*)(L + L_P + il * PPI + j0 * 2) = (v2u){pk2(s0, s1), pk2(s2, s3)}; }
        f32x4 oa[2];
#pragma unroll
        for (int ee = 0; ee < 2; ++ee) { const int eb = 2 * half + ee; oa[ee] = (f32x4){0.f, 0.f, 0.f, 0.f};
#pragma unroll
            for (int s = 0; s < 8; ++s) { const bf16x8 a = *(const LAS bf16x8*)(L + L_ST + (16 * eb + m16) * KP + (32 * s + 8 * g) * 2); oa[ee] = MFMA16(a, qf[s], oa[ee]); } }
        __syncthreads();
        bf16x8 vt[2][4];
#pragma unroll
        for (int ks = 0; ks < 2; ++ks)
#pragma unroll
            for (int eb = 0; eb < 4; ++eb) vt[ks][eb] = trfrag(L + L_V + (32 * ks) * VP + (16 * eb) * 2 + troff_v, VP);
#pragma unroll
        for (int ks = 0; ks < 2; ++ks) { const bf16x8 pf = *(const LAS bf16x8*)(L + L_P + (16 * ib + m16) * PPI + (32 * ks + 8 * g) * 2);
            if (half == 0) { oa[0] = MFMA16(vt[ks][0], pf, oa[0]); oa[1] = MFMA16(vt[ks][1], pf, oa[1]); }
            else           { oa[0] = MFMA16(vt[ks][2], pf, oa[0]); oa[1] = MFMA16(vt[ks][3], pf, oa[1]); } }
        { const size_t tok = tok0 + (size_t)c * 64 + 16 * ib + m16; float sq = 0.f;
#pragma unroll
            for (int ee = 0; ee < 2; ++ee) { const f32x4 o = oa[ee]; sq += (o[0] * o[0] + o[1] * o[1]) + (o[2] * o[2] + o[3] * o[3]);
                if (live) *(v2u*)(VO + tok * 2048 + h * 512 + es * 64 + 16 * (2 * half + ee) + 4 * g) = (v2u){pk2(o[0], o[1]), pk2(o[2], o[3])}; }
            sq += __shfl_xor(sq, 16); sq += __shfl_xor(sq, 32); if (g == 0 && live) hss[(tok * 4 + h) * 16 + es * 2 + half] = sq; }
#pragma unroll
        for (int ks = 0; ks < 2; ++ks)
#pragma unroll
            for (int dd = 0; dd < 2; ++dd) { const bf16x8 kt = trfrag(L + L_K + (32 * ks) * KP + (16 * (2 * w + dd)) * 2 + troff_k, KP);
#pragma unroll
                for (int eb = 0; eb < 4; ++eb) st[dd][eb] = MFMA16(kt, vt[ks][eb], st[dd][eb]); }
#pragma unroll
        for (int dd = 0; dd < 2; ++dd)
#pragma unroll
            for (int eb = 0; eb < 4; ++eb) { st[dd][eb] = st[dd][eb] * gC; const f32x4 s = st[dd][eb];
                *(LAS v2u*)(L + L_ST + (16 * eb + m16) * KP + (16 * (2 * w + dd) + 4 * g) * 2) = (v2u){pk2(s[0], s[1]), pk2(s[2], s[3])}; }
        __syncthreads();
    }
#undef RET_LOAD
}
}

struct Args { const float* in[14]; float* out; unsigned char* ws; };
struct Frame { LAS unsigned char* lds; int tid, lane, wave, vcu, G; };

__device__ __forceinline__ float wave_sum(float v) {
#pragma unroll
    for (int o = 1; o < 64; o <<= 1) v += __shfl_xor(v, o);
    return v;
}
__device__ __forceinline__ void prep_item(const float* W, int K, int Nsrc, bf16* WT, int rows, int mode, int coloff, const float* ks, LAS float* scr, int item, int lane) {
    const int nblk = rows / 32, kb = item / nblk, nb = item % nblk, k0 = 64 * kb, n0 = 32 * nb;
    const int src0 = mode ? (((n0 >> 7) & 1) * DFF + 128 * (n0 >> 8) + (n0 & 127)) : (coloff + n0);
    float wv[32];
#pragma unroll
    for (int i = 0; i < 32; ++i) { const int kk = 2 * i + (lane >> 5); wv[i] = __builtin_nontemporal_load(W + (size_t)(k0 + kk) * Nsrc + src0 + (lane & 31)); }
#pragma unroll
    for (int i = 0; i < 32; ++i) { const int kk = 2 * i + (lane >> 5); scr[kk * 33 + (lane & 31)] = wv[i]; }
    asm volatile("s_waitcnt lgkmcnt(0)" ::: "memory");
    const int c = lane & 7;
    float sc[8];
#pragma unroll
    for (int x = 0; x < 8; ++x) sc[x] = ks ? ks[k0 + 8 * c + x] : 1.0f;
#pragma unroll
    for (int j = 0; j < 4; ++j) { const int n = (lane >> 3) + 8 * j; const LAS float* s = scr + (8 * c) * 33 + n;
        v4u o; o.x = pk2(s[0 * 33] * sc[0], s[1 * 33] * sc[1]); o.y = pk2(s[2 * 33] * sc[2], s[3 * 33] * sc[3]); o.z = pk2(s[4 * 33] * sc[4], s[5 * 33] * sc[5]); o.w = pk2(s[6 * 33] * sc[6], s[7 * 33] * sc[7]);
        *(v4u*)(WT + (size_t)(n0 + n) * K + k0 + 8 * c) = o; }
    asm volatile("s_waitcnt lgkmcnt(0)" ::: "memory");
}
#define PREP(Wp, K_, Nsrc_, WTp, rows_, mode_, coloff_, ksp) do { const int nit_ = ((K_) / 64) * ((rows_) / 32); \
    for (int it_ = gw; it_ < nit_; it_ += NGW) prep_item((Wp), (K_), (Nsrc_), (WTp), (rows_), (mode_), (coloff_), (ksp), scr, it_, F.lane); } while (0)

typedef const volatile __attribute__((address_space(4))) unsigned long long* kargp_t;
#define KARG(i) ((unsigned long long)(*((kargp_t)__builtin_amdgcn_kernarg_segment_ptr() + (i))))
#define KIN(i) ((const float*)KARG(i))
#define KOUT ((float*)KARG(14))
#define KWS ((unsigned char*)KARG(15))
#define SEAM() do { XcdBarrier b_; b_.bar = (unsigned*)(KWS + WS_BAR); b_.x = xb_xcc_id(); b_.st = (volatile LAS unsigned*)(F.lds + RING_BYTES) + 8; xcd_barrier(b_); } while (0)
#define GEMM_PHASE(EpiT, Aop, Bop, N_, K_, Eobj) do { pg8::Gemm g_{(const pg8::bf16_t*)(Aop), (const pg8::bf16_t*)(Bop), T, (N_), (K_)}; pg8::StaticOrder S_; S_.init(T, (N_), F.G, (int)blockIdx.x); \
        pg8::gemm_phase<EpiT, pg8::StaticOrder, true, true>(F.lds, g_, S_, (Eobj)); } while (0)

__device__ __forceinline__ void p0_prologue(const Frame& F) {
    unsigned char* ws = KWS;
    const float* norm_w = KIN(2);
    float* SS = (float*)(ws + WS_SS); float* HSS = (float*)(ws + WS_HSS);
    const int gw = F.vcu * NWAVES + F.wave, NGW = F.G * NWAVES, gtid = gw * 64 + F.lane, NGT = NGW * 64;
    LAS float* scr = (LAS float*)(F.lds + F.wave * 16384);
    { float* ROPE = (float*)(ws + WS_ROPE);
      for (int i = gtid; i < 4096 * 128; i += NGT) { const int pos = i >> 7, j = i & 127;
        const float inv = exp2f(-(float)j * (13.287712379549449f / 128.0f)); const float ang = (float)pos * inv;
        double tr = (double)ang * 0.15915494309189535; tr -= rint(tr); const float tf = (float)tr;
        ROPE[2 * i] = __builtin_amdgcn_cosf(tf); ROPE[2 * i + 1] = __builtin_amdgcn_sinf(tf); } }
    { const float* x = KIN(0); bf16* HB = (bf16*)(ws + WS_HB);
      for (int m = gw; m < T / 2; m += NGW) {
        f32x4 v[2][4];
#pragma unroll
        for (int rr = 0; rr < 2; ++rr)
#pragma unroll
            for (int j = 0; j < 4; ++j) v[rr][j] = __builtin_nontemporal_load((const f32x4*)(x + (size_t)(m + rr * (T / 2)) * DM) + F.lane + 64 * j);
#pragma unroll
        for (int rr = 0; rr < 2; ++rr) { float s = 0.f; unsigned long long* o8 = (unsigned long long*)(HB + (size_t)(m + rr * (T / 2)) * DM) + F.lane;
#pragma unroll
            for (int j = 0; j < 4; ++j) { const f32x4 q = v[rr][j]; s += (q.x * q.x + q.y * q.y) + (q.z * q.z + q.w * q.w); o8[64 * j] = (unsigned long long)pk2(q.x, q.y) | ((unsigned long long)pk2(q.z, q.w) << 32); }
            s = wave_sum(s); if (F.lane < 16) SS[(size_t)(m + rr * (T / 2)) * 16 + F.lane] = F.lane == 0 ? s : 0.f; } } }
    { const float* pin = KIN(1); bf16* PB = (bf16*)(ws + WS_PB);
      for (int i = gtid; i < 2 * T * DPLE / 16; i += NGT) { f32x4 v[4];
#pragma unroll
        for (int j = 0; j < 4; ++j) v[j] = __builtin_nontemporal_load((const f32x4*)pin + (size_t)j * (2 * T * DPLE / 16) + i);
#pragma unroll
        for (int j = 0; j < 4; ++j) ((unsigned long long*)PB)[(size_t)j * (2 * T * DPLE / 16) + i] = (unsigned long long)pk2(v[j].x, v[j].y) | ((unsigned long long)pk2(v[j].z, v[j].w) << 32); } }
    { const float* fox_w_in = KIN(8); bf16* WFZ = (bf16*)(ws + WS_WFZ);
      for (int i = gtid; i < 16 * 1024; i += NGT) { const int n = i >> 10, k = i & 1023; WFZ[i] = (bf16)f2bf(fox_w_in[(size_t)k * 3088 + 3072 + n] * norm_w[(4 + 1) * DM + k]); } }
#pragma unroll 1
    for (int fi = 0; fi < 4; ++fi) { const int li = fi >> 1, f = fi & 1;
        PREP(KIN(3) + (size_t)fi * DM * 2 * DFF, DM, 2 * DFF, (bf16*)(ws + WS_WFFI) + (size_t)fi * 2 * DFF * DM, 2 * DFF, 1, 0, norm_w + (li * 4 + (f ? 2 : 0)) * DM);
        PREP(KIN(4) + (size_t)fi * DFF * DM, DFF, DM, (bf16*)(ws + WS_WFFO) + (size_t)fi * DM * DFF, DM, 0, 0, (const float*)nullptr); }
    PREP(KIN(5), DM, 6144, (bf16*)(ws + WS_WRIN), 4096, 0, 0, norm_w + 1 * DM);
    PREP(KIN(5), DM, 6144, (bf16*)(ws + WS_WRG), 2048, 0, 4096, norm_w + 1 * DM);
    PREP(KIN(7), 2048, DM, (bf16*)(ws + WS_WRO), DM, 0, 0, (const float*)nullptr);
    PREP(KIN(8), DM, 3088, (bf16*)(ws + WS_WFIN), 3072, 0, 0, norm_w + (4 + 1) * DM);
    PREP(KIN(10), DM, DM, (bf16*)(ws + WS_WFO), DM, 0, 0, (const float*)nullptr);
#pragma unroll 1
    for (int li = 0; li < 2; ++li) {
        PREP(KIN(12) + (size_t)li * DM * DM, DM, DM, (bf16*)(ws + WS_WPG) + (size_t)li * DM * DM, DM, 0, 0, norm_w + (li * 4 + 3) * DM);
        PREP(KIN(11) + (size_t)li * DPLE * DM, DPLE, DM, (bf16*)(ws + WS_WPP) + (size_t)li * DM * DPLE, DM, 0, 0, (const float*)nullptr); }
}

template <int LI> __device__ __forceinline__ bf16* resid() { return LI ? (bf16*)KOUT : (bf16*)(KWS + WS_HB); }
template <int FI, int SITE, bool WITH_PP> __device__ __forceinline__ void ffn_half(const Frame& F, cg::grid_group& grid) {
#ifdef PROBE_FFI
    { unsigned char* ws = KWS; pg8::EpiSwiglu E{(pg8::bf16_t*)(ws + WS_POOL), (const float*)(ws + WS_SS) + (size_t)SITE * T * 16};
      GEMM_PHASE(pg8::EpiSwiglu, resid<(FI >> 1)>(), (bf16*)(ws + WS_WFFI) + (size_t)FI * 2 * DFF * DM, 2 * DFF, DM, E); }
    SEAM();
#endif
    { unsigned char* ws = KWS; pg8::EpiSwiglu E{(pg8::bf16_t*)(ws + WS_POOL), (const float*)(ws + WS_SS) + (size_t)SITE * T * 16};
      GEMM_PHASE(pg8::EpiSwiglu, resid<(FI >> 1)>(), (bf16*)(ws + WS_WFFI) + (size_t)FI * 2 * DFF * DM, 2 * DFF, DM, E); }
    SEAM();
    { unsigned char* ws = KWS; bf16* R = resid<(FI >> 1)>(); pg8::EpiRes E{(const pg8::bf16_t*)R, (pg8::bf16_t*)R, (float*)(ws + WS_SS) + (size_t)(SITE + 1) * T * 16, 0.5f};
      GEMM_PHASE(pg8::EpiRes, ws + WS_POOL, (bf16*)(ws + WS_WFFO) + (size_t)FI * DM * DFF, DM, DFF, E); }
    if (WITH_PP) { unsigned char* ws = KWS; constexpr int LI = FI >> 1; pg8::EpiPlain E{(pg8::bf16_t*)(ws + WS_POOL + 176 * MiB), DM, (const float*)nullptr, 0, 0, 1.0f};
      GEMM_PHASE(pg8::EpiPlain, (bf16*)(ws + WS_PB) + (size_t)LI * T * DPLE, (bf16*)(ws + WS_WPP) + (size_t)LI * DM * DPLE, DM, DPLE, E); }
    SEAM();
}
template <int LI> __device__ __forceinline__ void ple_phase(const Frame& F, cg::grid_group& grid) {
    { unsigned char* ws = KWS; float* SS = (float*)(ws + WS_SS); bf16* R = resid<LI>();
      pg8::EpiPle<LI == 1> E{(const pg8::bf16_t*)R, (pg8::bf16_t*)KOUT, (float*)(ws + WS_POOL), SS + (size_t)(4 * LI + 4) * T * 16, SS + (size_t)(4 * LI + 3) * T * 16, (const pg8::bf16_t*)(ws + WS_POOL + 176 * MiB)};
      GEMM_PHASE(pg8::EpiPle<LI == 1>, R, (bf16*)(ws + WS_WPG) + (size_t)LI * DM * DM, DM, DM, E); }
    SEAM();
}
__device__ __forceinline__ void retention_mixer(const Frame& F, cg::grid_group& grid) {
    { unsigned char* ws = KWS; pg8::EpiRetIn E{(pg8::bf16_t*)(ws + WS_POOL), (pg8::bf16_t*)(ws + WS_POOL + 64 * MiB), (pg8::bf16_t*)(ws + WS_POOL + 128 * MiB), (const float*)(ws + WS_SS) + (size_t)T * 16, (const float*)(ws + WS_ROPE)};
      GEMM_PHASE(pg8::EpiRetIn, ws + WS_HB, ws + WS_WRIN, 4096, DM, E); }
    SEAM();
#ifdef PROBE_RET
    { unsigned char* ws = KWS; ret::ret_phase((LAS char*)F.lds, (const bf16*)(ws + WS_POOL), (const bf16*)(ws + WS_POOL + 64 * MiB), (bf16*)(ws + WS_POOL + 128 * MiB), (float*)(ws + WS_HSS), F.vcu, KARG(15) == 1ull); }
    SEAM();
#endif
    { unsigned char* ws = KWS; ret::ret_phase((LAS char*)F.lds, (const bf16*)(ws + WS_POOL), (const bf16*)(ws + WS_POOL + 64 * MiB), (bf16*)(ws + WS_POOL + 128 * MiB), (float*)(ws + WS_HSS), F.vcu); }
    SEAM();
    { unsigned char* ws = KWS; pg8::EpiRetGate E{(pg8::bf16_t*)(ws + WS_POOL + 128 * MiB), (const float*)(ws + WS_SS) + (size_t)T * 16, (const float*)(ws + WS_HSS), KIN(6)};
      GEMM_PHASE(pg8::EpiRetGate, ws + WS_HB, ws + WS_WRG, 2048, DM, E); }
    SEAM();
    { unsigned char* ws = KWS; pg8::EpiRes E{(const pg8::bf16_t*)(ws + WS_HB), (pg8::bf16_t*)(ws + WS_HB), (float*)(ws + WS_SS) + 2 * (size_t)T * 16, 1.0f};
      GEMM_PHASE(pg8::EpiRes, ws + WS_POOL + 128 * MiB, ws + WS_WRO, DM, 2048, E); }
    SEAM();
}
__device__ __forceinline__ void fox_mixer(const Frame& F, cg::grid_group& grid, unsigned char* lds_generic) {
    { unsigned char* ws = KWS; pg8::EpiPlain E{(pg8::bf16_t*)(ws + WS_POOL), DM, (const float*)(ws + WS_SS) + 5 * (size_t)T * 16, DM, (size_t)(64 * MiB / 2), attn_body::C2};
      GEMM_PHASE(pg8::EpiPlain, KOUT, ws + WS_WFIN, 3072, DM, E); }
    { unsigned char* ws = KWS; const bf16* HB = (const bf16*)KOUT; const bf16* WFZ = (const bf16*)(ws + WS_WFZ); float* LOGF = (float*)(ws + WS_LOGF); const float* ssm = (const float*)(ws + WS_SS) + 5 * (size_t)T * 16; const float* fox_b_f = KIN(9);
      const int gw = F.vcu * NWAVES + F.wave, NGW = F.G * NWAVES;
      for (int task = gw; task < T / 16; task += NGW) {
        const int m16 = F.lane & 15, g = F.lane >> 4; f32x4 a4 = (f32x4){0.f, 0.f, 0.f, 0.f};
        const bf16* ar = HB + (size_t)(16 * task + m16) * DM + 8 * g; const bf16* br = WFZ + (size_t)m16 * DM + 8 * g;
#pragma unroll 8
        for (int s = 0; s < 32; ++s) a4 = __builtin_amdgcn_mfma_f32_16x16x32_bf16(*(const bf16x8*)(ar + 32 * s), *(const bf16x8*)(br + 32 * s), a4, 0, 0, 0);
        const float bfh = fox_b_f[m16];
#pragma unroll
        for (int r = 0; r < 4; ++r) { const int t = 16 * task + 4 * g + r; const float z = a4[r] * pg8::rinv_of(ssm, t) + bfh;
            LOGF[(size_t)t * 16 + m16] = fminf(z, 0.f) - log1pf(__expf(-fabsf(z))); } } }
    SEAM();
    {
        unsigned char* ws = KWS; const float* LOGF = (const float*)(ws + WS_LOGF);
        const int bh = F.vcu >> 1, b = bh >> 4, h = bh & 15; LAS float* nb = (LAS float*)(F.lds + attn_body::LDS_NB); LAS float* wtot = (LAS float*)(F.lds + attn_body::LDS_WS);
        float v[8]; float run = 0.f;
#pragma unroll
        for (int q = 0; q < 8; ++q) { run += LOGF[((size_t)b * SEQ + 8 * F.tid + q) * 16 + h]; v[q] = run; }
        float incl = run;
#pragma unroll
        for (int o = 1; o < 64; o <<= 1) { const float y = __shfl_up(incl, o); if (F.lane >= o) incl += y; }
        if (F.lane == 63) wtot[F.wave] = incl;
        __syncthreads();
        float off = incl - run;
        for (int w2 = 0; w2 < F.wave; ++w2) off += wtot[w2];
#pragma unroll
        for (int q = 0; q < 8; ++q) nb[8 * F.tid + q] = -(off + v[q]) * 1.4426950408889634f;
        __syncthreads();
        const attn_body::bf16* FQ = (const attn_body::bf16*)(ws + WS_POOL);
        const attn_body::AttnTensors AT{FQ, FQ + (size_t)T * DM, FQ + (size_t)2 * T * DM, (attn_body::bf16*)FQ};
        const attn_body::StaticOrder S((int)F.G, (int)blockIdx.x);
        attn_body::attn_phase<attn_body::StaticOrder>((char*)lds_generic, AT, S);
    }
    SEAM();
    { unsigned char* ws = KWS; bf16* R = (bf16*)KOUT; pg8::EpiRes E{(const pg8::bf16_t*)R, (pg8::bf16_t*)R, (float*)(ws + WS_SS) + 6 * (size_t)T * 16, 1.0f};
      GEMM_PHASE(pg8::EpiRes, ws + WS_POOL, ws + WS_WFO, DM, DM, E); }
    SEAM();
}

__global__ void __launch_bounds__(NWAVES * 64, 2) hybrid_fwd(Args args) {
    extern __shared__ __attribute__((aligned(16))) unsigned char lds[];
    cg::grid_group grid = cg::this_grid();
    Frame F; F.lds = (LAS unsigned char*)lds; F.tid = threadIdx.x; F.lane = F.tid & 63; F.wave = __builtin_amdgcn_readfirstlane(F.tid >> 6);
    F.G = gridDim.x; { const int bx = blockIdx.x; F.vcu = (F.G % 8 == 0) ? (bx % 8) * (F.G / 8) + bx / 8 : bx; }
    if (F.tid < 64) ((LAS unsigned*)(F.lds + RING_BYTES))[F.tid] = 0u;
    __syncthreads();
    (void)xcd_barrier_post((unsigned*)(KWS + WS_BAR), (volatile LAS unsigned*)(F.lds + RING_BYTES) + 8);
    p0_prologue(F);
    grid.sync();
#ifdef PROBE_P0
    p0_prologue(F);
    SEAM();
#endif
    ffn_half<0, 0, false>(F, grid);
    retention_mixer(F, grid);
    ffn_half<1, 2, true>(F, grid);
    ple_phase<0>(F, grid);
    ffn_half<2, 4, false>(F, grid);
    fox_mixer(F, grid, lds);
    ffn_half<3, 6, true>(F, grid);
    ple_phase<1>(F, grid);
#ifdef PROBE_SYNC
#pragma unroll 1
    for (int i_ = 0; i_ < PROBE_SYNC; ++i_) grid.sync();
#endif
    { float* hres = KOUT; const float* hfin = (const float*)(KWS + WS_POOL); const float* final_norm_w = KIN(13); const int gw = F.vcu * NWAVES + F.wave, NGW = F.G * NWAVES;
      for (int m = gw; m < T; m += NGW) {
        const f32x4* xi = (const f32x4*)(hfin + (size_t)m * DM) + F.lane; f32x4* xr = (f32x4*)(hres + (size_t)m * DM) + F.lane; const f32x4* wr = (const f32x4*)final_norm_w + F.lane; f32x4 v[4]; float s = 0.f;
#pragma unroll
        for (int j = 0; j < 4; ++j) { v[j] = xi[64 * j]; s += (v[j].x * v[j].x + v[j].y * v[j].y) + (v[j].z * v[j].z + v[j].w * v[j].w); }
        const float ri = 1.0f / sqrtf(wave_sum(s) * (1.0f / DM) + 1e-6f);
#pragma unroll
        for (int j = 0; j < 4; ++j) xr[64 * j] = v[j] * ri * wr[64 * j];
      } }
}

extern "C" void kernel_launch(void* const* d_in, const int* in_sizes, int n_in, void* d_out, int out_size, void* d_ws, size_t ws_size, hipStream_t stream) {
    static int grid = 0;
    if (grid == 0) {
        if (n_in != 14 || out_size != T * DM || ws_size < WS_END) { fprintf(stderr, "kernel_launch: unexpected shapes (n_in %d out %d ws %zu)\n", n_in, out_size, ws_size); grid = -1; return; }
        int dev = 0, cus = 0, per_cu = 0;
        if (hipGetDevice(&dev) != hipSuccess || hipDeviceGetAttribute(&cus, hipDeviceAttributeMultiprocessorCount, dev) != hipSuccess) { grid = -1; return; }
        if (hipFuncSetAttribute((const void*)hybrid_fwd, hipFuncAttributeMaxDynamicSharedMemorySize, LDS_BYTES) != hipSuccess) { fprintf(stderr, "kernel_launch: hipFuncSetAttribute failed\n"); grid = -1; return; }
        if (hipOccupancyMaxActiveBlocksPerMultiprocessor(&per_cu, (const void*)hybrid_fwd, NWAVES * 64, LDS_BYTES) != hipSuccess || per_cu < 1) { fprintf(stderr, "kernel_launch: occupancy query says %d\n", per_cu); per_cu = 1; }
        (void)hipGetLastError();
        grid = cus * 1;
    }
    if (grid < 0) return;
    if (hipMemsetAsync((char*)d_ws + WS_BAR, 0, 16384, stream) != hipSuccess) { fprintf(stderr, "kernel_launch: memset failed\n"); return; }
    Args a{};
    for (int i = 0; i < 14; ++i) a.in[i] = (const float*)d_in[i];
    a.out = (float*)d_out; a.ws = (unsigned char*)d_ws;
    void* kargs[] = {&a};
    hipError_t e = hipLaunchCooperativeKernel((const void*)hybrid_fwd, dim3(grid), dim3(NWAVES * 64), kargs, LDS_BYTES, stream);
    if (e != hipSuccess) fprintf(stderr, "cooperative launch failed: %s (grid %d)\n", hipGetErrorString(e), grid);
}
```

```cpp
#include <hip/hip_runtime.h>
#include <hip/hip_cooperative_groups.h>
#include <cstdio>
#include <cstdint>
namespace cg = cooperative_groups;
#define GAS __attribute__((address_space(1)))
#define LAS __attribute__((address_space(3)))
namespace pg8 {
#define PG8_LAS __attribute__((address_space(3)))
typedef unsigned short bf16_t;
typedef short bf16x8 __attribute__((ext_vector_type(8)));
typedef float f32x4 __attribute__((ext_vector_type(4)));
typedef unsigned u32x4 __attribute__((ext_vector_type(4)));
constexpr int BM = 256, BK = 64, HALF = 128, HTB = HALF * BK * 2  , STAGE_BYTES = 8 * HTB, NXCD = 8, WGM = 8;

__host__ __device__ __forceinline__ int lds_byte(int r, int c) { const int st = (r >> 4) * 2 + (c >> 5), rr = r & 15, cc = c & 31, ob = rr * 64 + cc * 2; return st * 1024 + (ob ^ (((ob >> 9) & 1) << 5)); }
__host__ __device__ __forceinline__ void stage_rc(int b, int& R, int& C) { const int st = b / 1024, sb = b % 1024, swz = sb ^ (((sb >> 9) & 1) << 5); R = (st >> 1) * 16 + swz / 64; C = (st & 1) * 32 + (swz % 64) / 2; }
__host__ __device__ __forceinline__ int perm32(int rho) { const int n = rho >> 4, i = rho & 15; return 8 * (i >> 2) + 4 * n + (i & 3); }

struct Unit { int pm, pn; };
struct Gemm { const bf16_t* A; const bf16_t* Bt; int M, N, K; };

struct StaticOrder {
    int nM, nN, nwg, G, c;
    __host__ __device__ void init(int M, int N, int G_, int c_) { nM = M / BM; nN = N / BM; nwg = nM * nN; G = G_; c = c_; }
    __host__ __device__ bool next(int i, Unit& u) const {
        const long L = (long)i * G + c; if (L >= nwg) return false;
        int wgid = (int)L; { const int q = nwg / NXCD, r = nwg % NXCD, xcd = wgid % NXCD, off = wgid / NXCD; wgid = (xcd < r ? xcd * (q + 1) : r * (q + 1) + (xcd - r) * q) + off; }
        const int nig = WGM * nN, gid = wgid / nig, fm = gid * WGM, gsz = (nM - fm) < WGM ? (nM - fm) : WGM;
        u.pm = fm + ((wgid % nig) % gsz); u.pn = (wgid % nig) / gsz; return true;
    }
    __device__ __forceinline__ void a_ready(const Unit&) const {}
    __device__ __forceinline__ void done(const Unit&) const {}
};
__device__ __forceinline__ unsigned cvt_pk_bf16(float lo, float hi) { unsigned r; asm volatile("v_cvt_pk_bf16_f32 %0, %1, %2" : "=v"(r) : "v"(lo), "v"(hi)); return r; }
__device__ __forceinline__ u32x4 pack8(const f32x4 v0, const f32x4 v1) { u32x4 w; w.x = cvt_pk_bf16(v0[0], v0[1]); w.y = cvt_pk_bf16(v0[2], v0[3]); w.z = cvt_pk_bf16(v1[0], v1[1]); w.w = cvt_pk_bf16(v1[2], v1[3]); return w; }
__device__ __forceinline__ float bflo(unsigned u) { return __uint_as_float(u << 16); }
__device__ __forceinline__ float bfhi(unsigned u) { return __uint_as_float(u & 0xffff0000u); }
__device__ __forceinline__ void unpack8(const u32x4 w, f32x4& v0, f32x4& v1) { v0 = (f32x4){bflo(w.x), bfhi(w.x), bflo(w.y), bfhi(w.y)}; v1 = (f32x4){bflo(w.z), bfhi(w.z), bflo(w.w), bfhi(w.w)}; }
__device__ __forceinline__ float sigm(float x) { return __builtin_amdgcn_rcpf(1.0f + __builtin_amdgcn_exp2f(-1.4426950408889634f * x)); }
__device__ __forceinline__ f32x4 silu4(const f32x4 x) { return (f32x4){x[0] * sigm(x[0]), x[1] * sigm(x[1]), x[2] * sigm(x[2]), x[3] * sigm(x[3])}; }
__device__ __forceinline__ f32x4 sigm4(const f32x4 x) { return (f32x4){sigm(x[0]), sigm(x[1]), sigm(x[2]), sigm(x[3])}; }
__device__ __forceinline__ float sum16(const float* p) { const f32x4* q = (const f32x4*)p; const f32x4 a = q[0], b = q[1], c = q[2], d = q[3];
    return (((a[0] + a[1]) + (a[2] + a[3])) + ((b[0] + b[1]) + (b[2] + b[3]))) + (((c[0] + c[1]) + (c[2] + c[3])) + ((d[0] + d[1]) + (d[2] + d[3]))); }
__device__ __forceinline__ float rinv_of(const float* ss, int r) { return 1.0f / sqrtf(sum16(ss + (size_t)r * 16) * (1.0f / 1024.0f) + 1e-6f); }
#define EPI_ARGS const f32x4 (&acc)[2][2][4][2], const Unit& u, int wr, int wc, int fr, int fq
#define EPI_ROWS(ai, m) (u.pm * BM + (ai) * HALF + wr * 64 + (m) * 16 + fr)

struct EpiSwiglu { static constexpr bool PERM = true, AFTER_DRAIN = false; bf16_t* act; const float* ss;
    __device__ __forceinline__ void operator()(EPI_ARGS) const {
        const int col0 = u.pn * HALF + wc * 32 + 8 * fq;
#pragma unroll
        for (int ai = 0; ai < 2; ++ai)
#pragma unroll
            for (int m = 0; m < 4; ++m) { const int r = EPI_ROWS(ai, m); const float ri = rinv_of(ss, r);
                const f32x4 a0 = silu4(acc[ai][0][m][0] * ri) * (acc[ai][1][m][0] * ri), a1 = silu4(acc[ai][0][m][1] * ri) * (acc[ai][1][m][1] * ri);
                *(u32x4*)(act + (size_t)r * 2816 + col0) = pack8(a0, a1); }
    }
};
struct EpiRes { static constexpr bool PERM = true, AFTER_DRAIN = false; const bf16_t* rin; bf16_t* rout; float* ssn; float scale;
    __device__ __forceinline__ void operator()(EPI_ARGS) const {
#pragma unroll
        for (int ai = 0; ai < 2; ++ai)
#pragma unroll
            for (int m = 0; m < 4; ++m) { const int r = EPI_ROWS(ai, m); float sq = 0.f;
#pragma unroll
                for (int bj = 0; bj < 2; ++bj) { const size_t off = (size_t)r * 1024 + u.pn * BM + bj * HALF + wc * 32 + 8 * fq;
                    f32x4 h0, h1; unpack8(*(const u32x4*)(rin + off), h0, h1);
                    const f32x4 v0 = h0 + acc[ai][bj][m][0] * scale, v1 = h1 + acc[ai][bj][m][1] * scale;
                    *(u32x4*)(rout + off) = pack8(v0, v1);
                    sq += (v0[0] * v0[0] + v0[1] * v0[1]) + (v0[2] * v0[2] + v0[3] * v0[3]) + (v1[0] * v1[0] + v1[1] * v1[1]) + (v1[2] * v1[2] + v1[3] * v1[3]); }
                sq += __shfl_xor(sq, 16); sq += __shfl_xor(sq, 32); if (fq == 0) ssn[(size_t)r * 16 + u.pn * 4 + wc] = sq; }
    }
};
template <bool F32OUT> struct EpiPle { static constexpr bool PERM = true, AFTER_DRAIN = false; const bf16_t* rin; bf16_t* rout; float* fout; float* ssn; const float* ss; const bf16_t* pp;
    __device__ __forceinline__ void operator()(EPI_ARGS) const {
#pragma unroll
        for (int ai = 0; ai < 2; ++ai)
#pragma unroll
            for (int m = 0; m < 4; ++m) { const int r = EPI_ROWS(ai, m); const float ri = rinv_of(ss, r); float sq = 0.f;
#pragma unroll
                for (int bj = 0; bj < 2; ++bj) { const size_t off = (size_t)r * 1024 + u.pn * BM + bj * HALF + wc * 32 + 8 * fq;
                    f32x4 p0, p1, h0, h1; unpack8(*(const u32x4*)(pp + off), p0, p1); unpack8(*(const u32x4*)(rin + off), h0, h1);
                    const f32x4 v0 = h0 + sigm4(acc[ai][bj][m][0] * ri) * p0, v1 = h1 + sigm4(acc[ai][bj][m][1] * ri) * p1;
                    if (F32OUT) { *(f32x4*)(fout + off) = v0; *(f32x4*)(fout + off + 4) = v1; }
                    else { *(u32x4*)(rout + off) = pack8(v0, v1);
                        sq += (v0[0] * v0[0] + v0[1] * v0[1]) + (v0[2] * v0[2] + v0[3] * v0[3]) + (v1[0] * v1[0] + v1[1] * v1[1]) + (v1[2] * v1[2] + v1[3] * v1[3]); } }
                if (!F32OUT) { sq += __shfl_xor(sq, 16); sq += __shfl_xor(sq, 32); if (fq == 0) ssn[(size_t)r * 16 + u.pn * 4 + wc] = sq; } }
    }
};
struct EpiPlain { static constexpr bool PERM = true, AFTER_DRAIN = false; bf16_t* O; int ldc; const float* ss; int split_cols; size_t split_stride; float scale0;
    __device__ __forceinline__ void operator()(EPI_ARGS) const {
        int colt = u.pn * BM; bf16_t* base = O; float sc = 1.f;
        if (split_cols) { const int t = colt / split_cols; base += (size_t)t * split_stride; colt -= t * split_cols; if (t == 0) sc = scale0; }
        const int col0 = colt + wc * 32 + 8 * fq;
#pragma unroll
        for (int ai = 0; ai < 2; ++ai)
#pragma unroll
            for (int m = 0; m < 4; ++m) { const int r = EPI_ROWS(ai, m); const float ri = (ss ? rinv_of(ss, r) : 1.0f) * sc;
#pragma unroll
                for (int bj = 0; bj < 2; ++bj) *(u32x4*)(base + (size_t)r * ldc + col0 + bj * HALF) = pack8(acc[ai][bj][m][0] * ri, acc[ai][bj][m][1] * ri); }
    }
};
struct EpiRetIn { static constexpr bool PERM = true, AFTER_DRAIN = false; bf16_t* Qt; bf16_t* Kt; bf16_t* V; const float* ss; const float* rope  ;
    __device__ __forceinline__ void operator()(EPI_ARGS) const {
        const int pn = u.pn;
        if (pn >= 8) {
            const int col0 = (pn - 8) * BM + wc * 32 + 8 * fq;
#pragma unroll
            for (int ai = 0; ai < 2; ++ai)
#pragma unroll
                for (int m = 0; m < 4; ++m) { const int r = EPI_ROWS(ai, m); const float ri = rinv_of(ss, r);
#pragma unroll
                    for (int bj = 0; bj < 2; ++bj) *(u32x4*)(V + (size_t)r * 2048 + col0 + bj * HALF) = pack8(acc[ai][bj][m][0] * ri, acc[ai][bj][m][1] * ri); }
            return;
        }
        const bool isk = pn >= 4; const int hd = pn & 3; bf16_t* outp = isk ? Kt : Qt;
        const float lg = log2f(1.0f - exp2f(-5.0f - (float)hd));
        const int j0 = wc * 32 + 8 * fq;
#pragma unroll
        for (int ai = 0; ai < 2; ++ai)
#pragma unroll
            for (int m = 0; m < 4; ++m) { const int r = EPI_ROWS(ai, m); const int pos = r & 4095; const float e1 = (float)((pos & 63) + 1) * lg;
                const float f = rinv_of(ss, r) * (isk ? 0.0625f * exp2f(-e1) : exp2f(e1));
                const f32x4* cs = (const f32x4*)(rope + ((size_t)pos * 128 + j0) * 2);
                const f32x4 c01 = cs[0], c23 = cs[1], c45 = cs[2], c67 = cs[3];
                const f32x4 x10 = acc[ai][0][m][0] * f, x11 = acc[ai][0][m][1] * f, x20 = acc[ai][1][m][0] * f, x21 = acc[ai][1][m][1] * f;
                const f32x4 cc0 = (f32x4){c01[0], c01[2], c23[0], c23[2]}, sn0 = (f32x4){c01[1], c01[3], c23[1], c23[3]};
                const f32x4 cc1 = (f32x4){c45[0], c45[2], c67[0], c67[2]}, sn1 = (f32x4){c45[1], c45[3], c67[1], c67[3]};
                const f32x4 y10 = x10 * cc0 - x20 * sn0, y11 = x11 * cc1 - x21 * sn1, y20 = x10 * sn0 + x20 * cc0, y21 = x11 * sn1 + x21 * cc1;
                bf16_t* rowp = outp + (size_t)r * 1024 + hd * 256 + j0;
                *(u32x4*)(rowp) = pack8(y10, y11); *(u32x4*)(rowp + HALF) = pack8(y20, y21); }
    }
};
struct EpiRetGate { static constexpr bool PERM = true, AFTER_DRAIN = false; bf16_t* Y; const float* ss; const float* hss; const float* gnw;
    __device__ __forceinline__ void operator()(EPI_ARGS) const {
        const int hd = u.pn >> 1;
#pragma unroll
        for (int ai = 0; ai < 2; ++ai)
#pragma unroll
            for (int m = 0; m < 4; ++m) { const int r = EPI_ROWS(ai, m); const float ri = rinv_of(ss, r); const float hr = 1.0f / sqrtf(sum16(hss + ((size_t)r * 4 + hd) * 16) * (1.0f / 512.0f) + 1e-6f);
#pragma unroll
                for (int bj = 0; bj < 2; ++bj) { const int c = u.pn * BM + bj * HALF + wc * 32 + 8 * fq; bf16_t* p = Y + (size_t)r * 2048 + c;
                    f32x4 o0, o1; unpack8(*(const u32x4*)p, o0, o1);
                    const f32x4 g0 = *(const f32x4*)(gnw + c) * hr, g1 = *(const f32x4*)(gnw + c + 4) * hr;
                    *(u32x4*)p = pack8(silu4(acc[ai][bj][m][0] * ri) * o0 * g0, silu4(acc[ai][bj][m][1] * ri) * o1 * g1); }
            }
    }
};
template <class Epi, class Sched, bool ALIGN_EPI = false, bool SP2 = false>
__device__ __forceinline__ void gemm_phase(PG8_LAS unsigned char* lds, const Gemm g, const Sched& S, const Epi& E) {
    int tid_ = threadIdx.x; asm volatile("" : "+v"(tid_));
    const int tid = tid_, wid = __builtin_amdgcn_readfirstlane(tid >> 6), lane = tid & 63, wr = wid >> 2, wc = wid & 3, fr = lane & 15, fq = lane >> 4;
    const int K = g.K, nt = K / BK;
    unsigned voffA[2], voffB[2];
#pragma unroll
    for (int i = 0; i < 2; ++i) { int R, C; stage_rc(tid * 16 + i * 8192, R, C); const int Rb = Epi::PERM ? ((R & ~31) + perm32(R & 31)) : R;
        voffA[i] = (unsigned)(R * K + C) * 2u; voffB[i] = (unsigned)(Rb * K + C) * 2u; }
    const size_t kstep = (size_t)(BK * 2);
    const size_t hstep = (size_t)HALF * K * 2;
    const size_t tstep = 2 * hstep;
    const unsigned ldsw = (unsigned)wid * 1024u;
    const int aoff = lds_byte(wr * 64 + fr, fq * 8), boff = lds_byte(wc * 32 + fr, fq * 8);
#define PG8_SA(b, h) (((b) * 2 + (h)) * HTB)
#define PG8_SB(b, h) ((4 + (b) * 2 + (h)) * HTB)
#define PG8_STAGE(bufoff, gbase, voff) do { _Pragma("unroll") for (int _i = 0; _i < 2; ++_i) \
        __builtin_amdgcn_global_load_lds((const unsigned*)((const char*)(gbase) + (voff)[_i]), (PG8_LAS unsigned*)(lds + (bufoff) + ldsw + _i * 8192), 16, 0, 0); } while (0)
#define PG8_LDA(dst, b, h) do { _Pragma("unroll") for (int m = 0; m < 4; ++m) _Pragma("unroll") for (int k = 0; k < 2; ++k) dst[m][k] = *(const PG8_LAS bf16x8*)(lds + PG8_SA(b, h) + aoff + m * 2048 + k * 1024); } while (0)
#define PG8_LDB(dst, b, h) do { _Pragma("unroll") for (int n = 0; n < 2; ++n) _Pragma("unroll") for (int k = 0; k < 2; ++k) dst[n][k] = *(const PG8_LAS bf16x8*)(lds + PG8_SB(b, h) + boff + n * 2048 + k * 1024); } while (0)
#define PG8_MMA(ai, bj, At, Bt) do { __builtin_amdgcn_s_setprio(1); _Pragma("unroll") for (int m = 0; m < 4; ++m) _Pragma("unroll") for (int n = 0; n < 2; ++n) _Pragma("unroll") for (int k = 0; k < 2; ++k) \
        acc[ai][bj][m][n] = __builtin_amdgcn_mfma_f32_16x16x32_bf16(Bt[n][k], At[m][k], acc[ai][bj][m][n], 0, 0, 0); __builtin_amdgcn_s_setprio(0); } while (0)
#define PG8_WAIT_V(n) asm volatile("s_waitcnt vmcnt(" #n ")" ::: "memory")
#define PG8_WAIT_L(n) asm volatile("s_waitcnt lgkmcnt(" #n ")" ::: "memory")
#define PG8_BAR __builtin_amdgcn_s_barrier()
#define PG8_SCHED __builtin_amdgcn_sched_barrier(0)
    Unit cur, nxt; int ui = 0;
    if (!S.next(0, cur)) return;
    f32x4 acc[2][2][4][2];
#pragma unroll
    for (int a = 0; a < 2; ++a)
#pragma unroll
        for (int b = 0; b < 2; ++b)
#pragma unroll
            for (int m = 0; m < 4; ++m)
#pragma unroll
                for (int n = 0; n < 2; ++n) acc[a][b][m][n] = (f32x4){0.f, 0.f, 0.f, 0.f};
    bf16x8 At[4][2], B0[2][2], B1[2][2];
    const char* cA = (const char*)g.A + (size_t)cur.pm * tstep; const char* cB = (const char*)g.Bt + (size_t)cur.pn * tstep;
    S.a_ready(cur);
    if constexpr (SP2) {
        PG8_STAGE(PG8_SB(0, 0), cB, voffB); PG8_STAGE(PG8_SB(0, 1), cB + hstep, voffB); PG8_STAGE(PG8_SA(0, 0), cA, voffA); PG8_STAGE(PG8_SA(0, 1), cA + hstep, voffA);
        if (wr == 1) PG8_BAR;
        PG8_WAIT_V(2); PG8_BAR;
        PG8_STAGE(PG8_SB(1, 0), cB + kstep, voffB); PG8_STAGE(PG8_SA(1, 0), cA + kstep, voffA); PG8_STAGE(PG8_SB(1, 1), cB + hstep + kstep, voffB);
        PG8_WAIT_V(6); PG8_BAR;
    } else {
        PG8_STAGE(PG8_SB(0, 0), cB, voffB); PG8_STAGE(PG8_SA(0, 0), cA, voffA); PG8_STAGE(PG8_SB(0, 1), cB + hstep, voffB); PG8_STAGE(PG8_SA(0, 1), cA + hstep, voffA);
        if (wr == 1) PG8_BAR;
        PG8_WAIT_V(4); PG8_BAR;
        PG8_STAGE(PG8_SB(1, 0), cB + kstep, voffB); PG8_STAGE(PG8_SA(1, 0), cA + kstep, voffA); PG8_STAGE(PG8_SB(1, 1), cB + hstep + kstep, voffB);
        PG8_WAIT_V(6); PG8_BAR;
    }
    for (;;) {
        const bool has_next = S.next(ui + 1, nxt);
        const char* nA = has_next ? (const char*)g.A + (size_t)nxt.pm * tstep : cA; const char* nB = has_next ? (const char*)g.Bt + (size_t)nxt.pn * tstep : cB;
        for (int t = 0; t < nt; t += 2) {
            const bool last = (t == nt - 2);
            const char* a1 = cA + (size_t)(t + 1) * kstep;
            const char* a2 = last ? nA : cA + (size_t)(t + 2) * kstep; const char* b2 = last ? nB : cB + (size_t)(t + 2) * kstep;
            const char* a3 = a2 + kstep; const char* b3 = b2 + kstep;
            if (last && has_next) S.a_ready(nxt);
            if constexpr (SP2) {
            PG8_LDB(B0, 0, 0); PG8_LDB(B1, 0, 1); PG8_SCHED; PG8_LDA(At, 0, 0); PG8_STAGE(PG8_SA(1, 1), a1 + hstep, voffA);
            PG8_WAIT_V(8); PG8_WAIT_L(0); PG8_BAR; PG8_MMA(0, 0, At, B0); PG8_MMA(0, 1, At, B1); PG8_BAR; PG8_SCHED;
            PG8_LDA(At, 0, 1); PG8_STAGE(PG8_SB(0, 0), b2, voffB); PG8_STAGE(PG8_SB(0, 1), b2 + hstep, voffB); PG8_STAGE(PG8_SA(0, 0), a2, voffA);
            PG8_WAIT_V(8); PG8_WAIT_L(0); PG8_BAR; PG8_MMA(1, 0, At, B0); PG8_MMA(1, 1, At, B1); PG8_BAR; PG8_SCHED;
            PG8_LDB(B0, 1, 0); PG8_LDB(B1, 1, 1); PG8_SCHED; PG8_LDA(At, 1, 0); PG8_STAGE(PG8_SA(0, 1), a2 + hstep, voffA);
            PG8_WAIT_V(8); PG8_WAIT_L(0); PG8_BAR; PG8_MMA(0, 0, At, B0); PG8_MMA(0, 1, At, B1); PG8_BAR; PG8_SCHED;
            PG8_LDA(At, 1, 1); PG8_STAGE(PG8_SB(1, 0), b3, voffB); PG8_STAGE(PG8_SB(1, 1), b3 + hstep, voffB); PG8_STAGE(PG8_SA(1, 0), a3, voffA);
            PG8_WAIT_V(8); PG8_WAIT_L(0); PG8_BAR; PG8_MMA(1, 0, At, B0); PG8_MMA(1, 1, At, B1); PG8_BAR; PG8_SCHED;
            } else {
            PG8_LDB(B0, 0, 0); PG8_SCHED; PG8_LDA(At, 0, 0); PG8_STAGE(PG8_SA(1, 1), a1 + hstep, voffA);
            PG8_WAIT_L(8); PG8_BAR; PG8_WAIT_L(0); PG8_MMA(0, 0, At, B0); PG8_BAR; PG8_SCHED;
            PG8_LDB(B1, 0, 1); PG8_STAGE(PG8_SB(0, 0), b2, voffB);
            PG8_BAR; PG8_WAIT_L(0); PG8_MMA(0, 1, At, B1); PG8_BAR;
            PG8_LDA(At, 0, 1); PG8_STAGE(PG8_SA(0, 0), a2, voffA);
            PG8_BAR; PG8_WAIT_L(0); PG8_MMA(1, 0, At, B0); PG8_BAR; PG8_SCHED;
            PG8_STAGE(PG8_SB(0, 1), b2 + hstep, voffB);
            PG8_WAIT_V(6); PG8_BAR; PG8_MMA(1, 1, At, B1); PG8_BAR;
            PG8_LDB(B0, 1, 0); PG8_SCHED; PG8_LDA(At, 1, 0); PG8_STAGE(PG8_SA(0, 1), a2 + hstep, voffA);
            PG8_WAIT_L(8); PG8_BAR; PG8_WAIT_L(0); PG8_MMA(0, 0, At, B0); PG8_BAR; PG8_SCHED;
            PG8_LDB(B1, 1, 1); PG8_STAGE(PG8_SB(1, 0), b3, voffB);
            PG8_BAR; PG8_WAIT_L(0); PG8_MMA(0, 1, At, B1); PG8_BAR;
            PG8_LDA(At, 1, 1); PG8_STAGE(PG8_SA(1, 0), a3, voffA);
            PG8_BAR; PG8_WAIT_L(0); PG8_MMA(1, 0, At, B0); PG8_BAR; PG8_SCHED;
            PG8_STAGE(PG8_SB(1, 1), b3 + hstep, voffB);
            PG8_WAIT_V(6); PG8_BAR; PG8_MMA(1, 1, At, B1); PG8_BAR;
            }
        }
        if constexpr (ALIGN_EPI) { if (wr == 0) PG8_BAR; }
        if constexpr (!Epi::AFTER_DRAIN) { E(acc, cur, wr, wc, fr, fq); S.done(cur); }
        if (!has_next) break;
#pragma unroll
        for (int a = 0; a < 2; ++a)
#pragma unroll
            for (int b = 0; b < 2; ++b)
#pragma unroll
                for (int m = 0; m < 4; ++m)
#pragma unroll
                    for (int n = 0; n < 2; ++n) acc[a][b][m][n] = (f32x4){0.f, 0.f, 0.f, 0.f};
        cur = nxt; cA = nA; cB = nB; ++ui;
        if constexpr (ALIGN_EPI) { if (wr == 1) PG8_BAR; }
    }
    PG8_WAIT_V(0);
    if constexpr (!ALIGN_EPI) { if (wr == 0) PG8_BAR; }
    PG8_BAR;
    if constexpr (Epi::AFTER_DRAIN) { E.fused(acc, cur, wr, wc, fr, fq, lds, wid, lane); S.done(cur); }
#undef PG8_SA
#undef PG8_SB
#undef PG8_STAGE
#undef PG8_LDA
#undef PG8_LDB
#undef PG8_MMA
#undef PG8_WAIT_V
#undef PG8_WAIT_L
#undef PG8_BAR
#undef PG8_SCHED
}
}
#include <hip/hip_bf16.h>
#include <cmath>
namespace attn_body {
using bf16=__hip_bfloat16;
using bf16x8=__attribute__((ext_vector_type(8)))short;
using s16x4=__attribute__((ext_vector_type(4)))short;
using f32x16=__attribute__((ext_vector_type(16)))float;
using u32x4=__attribute__((ext_vector_type(4)))unsigned;
constexpr int BATCH=8,NHEAD=16,SEQ=4096,D=64,DM=NHEAD*D;
constexpr int NW=8,QBLK=32,QB=QBLK*NW,KVBLK=64,NQB=SEQ/QB;
constexpr int ATTN_PITCH=DM, ATTN_UNIT_ROWS=QB;
__device__ __forceinline__ int crow(int r,int hi){return (r&3)+8*(r>>2)+4*hi;}
#define SBAR() __builtin_amdgcn_sched_barrier(0)
__device__ __forceinline__ void cmask(f32x16&p0,f32x16&p1,int jb,int qrel,int hi){
  const float NEG=-INFINITY; int kb=64*jb+4*hi;
  #pragma unroll
  for(int r=0;r<16;++r){int kv=kb+(r&3)+8*(r>>2); if(kv>qrel)p0[r]=NEG; if(kv+32>qrel)p1[r]=NEG;}
}

constexpr int NSLOT=3, SLOTB=8192;
typedef float f32x4_t __attribute__((ext_vector_type(4)));
constexpr int LDS_K=0, LDS_V=NSLOT*SLOTB, LDS_WS=2*NSLOT*SLOTB, LDS_OST=LDS_WS+NW*64*4, LDS_NB=LDS_OST+NW*4096, LDS_BYTES=LDS_NB+SEQ*4;
constexpr float C2=0.125f*1.4426950408889634f;
__device__ __forceinline__ void glds16(const void*gsrc,unsigned lds_dst){unsigned keep;
  asm volatile("s_mov_b32 %0, m0\n\ts_mov_b32 m0, %2\n\ts_nop 0\n\tglobal_load_lds_dwordx4 %1, off\n\ts_mov_b32 m0, %0":"=&s"(keep):"v"(gsrc),"s"(lds_dst):"memory");}
__device__ __forceinline__ float max3f(float a,float b,float c){float r;asm("v_max3_f32 %0, %1, %2, %3":"=v"(r):"v"(a),"v"(b),"v"(c));return r;}
__device__ __forceinline__ float max2f(float a,float b){float r;asm("v_max_f32_e32 %0, %1, %2":"=v"(r):"v"(a),"v"(b));return r;}
__device__ __forceinline__ float fadd_s(float a,float b){float r;asm("v_add_f32_e32 %0, %1, %2":"=v"(r):"v"(a),"v"(b));return r;}
__device__ __forceinline__ float fsub_s(float a,float b){float r;asm("v_sub_f32_e32 %0, %1, %2":"=v"(r):"v"(a),"v"(b));return r;}
typedef float f32x2_t __attribute__((ext_vector_type(2))); typedef __bf16 bf16x2_t __attribute__((ext_vector_type(2)));
__device__ __forceinline__ unsigned cvtpk_s(float lo,float hi){f32x2_t v={lo,hi};bf16x2_t b=__builtin_convertvector(v,bf16x2_t);return __builtin_bit_cast(unsigned,b);}
#define WAIT_BAR(N) asm volatile("s_waitcnt vmcnt(" #N ") lgkmcnt(0)\n\ts_barrier":::"memory")

__device__ __forceinline__ void qkt(f32x16&p0,f32x16&p1,const char*Kslot,const bf16x8*qr,int r32,int hi){
  const char*kb=Kslot+hi*1024+r32*16;
  #pragma unroll
  for(int d0=0;d0<4;++d0){
    const bf16x8 b0=*reinterpret_cast<const bf16x8*>(kb+d0*2048);
    const bf16x8 b1=*reinterpret_cast<const bf16x8*>(kb+d0*2048+512);
    p0=__builtin_amdgcn_mfma_f32_32x32x16_bf16(b0,qr[d0],p0,0,0,0);p1=__builtin_amdgcn_mfma_f32_32x32x16_bf16(b1,qr[d0],p1,0,0,0);}
}
typedef __attribute__((address_space(3))) const char* lds_cptr;
typedef short v4i16_t __attribute__((ext_vector_type(4)));
__device__ __forceinline__ void kload8(bf16x8*kf,lds_cptr kp){
  kf[0]=*(const __attribute__((address_space(3))) bf16x8*)(kp);      kf[1]=*(const __attribute__((address_space(3))) bf16x8*)(kp+512);
  kf[2]=*(const __attribute__((address_space(3))) bf16x8*)(kp+2048); kf[3]=*(const __attribute__((address_space(3))) bf16x8*)(kp+2560);
  kf[4]=*(const __attribute__((address_space(3))) bf16x8*)(kp+4096); kf[5]=*(const __attribute__((address_space(3))) bf16x8*)(kp+4608);
  kf[6]=*(const __attribute__((address_space(3))) bf16x8*)(kp+6144); kf[7]=*(const __attribute__((address_space(3))) bf16x8*)(kp+6656);
}
__device__ __forceinline__ void kload2(bf16x8*kf,lds_cptr kp,int j){ kf[2*j]=*(const __attribute__((address_space(3))) bf16x8*)(kp+j*2048); kf[2*j+1]=*(const __attribute__((address_space(3))) bf16x8*)(kp+j*2048+512); }
__device__ __forceinline__ s16x4 vtr(lds_cptr p){ return __builtin_bit_cast(s16x4,__builtin_amdgcn_ds_read_tr16_b64_v4i16((__attribute__((address_space(3))) v4i16_t*)p)); }
__device__ __forceinline__ float rowmax(const f32x16&p0,const f32x16&p1){
  float a=max3f(p0[0],p0[1],p1[0]),b=max3f(p0[2],p0[3],p1[1]);a=max3f(a,p1[2],p1[3]);
  #pragma unroll
  for(int r=4;r<16;r+=4){a=max3f(a,p0[r],p0[r+1]);b=max3f(b,p0[r+2],p0[r+3]);a=max3f(a,p1[r],p1[r+1]);b=max3f(b,p1[r+2],p1[r+3]);}
  const float m=max2f(a,b);
  auto rr=__builtin_amdgcn_permlane32_swap(__float_as_uint(m),__float_as_uint(m),false,false);
  return max2f(__uint_as_float(rr[0]),__uint_as_float(rr[1]));
}
__device__ __forceinline__ void pv(f32x16*o,int vb,bf16x8 pa0,bf16x8 pa1,bf16x8 pa2,bf16x8 pa3){
  #pragma unroll
  for(int d0=0;d0<2;++d0){s16x4 lo[4],hi[4];
    #pragma unroll
    for(int ks=0;ks<4;++ks){
      asm volatile("ds_read_b64_tr_b16 %0,%1 offset:%c2":"=&v"(lo[ks]):"v"(vb),"i"(d0*4096+ks*1024):"memory");
      asm volatile("ds_read_b64_tr_b16 %0,%1 offset:%c2":"=&v"(hi[ks]):"v"(vb),"i"(d0*4096+ks*1024+512):"memory");}
    asm volatile("s_waitcnt lgkmcnt(0)":::"memory");SBAR();
    #define PK(k) (bf16x8){lo[k][0],lo[k][1],lo[k][2],lo[k][3],hi[k][0],hi[k][1],hi[k][2],hi[k][3]}
    o[d0]=__builtin_amdgcn_mfma_f32_32x32x16_bf16(pa0,PK(0),o[d0],0,0,0);
    o[d0]=__builtin_amdgcn_mfma_f32_32x32x16_bf16(pa1,PK(1),o[d0],0,0,0);
    o[d0]=__builtin_amdgcn_mfma_f32_32x32x16_bf16(pa2,PK(2),o[d0],0,0,0);
    o[d0]=__builtin_amdgcn_mfma_f32_32x32x16_bf16(pa3,PK(3),o[d0],0,0,0);
    #undef PK
  }
}

#ifndef ATTN_STORE16
#define ATTN_STORE16(p,v) (*(u32x4*)(p)=(v))
#endif
template<int THRL> __device__ __forceinline__ void attn_unit(int b,int h,int qb,const bf16*Q,const bf16*__restrict__ K,const bf16*__restrict__ V,bf16*O,char*shm,bool live){
  const __attribute__((address_space(3))) float* nbp=(const __attribute__((address_space(3))) float*)(lds_cptr)(shm+LDS_NB);
  #define BIASC(C0,C1,t) do{ const __attribute__((address_space(3))) float* bp_=nbp+(t)*64+4*hi; \
    _Pragma("unroll") for(int g_=0;g_<4;++g_){ const f32x4_t a_=*(const __attribute__((address_space(3))) f32x4_t*)(bp_+8*g_); const f32x4_t b_=*(const __attribute__((address_space(3))) f32x4_t*)(bp_+32+8*g_); \
      C0[4*g_]=a_[0]-mhat;C0[4*g_+1]=a_[1]-mhat;C0[4*g_+2]=a_[2]-mhat;C0[4*g_+3]=a_[3]-mhat; C1[4*g_]=b_[0]-mhat;C1[4*g_+1]=b_[1]-mhat;C1[4*g_+2]=b_[2]-mhat;C1[4*g_+3]=b_[3]-mhat; } }while(0)

  int tid_=threadIdx.x; asm volatile("":"+v"(tid_)); const int tid=tid_,lane=tid&63,r32=lane&31,hi=lane>>5; const int wid=__builtin_amdgcn_readfirstlane(tid>>6);
  const long rowbase=(long)b*SEQ; const int q0=qb*QB;
  const bf16*Qw=Q+(rowbase+q0+wid*QBLK)*DM+h*D;
  const bf16*Kh=K+rowbase*DM+h*D,*Vh=V+rowbase*DM+h*D;
  const unsigned lds0=(unsigned)(uintptr_t)shm;
  float*wsf=(float*)(shm+LDS_WS)+wid*64;
  const bf16*ksrc=Kh+(long)lane*DM+wid*8;
  const bf16*vsrc=Vh+(long)(16*(wid&3)+(lane>>2))*DM+(wid>>2)*32+(lane&3)*8;
  const unsigned kdst=lds0+LDS_K+wid*1024, vdst=lds0+LDS_V+wid*1024;
  #define DMA_K(t,slot) glds16(ksrc+(long)(t)*KVBLK*DM,(unsigned)__builtin_amdgcn_readfirstlane(kdst+(slot)))
  #define DMA_V(t,slot) glds16(vsrc+(long)(t)*KVBLK*DM,(unsigned)__builtin_amdgcn_readfirstlane(vdst+(slot)))
  const int vb0=(int)(lds0+LDS_V)+((lane>>4)&1)*32+(lane&3)*8+(4*hi+((lane&15)>>2))*64;
  const char*Kbase=shm+LDS_K; bf16x8 kf[8];
  const lds_cptr shm3=(lds_cptr)shm; const lds_cptr kp0=shm3+LDS_K+hi*1024+r32*16; const lds_cptr vp0=shm3+LDS_V+((lane>>4)&1)*32+(lane&3)*8+(4*hi+((lane&15)>>2))*64;
  const int NT=(q0+QB)/KVBLK;
  DMA_K(0,0);DMA_V(0,0);DMA_K(1,SLOTB);
  bf16x8 qr[4];
  #pragma unroll
  for(int d0=0;d0<4;++d0)qr[d0]=*reinterpret_cast<const bf16x8*>(&Qw[(long)r32*DM+d0*16+hi*8]);
  float mhat=0.f,l_reg=0.f;f32x16 o[2];o[0]=f32x16{};o[1]=f32x16{};
  const int qrel=wid*QBLK+r32;
  #define CMASK(P0,P1,t) do{int jb_=(t)-(NT-4); if(jb_>=0)cmask(P0,P1,jb_,qrel,hi);}while(0)
  bool resc=false;
  #define START(P0,P1) do{ const float rm=rowmax(P0,P1); resc=false; \
    { const float dl=rm; mhat=fadd_s(mhat,dl); \
      _Pragma("unroll") for(int r=0;r<16;++r){P0[r]=fsub_s(P0[r],dl);P1[r]=fsub_s(P1[r],dl);} \
      } \
    _Pragma("unroll") for(int r=0;r<16;++r)P0[r]=__builtin_amdgcn_exp2f(P0[r]); }while(0)
  #define RESC() do{ if(resc){ asm volatile("s_waitcnt lgkmcnt(0)":::"memory"); \
      _Pragma("unroll") for(int d_=0;d_<2;++d_) _Pragma("unroll") for(int r=0;r<16;++r)o[d_][r]*=wsf[crow(r,hi)]; } }while(0)
  f32x16 pA0,pA1,pB0,pB1;
  int sl_prev=0,sl_cur=0,sl_next=SLOTB;
  #define ROT() do{sl_prev=sl_cur;sl_cur=sl_next;sl_next=(sl_next==(NSLOT-1)*SLOTB)?0:sl_next+SLOTB;}while(0)
  DMA_K(2,2*SLOTB);
  WAIT_BAR(3);
  BIASC(pA0,pA1,0); qkt(pA0,pA1,Kbase,qr,r32,hi);asm volatile("s_nop 15\n\ts_nop 7":"+v"(pA0),"+v"(pA1));CMASK(pA0,pA1,0);
  START(pA0,pA1);
  _Pragma("unroll") for(int r=0;r<16;++r)pA1[r]=__builtin_amdgcn_exp2f(pA1[r]);
  BIASC(pB0,pB1,1);
  WAIT_BAR(0);
  DMA_K(3,0);DMA_V(1,SLOTB);
  ROT();
  kload8(kf,kp0+sl_cur);
  WAIT_BAR(2);
  s16x4 vlo[8],vhi[8]; u32x4 pw0,pw1,pw2,pw3;
  #define PKW(P,B) cvtpk_s(P[B],P[B+1])
  #define PAF(k) __builtin_bit_cast(bf16x8,pw##k)
  #define VFR(i) (bf16x8){vlo[i][0],vlo[i][1],vlo[i][2],vlo[i][3],vhi[i][0],vhi[i][1],vhi[i][2],vhi[i][3]}
  #define PIN(x) asm volatile("":"+v"(x))
  #define MX3(a,b,c) __builtin_fmaxf(__builtin_fmaxf((a),(b)),(c))
  #define GAPA(MF,A0,A1,A2,A3,W0,W1,PW) do{ MF; sacc+=A0; sacc+=A1; sacc+=A2; sacc+=A3; PIN(sacc); W0; W1; PIN(PW); SBAR(); }while(0)
  #define EX(v) __builtin_amdgcn_exp2f(v)
  #define GAPB(MF,X,B,Z) do{ MF; X[B]=EX(X[B]); X[B+1]=EX(X[B+1]); X[B+2]=EX(X[B+2]); X[B+3]=EX(X[B+3]); PIN(X); Z[B]-=mhat; Z[B+1]-=mhat; Z[B+2]-=mhat; Z[B+3]-=mhat; PIN(Z); SBAR(); }while(0)
  #define BIASLD(Z0,Z1,t) do{ const __attribute__((address_space(3))) float* bp_=nbp+(t)*64+4*hi; \
    _Pragma("unroll") for(int g_=0;g_<4;++g_){ const f32x4_t a_=*(const __attribute__((address_space(3))) f32x4_t*)(bp_+8*g_); const f32x4_t b_=*(const __attribute__((address_space(3))) f32x4_t*)(bp_+32+8*g_); \
      Z0[4*g_]=a_[0];Z0[4*g_+1]=a_[1];Z0[4*g_+2]=a_[2];Z0[4*g_+3]=a_[3]; Z1[4*g_]=b_[0];Z1[4*g_+1]=b_[1];Z1[4*g_+2]=b_[2];Z1[4*g_+3]=b_[3]; } }while(0)
  #define VRD(i) do{ vlo[i]=vtr(vp_+(((i)>>2)*4096+((i)&3)*1024)); vhi[i]=vtr(vp_+(((i)>>2)*4096+((i)&3)*1024+512)); }while(0)
  #define KRD(G,j) do{ if(G){ kload2(kf,kp0+sl_next,j); SBAR(); } }while(0)
  #define STEP(C0,C1,P0,P1,t,GK,GV,GL) do{ SBAR(); \
    const lds_cptr vp_=vp0+sl_prev; \
    VRD(0); SBAR(); float sacc=(P0[0]+P0[1]); \
    GAPA(C0=__builtin_amdgcn_mfma_f32_32x32x16_bf16(kf[0],qr[0],C0,0,0,0), P0[2],P0[3],P0[4],P0[5],     pw0[0]=PKW(P0,0), pw0[1]=PKW(P0,2), pw0); \
    VRD(4); SBAR(); GAPA(C1=__builtin_amdgcn_mfma_f32_32x32x16_bf16(kf[1],qr[0],C1,0,0,0), P0[6],P0[7],P0[8],P0[9],     pw0[2]=PKW(P0,4), pw0[3]=PKW(P0,6), pw0); \
    VRD(1); SBAR(); GAPA(C0=__builtin_amdgcn_mfma_f32_32x32x16_bf16(kf[2],qr[1],C0,0,0,0),   P0[10],P0[11],P0[12],P0[13], pw1[0]=PKW(P0,8), pw1[1]=PKW(P0,10), pw1); \
    VRD(5); SBAR(); GAPA(C1=__builtin_amdgcn_mfma_f32_32x32x16_bf16(kf[3],qr[1],C1,0,0,0),   P0[14],P0[15],P1[0],P1[1],   pw1[2]=PKW(P0,12),pw1[3]=PKW(P0,14), pw1); \
    VRD(2); SBAR(); GAPA(C0=__builtin_amdgcn_mfma_f32_32x32x16_bf16(kf[4],qr[2],C0,0,0,0),   P1[2],P1[3],P1[4],P1[5],     pw2[0]=PKW(P1,0), pw2[1]=PKW(P1,2), pw2); \
    VRD(6); SBAR(); GAPA(C1=__builtin_amdgcn_mfma_f32_32x32x16_bf16(kf[5],qr[2],C1,0,0,0),   P1[6],P1[7],P1[8],P1[9],     pw2[2]=PKW(P1,4), pw2[3]=PKW(P1,6), pw2); \
    VRD(3); SBAR(); GAPA(C0=__builtin_amdgcn_mfma_f32_32x32x16_bf16(kf[6],qr[3],C0,0,0,0),   P1[10],P1[11],P1[12],P1[13], pw3[0]=PKW(P1,8), pw3[1]=PKW(P1,10), pw3); \
    VRD(7); SBAR(); GAPA(C1=__builtin_amdgcn_mfma_f32_32x32x16_bf16(kf[7],qr[3],C1,0,0,0),   P1[14],P1[15],0.f,0.f,       pw3[2]=PKW(P1,12),pw3[3]=PKW(P1,14), pw3); \
    l_reg+=sacc; \
    if(GK){DMA_K((t)+3,sl_cur);} if(GV){DMA_V((t)+1,sl_next);} \
    CMASK(C0,C1,t); \
    { float a=MX3(C0[0],C0[1],C1[0]),b=MX3(C0[2],C0[3],C1[1]); a=MX3(a,C1[2],C1[3]); \
      _Pragma("unroll") for(int r=4;r<16;r+=4){a=MX3(a,C0[r],C0[r+1]);b=MX3(b,C0[r+2],C0[r+3]);a=MX3(a,C1[r],C1[r+1]);b=MX3(b,C1[r+2],C1[r+3]);} \
      float rm=__builtin_fmaxf(a,b); { auto rr=__builtin_amdgcn_permlane32_swap(__float_as_uint(rm),__float_as_uint(rm),false,false); rm=__builtin_fmaxf(__uint_as_float(rr[0]),__uint_as_float(rr[1])); } \
      resc=false; \
      if(__builtin_expect(__any(rm>(float)THRL),0)){ const float dl=__builtin_fmaxf(rm,0.f); mhat+=dl; \
        _Pragma("unroll") for(int r=0;r<16;++r){C0[r]-=dl;C1[r]-=dl;} \
        const float f=__builtin_amdgcn_exp2f(-dl); l_reg*=f; if(hi==0)wsf[r32]=f; resc=true; } } \
    SBAR(); BIASLD(P0,P1,(t)+1); SBAR(); \
    GAPB(o[0]=__builtin_amdgcn_mfma_f32_32x32x16_bf16(PAF(0),VFR(0),o[0],0,0,0), C0,0,P0); \
    GAPB(o[1]=__builtin_amdgcn_mfma_f32_32x32x16_bf16(PAF(0),VFR(4),o[1],0,0,0), C0,4,P0); \
    KRD(GL,0); GAPB(o[0]=__builtin_amdgcn_mfma_f32_32x32x16_bf16(PAF(1),VFR(1),o[0],0,0,0), C0,8,P0); \
    KRD(GL,1); GAPB(o[1]=__builtin_amdgcn_mfma_f32_32x32x16_bf16(PAF(1),VFR(5),o[1],0,0,0), C0,12,P0); \
    KRD(GL,2); GAPB(o[0]=__builtin_amdgcn_mfma_f32_32x32x16_bf16(PAF(2),VFR(2),o[0],0,0,0), C1,0,P1); \
    KRD(GL,3); GAPB(o[1]=__builtin_amdgcn_mfma_f32_32x32x16_bf16(PAF(2),VFR(6),o[1],0,0,0), C1,4,P1); \
    GAPB(o[0]=__builtin_amdgcn_mfma_f32_32x32x16_bf16(PAF(3),VFR(3),o[0],0,0,0), C1,8,P1); \
    GAPB(o[1]=__builtin_amdgcn_mfma_f32_32x32x16_bf16(PAF(3),VFR(7),o[1],0,0,0), C1,12,P1); \
    }while(0)
  int t=1;
  #undef CMASK
  #define CMASK(P0,P1,t) do{}while(0)
  for(;t+5<NT;t+=2){
    STEP(pB0,pB1,pA0,pA1,t,true,true,true);     WAIT_BAR(2); RESC(); ROT();
    STEP(pA0,pA1,pB0,pB1,t+1,true,true,true);   WAIT_BAR(2); RESC(); ROT();
  }
  #undef CMASK
  #define CMASK(P0,P1,t) do{int jb_=(t)-(NT-4); if(jb_>=0)cmask(P0,P1,jb_,qrel,hi);}while(0)
  #define ENDW(tt) do{ if((tt)+3<NT){WAIT_BAR(2);} else if((tt)+2<NT){WAIT_BAR(1);} else {WAIT_BAR(0);} }while(0)
  for(;t+1<NT;t+=2){
    STEP(pB0,pB1,pA0,pA1,t,(t+3<NT),(t+1<NT),(t+1<NT));       ENDW(t);   RESC(); ROT();
    STEP(pA0,pA1,pB0,pB1,t+1,(t+4<NT),(t+2<NT),(t+2<NT));     ENDW(t+1); RESC(); ROT();
  }
  STEP(pB0,pB1,pA0,pA1,NT-1,false,false,false); RESC();
  { float sacc=pB0[0]+pB0[1]; _Pragma("unroll") for(int r=2;r<16;++r)sacc+=pB0[r]; _Pragma("unroll") for(int r=0;r<16;++r)sacc+=pB1[r]; l_reg+=sacc;
    pw0=(u32x4){PKW(pB0,0),PKW(pB0,2),PKW(pB0,4),PKW(pB0,6)};pw1=(u32x4){PKW(pB0,8),PKW(pB0,10),PKW(pB0,12),PKW(pB0,14)};pw2=(u32x4){PKW(pB1,0),PKW(pB1,2),PKW(pB1,4),PKW(pB1,6)};pw3=(u32x4){PKW(pB1,8),PKW(pB1,10),PKW(pB1,12),PKW(pB1,14)};
    SBAR(); pv(o,vb0+sl_cur,PAF(0),PAF(1),PAF(2),PAF(3)); }
  #undef PKW
  #undef PAF
  #undef VFR
  #undef PIN
  #undef MX3
  #undef GAPA
  #undef GAPB
  #undef BIASLD
  #undef EX
  #undef VRD
  #undef KRD
  #undef STEP
  #undef ENDW
  {auto rr=__builtin_amdgcn_permlane32_swap(__float_as_uint(l_reg),__float_as_uint(l_reg),false,false);l_reg=__uint_as_float(rr[0])+__uint_as_float(rr[1]);}
  if(hi==0)wsf[32+r32]=l_reg;asm volatile("s_waitcnt lgkmcnt(0)":::"memory");
  float rli[16];
  #pragma unroll
  for(int r=0;r<16;++r)rli[r]=__builtin_amdgcn_rcpf(wsf[32+crow(r,hi)]);
  bf16*Ow=O+(rowbase+q0+wid*QBLK)*DM+h*D;
  { bf16*stg=(bf16*)(shm+LDS_OST)+wid*2048;
    #pragma unroll
    for(int r=0;r<16;++r){const int orow=crow(r,hi);
      #pragma unroll
      for(int d0=0;d0<2;++d0)stg[orow*64+d0*32+r32]=__float2bfloat16(o[d0][r]*rli[r]);}
    asm volatile("s_waitcnt lgkmcnt(0)":::"memory");
    #pragma unroll
    for(int i=0;i<4;++i){const int row=i*8+(lane>>3),ch=lane&7; const u32x4 v=*(const u32x4*)(stg+row*64+ch*8); if(live){ATTN_STORE16(Ow+(long)row*DM+ch*8,v);}} }
  asm volatile("s_waitcnt lgkmcnt(0)\n\ts_barrier":::"memory");
  #undef BIASC
  #undef DMA_K
  #undef DMA_V
  #undef CMASK
  #undef START
  #undef RESC
  #undef ROT
}
constexpr int ATTN_LDS_BYTES=LDS_BYTES;
struct AttnTensors { const bf16* Q; const bf16* K; const bf16* V; bf16* O; };
struct AttnUnit { int bh; int qb; };
struct StaticOrder {
  int vcu;
  __device__ __forceinline__ explicit StaticOrder(int grid,int block):vcu((block%8)*(grid/8)+block/8){}
  __device__ __forceinline__ bool next(int i,AttnUnit&u)const{ if(i>=8)return false; const int p=vcu&1; u.bh=vcu>>1; const int base=4*(i>>1); u.qb=(i&1)?base+3-p:base+p; return true; }
  __device__ __forceinline__ void a_ready(const AttnUnit&)const{}
  __device__ __forceinline__ void done(const AttnUnit&)const{}
};
template<class Sched,int THRL=8> __device__ __forceinline__ void attn_phase(char*lds,const AttnTensors&T,const Sched&S,bool live=true){
  AttnUnit u;
  for(int i=0;S.next(i,u);++i){ S.a_ready(u); attn_unit<THRL>(u.bh/NHEAD,u.bh%NHEAD,u.qb,T.Q,T.K,T.V,T.O,lds,live); S.done(u); }
}
#undef SBAR
#undef WAIT_BAR
}
#define XB_TMO      128
#define XB_XCNT(j)  (256  + 64 * (j))
#define XB_XSUB(j)  (1280 + 64 * (j))
#define XB_XGEN(j)  (2304 + 64 * (j))
#define XB_TOP      3328
#define XB_TOPGEN   3392
#define XCD_BAR_WORDS 3456
#define XB_SPIN_CAP (1u << 18)

__device__ __forceinline__ unsigned xb_ld(unsigned* p)              { return __hip_atomic_load(p, __ATOMIC_RELAXED, __HIP_MEMORY_SCOPE_AGENT); }
__device__ __forceinline__ unsigned xb_add(unsigned* p, unsigned v) { return __hip_atomic_fetch_add(p, v, __ATOMIC_RELAXED, __HIP_MEMORY_SCOPE_AGENT); }
__device__ __forceinline__ unsigned xb_xcc_id() { return (unsigned)__builtin_amdgcn_s_getreg((3 << 11) | 20) & 0xFu; }
#define XB_SPIN(cond, bar) do { unsigned _sp = 0; while (cond) { __builtin_amdgcn_s_sleep(1); \
    if ((++_sp & 255u) == 0u) { if (xb_ld(&(bar)[XB_TMO])) break; if (_sp > XB_SPIN_CAP) { atomicAdd(&(bar)[XB_TMO], 1u); break; } } } } while (0)

struct XcdBarrier {
    unsigned* bar; unsigned x;
    volatile LAS unsigned* st;
};

__device__ __forceinline__ XcdBarrier xcd_barrier_post(unsigned* bar, volatile LAS unsigned* st) {
    XcdBarrier b; b.bar = bar; b.x = xb_xcc_id(); b.st = st;
    if (threadIdx.x == 0) (void)xb_add(&bar[XB_XCNT(b.x)], 1u);
    return b;
}
__device__ __forceinline__ void xcd_barrier_complete(unsigned* bar, unsigned x, unsigned& nloc, unsigned& nx) {
    const unsigned G = gridDim.x * gridDim.y * gridDim.z;
    unsigned sum, cnt, mine, sp = 0u;
    for (;;) {
        sum = 0u; cnt = 0u; mine = 0u;
#pragma unroll
        for (unsigned j = 0; j < 16; ++j) { const unsigned c = xb_ld(&bar[XB_XCNT(j)]); sum += c; cnt += (c > 0u) ? 1u : 0u; mine = (j == x) ? c : mine; }
        if (sum == G) break;
        __builtin_amdgcn_s_sleep(1);
        if ((++sp & 255u) == 0u) { if (xb_ld(&bar[XB_TMO])) break; if (sp > XB_SPIN_CAP) { atomicAdd(&bar[XB_TMO], 1u); break; } }
    }
    nloc = mine > 0u ? mine : 1u; nx = cnt > 0u ? cnt : 1u;
}

__device__ __forceinline__ void xcd_barrier(const XcdBarrier& b) {
    asm volatile("s_waitcnt vmcnt(0)" ::: "memory");
    __syncthreads();
    if (threadIdx.x == 0) {
        unsigned* bar = b.bar;
        __builtin_amdgcn_s_waitcnt(0);
        unsigned nloc = b.st[0], nx = b.st[1];
        if (nloc == 0u) { xcd_barrier_complete(bar, b.x, nloc, nx); b.st[0] = nloc; b.st[1] = nx; }
        const unsigned old = xb_add(&bar[XB_XSUB(b.x)], 1u);
        const unsigned gen = old / nloc;
        if (old + 1u == (gen + 1u) * nloc) {
            __builtin_amdgcn_fence(__ATOMIC_RELEASE, "agent");
            asm volatile("s_waitcnt vmcnt(0)" ::: "memory");
            const unsigned og = xb_add(&bar[XB_TOP], 1u);
            const unsigned tg = og / nx;
            if (og + 1u == (tg + 1u) * nx) xb_add(&bar[XB_TOPGEN], 1u);
            else XB_SPIN(xb_ld(&bar[XB_TOPGEN]) == tg, bar);
            __builtin_amdgcn_fence(__ATOMIC_ACQUIRE, "agent");
            xb_add(&bar[XB_XGEN(b.x)], 1u);
            asm volatile("s_waitcnt vmcnt(0)" ::: "memory");
        } else {
            XB_SPIN(xb_ld(&bar[XB_XGEN(b.x)]) == gen, bar);
            __builtin_amdgcn_fence(__ATOMIC_ACQUIRE, "agent");
            asm volatile("s_waitcnt vmcnt(0)" ::: "memory");
        }
    }
    __syncthreads();
}
constexpr int BATCH = 8, SEQ = 4096, DM = 1024, T = BATCH * SEQ, DFF = 2816, DPLE = 256;
constexpr int NWAVES = 8;
typedef unsigned short bf16;
typedef unsigned v4u __attribute__((ext_vector_type(4)));
typedef unsigned v2u __attribute__((ext_vector_type(2)));
typedef float f32x4 __attribute__((ext_vector_type(4)));
typedef short bf16x8 __attribute__((ext_vector_type(8)));
typedef short v4i16 __attribute__((ext_vector_type(4)));
__device__ __forceinline__ unsigned f2bf(float f) { unsigned u = __builtin_bit_cast(unsigned, f); return (u + 0x7fffu + ((u >> 16) & 1u)) >> 16; }
__device__ __forceinline__ unsigned pk2(float lo, float hi) { return f2bf(lo) | (f2bf(hi) << 16); }

constexpr size_t MiB = 1u << 20;
constexpr size_t WS_SS = 456 * MiB;
constexpr size_t WS_HSS = 474 * MiB;
constexpr size_t WS_BAR = 1856 * 1024;
constexpr size_t WS_LOGF = 2 * MiB;
constexpr size_t WS_ROPE = 4 * MiB;
constexpr size_t WS_WFFI = 8 * MiB;
constexpr size_t WS_WFFO = 52 * MiB;
constexpr size_t WS_WRIN = 74 * MiB;
constexpr size_t WS_WRG = 82 * MiB;
constexpr size_t WS_WRO = 86 * MiB;
constexpr size_t WS_WFIN = 90 * MiB;
constexpr size_t WS_WFZ = 96 * MiB;
constexpr size_t WS_WFO = 97 * MiB;
constexpr size_t WS_WPG = 99 * MiB;
constexpr size_t WS_WPP = 103 * MiB;
constexpr size_t WS_HB = 104 * MiB;
constexpr size_t WS_PB = 168 * MiB;
constexpr size_t WS_POOL = 200 * MiB;
constexpr size_t WS_END = 482 * MiB;
constexpr int LDS_BYTES = 147456, RING_BYTES = 131072;

namespace ret {
constexpr int KP = 544, VP = 144, PPI = 144;
constexpr int L_K = 0, L_V = L_K + 64 * KP, L_P = L_V + 64 * VP, L_ST = L_P + 64 * PPI, L_END = L_ST + 64 * KP;
static_assert(L_END <= RING_BYTES, "retention LDS");
#define MFMA16(a, b, c) __builtin_amdgcn_mfma_f32_16x16x32_bf16((a), (b), (c), 0, 0, 0)
__device__ __forceinline__ bf16x8 trfrag(const LAS char* p, int pitch) {
    const v4i16 lo = __builtin_amdgcn_ds_read_tr16_b64_v4i16((LAS v4i16*)p), hi = __builtin_amdgcn_ds_read_tr16_b64_v4i16((LAS v4i16*)(p + 4 * pitch));
    return (bf16x8){lo[0], lo[1], lo[2], lo[3], hi[0], hi[1], hi[2], hi[3]};
}
__device__ __forceinline__ void ret_phase(LAS char* L, const bf16* Qt, const bf16* Kt, bf16* VO, float* hss, int vcu, bool live = true) {
    int tid_ = threadIdx.x; asm volatile("" : "+v"(tid_));
    const int tid = tid_, lane = tid & 63, w = __builtin_amdgcn_readfirstlane(tid >> 6), m16 = lane & 15, g = lane >> 4, q4 = m16 >> 2, p4 = lane & 3;
    const int ib = w >> 1, half = w & 1;
    const int bh = vcu >> 3, es = vcu & 7, b = bh >> 2, h = bh & 3;
    const float lg = log2f(1.0f - exp2f(-5.0f - (float)h)), gC = exp2f(64.0f * lg);
    const size_t tok0 = (size_t)b * SEQ;
    const bf16* kbase = Kt + tok0 * 1024 + h * 256 + (size_t)(tid >> 5) * 1024 + (tid & 31) * 8;
    const bf16* vbase = VO + tok0 * 2048 + h * 512 + es * 64 + (size_t)(tid >> 3) * 2048 + (tid & 7) * 8;
    const bf16* qbase = Qt + tok0 * 1024 + h * 256 + (size_t)(16 * ib + m16) * 1024 + 8 * g;
    for (int i = tid; i < 64 * KP / 16; i += 512) *(LAS v4u*)(L + L_ST + 16 * i) = (v4u){0u, 0u, 0u, 0u};
    f32x4 st[2][4];
#pragma unroll
    for (int a = 0; a < 2; ++a)
#pragma unroll
        for (int e = 0; e < 4; ++e) st[a][e] = (f32x4){0.f, 0.f, 0.f, 0.f};
    v4u kreg[4], vreg; bf16x8 qn[8];
#define RET_LOAD(c) do { _Pragma("unroll") for (int u_ = 0; u_ < 4; ++u_) kreg[u_] = *(const v4u*)(kbase + (size_t)((c) * 64 + 16 * u_) * 1024); \
        vreg = *(const v4u*)(vbase + (size_t)(c) * 64 * 2048); \
        _Pragma("unroll") for (int s_ = 0; s_ < 8; ++s_) qn[s_] = *(const bf16x8*)(qbase + (size_t)(c) * 64 * 1024 + 32 * s_); } while (0)
    RET_LOAD(0);
    const int troff_k = (8 * g + q4) * KP + 8 * p4, troff_v = (8 * g + q4) * VP + 8 * p4;
    for (int c = 0; c < 64; ++c) {
#pragma unroll
        for (int u_ = 0; u_ < 4; ++u_) *(LAS v4u*)(L + L_K + ((tid >> 5) + 16 * u_) * KP + (tid & 31) * 16) = kreg[u_];
        *(LAS v4u*)(L + L_V + (tid >> 3) * VP + (tid & 7) * 16) = vreg;
        bf16x8 qf[8];
#pragma unroll
        for (int s = 0; s < 8; ++s) qf[s] = qn[s];
        __syncthreads();
        if (c + 1 < 64) RET_LOAD(c + 1);
#pragma unroll
        for (int jj = 0; jj < 2; ++jj) { const int jb = 2 * half + jj; f32x4 sa = (f32x4){0.f, 0.f, 0.f, 0.f};
#pragma unroll
            for (int s = 0; s < 8; ++s) { const bf16x8 a = *(const LAS bf16x8*)(L + L_K + (16 * jb + m16) * KP + (32 * s + 8 * g) * 2); sa = MFMA16(a, qf[s], sa); }
            const int il = 16 * ib + m16, j0 = 16 * jb + 4 * g;
            const float s0 = (j0 + 0 <= il) ? sa[0] : 0.f, s1 = (j0 + 1 <= il) ? sa[1] : 0.f, s2 = (j0 + 2 <= il) ? sa[2] : 0.f, s3 = (j0 + 3 <= il) ? sa[3] : 0.f;
            *(LAS v2u*)(L + L_P + il * PPI + j0 * 2) = (v2u){pk2(s0, s1), pk2(s2, s3)}; }
        f32x4 oa[2];
#pragma unroll
        for (int ee = 0; ee < 2; ++ee) { const int eb = 2 * half + ee; oa[ee] = (f32x4){0.f, 0.f, 0.f, 0.f};
#pragma unroll
            for (int s = 0; s < 8; ++s) { const bf16x8 a = *(const LAS bf16x8*)(L + L_ST + (16 * eb + m16) * KP + (32 * s + 8 * g) * 2); oa[ee] = MFMA16(a, qf[s], oa[ee]); } }
        __syncthreads();
        bf16x8 vt[2][4];
#pragma unroll
        for (int ks = 0; ks < 2; ++ks)
#pragma unroll
            for (int eb = 0; eb < 4; ++eb) vt[ks][eb] = trfrag(L + L_V + (32 * ks) * VP + (16 * eb) * 2 + troff_v, VP);
#pragma unroll
        for (int ks = 0; ks < 2; ++ks) { const bf16x8 pf = *(const LAS bf16x8*)(L + L_P + (16 * ib + m16) * PPI + (32 * ks + 8 * g) * 2);
            if (half == 0) { oa[0] = MFMA16(vt[ks][0], pf, oa[0]); oa[1] = MFMA16(vt[ks][1], pf, oa[1]); }
            else           { oa[0] = MFMA16(vt[ks][2], pf, oa[0]); oa[1] = MFMA16(vt[ks][3], pf, oa[1]); } }
        { const size_t tok = tok0 + (size_t)c * 64 + 16 * ib + m16; float sq = 0.f;
#pragma unroll
            for (int ee = 0; ee < 2; ++ee) { const f32x4 o = oa[ee]; sq += (o[0] * o[0] + o[1] * o[1]) + (o[2] * o[2] + o[3] * o[3]);
                if (live) *(v2u*)(VO + tok * 2048 + h * 512 + es * 64 + 16 * (2 * half + ee) + 4 * g) = (v2u){pk2(o[0], o[1]), pk2(o[2], o[3])}; }
            sq += __shfl_xor(sq, 16); sq += __shfl_xor(sq, 32); if (g == 0 && live) hss[(tok * 4 + h) * 16 + es * 2 + half] = sq; }
#pragma unroll
        for (int ks = 0; ks < 2; ++ks)
#pragma unroll
            for (int dd = 0; dd < 2; ++dd) { const bf16x8 kt = trfrag(L + L_K + (32 * ks) * KP + (16 * (2 * w + dd)) * 2 + troff_k, KP);
#pragma unroll
                for (int eb = 0; eb < 4; ++eb) st[dd][eb] = MFMA16(kt, vt[ks][eb], st[dd][eb]); }
#pragma unroll
        for (int dd = 0; dd < 2; ++dd)
#pragma unroll
            for (int eb = 0; eb < 4; ++eb) { st[dd][eb] = st[dd][eb] * gC; const f32x4 s = st[dd][eb];
                *(LAS v2u*)(L + L_ST + (16 * eb + m16) * KP + (16 * (2 * w + dd) + 4 * g) * 2) = (v2u){pk2(s[0], s[1]), pk2(s[2], s[3])}; }
        __syncthreads();
    }
#undef RET_LOAD
}
}

struct Args { const float* in[14]; float* out; unsigned char* ws; };
struct Frame { LAS unsigned char* lds; int tid, lane, wave, vcu, G; };

__device__ __forceinline__ float wave_sum(float v) {
#pragma unroll
    for (int o = 1; o < 64; o <<= 1) v += __shfl_xor(v, o);
    return v;
}
__device__ __forceinline__ void prep_item(const float* W, int K, int Nsrc, bf16* WT, int rows, int mode, int coloff, const float* ks, LAS float* scr, int item, int lane) {
    const int nblk = rows / 32, kb = item / nblk, nb = item % nblk, k0 = 64 * kb, n0 = 32 * nb;
    const int src0 = mode ? (((n0 >> 7) & 1) * DFF + 128 * (n0 >> 8) + (n0 & 127)) : (coloff + n0);
    float wv[32];
#pragma unroll
    for (int i = 0; i < 32; ++i) { const int kk = 2 * i + (lane >> 5); wv[i] = __builtin_nontemporal_load(W + (size_t)(k0 + kk) * Nsrc + src0 + (lane & 31)); }
#pragma unroll
    for (int i = 0; i < 32; ++i) { const int kk = 2 * i + (lane >> 5); scr[kk * 33 + (lane & 31)] = wv[i]; }
    asm volatile("s_waitcnt lgkmcnt(0)" ::: "memory");
    const int c = lane & 7;
    float sc[8];
#pragma unroll
    for (int x = 0; x < 8; ++x) sc[x] = ks ? ks[k0 + 8 * c + x] : 1.0f;
#pragma unroll
    for (int j = 0; j < 4; ++j) { const int n = (lane >> 3) + 8 * j; const LAS float* s = scr + (8 * c) * 33 + n;
        v4u o; o.x = pk2(s[0 * 33] * sc[0], s[1 * 33] * sc[1]); o.y = pk2(s[2 * 33] * sc[2], s[3 * 33] * sc[3]); o.z = pk2(s[4 * 33] * sc[4], s[5 * 33] * sc[5]); o.w = pk2(s[6 * 33] * sc[6], s[7 * 33] * sc[7]);
        *(v4u*)(WT + (size_t)(n0 + n) * K + k0 + 8 * c) = o; }
    asm volatile("s_waitcnt lgkmcnt(0)" ::: "memory");
}
#define PREP(Wp, K_, Nsrc_, WTp, rows_, mode_, coloff_, ksp) do { const int nit_ = ((K_) / 64) * ((rows_) / 32); \
    for (int it_ = gw; it_ < nit_; it_ += NGW) prep_item((Wp), (K_), (Nsrc_), (WTp), (rows_), (mode_), (coloff_), (ksp), scr, it_, F.lane); } while (0)

typedef const volatile __attribute__((address_space(4))) unsigned long long* kargp_t;
#define KARG(i) ((unsigned long long)(*((kargp_t)__builtin_amdgcn_kernarg_segment_ptr() + (i))))
#define KIN(i) ((const float*)KARG(i))
#define KOUT ((float*)KARG(14))
#define KWS ((unsigned char*)KARG(15))
#define SEAM() do { XcdBarrier b_; b_.bar = (unsigned*)(KWS + WS_BAR); b_.x = xb_xcc_id(); b_.st = (volatile LAS unsigned*)(F.lds + RING_BYTES) + 8; xcd_barrier(b_); } while (0)
#define GEMM_PHASE(EpiT, Aop, Bop, N_, K_, Eobj) do { pg8::Gemm g_{(const pg8::bf16_t*)(Aop), (const pg8::bf16_t*)(Bop), T, (N_), (K_)}; pg8::StaticOrder S_; S_.init(T, (N_), F.G, (int)blockIdx.x); \
        pg8::gemm_phase<EpiT, pg8::StaticOrder, true, true>(F.lds, g_, S_, (Eobj)); } while (0)

__device__ __forceinline__ void p0_prologue(const Frame& F) {
    unsigned char* ws = KWS;
    const float* norm_w = KIN(2);
    float* SS = (float*)(ws + WS_SS); float* HSS = (float*)(ws + WS_HSS);
    const int gw = F.vcu * NWAVES + F.wave, NGW = F.G * NWAVES, gtid = gw * 64 + F.lane, NGT = NGW * 64;
    LAS float* scr = (LAS float*)(F.lds + F.wave * 16384);
    { float* ROPE = (float*)(ws + WS_ROPE);
      for (int i = gtid; i < 4096 * 128; i += NGT) { const int pos = i >> 7, j = i & 127;
        const float inv = exp2f(-(float)j * (13.287712379549449f / 128.0f)); const float ang = (float)pos * inv;
        double tr = (double)ang * 0.15915494309189535; tr -= rint(tr); const float tf = (float)tr;
        ROPE[2 * i] = __builtin_amdgcn_cosf(tf); ROPE[2 * i + 1] = __builtin_amdgcn_sinf(tf); } }
    { const float* x = KIN(0); bf16* HB = (bf16*)(ws + WS_HB);
      for (int m = gw; m < T / 2; m += NGW) {
        f32x4 v[2][4];
#pragma unroll
        for (int rr = 0; rr < 2; ++rr)
#pragma unroll
            for (int j = 0; j < 4; ++j) v[rr][j] = __builtin_nontemporal_load((const f32x4*)(x + (size_t)(m + rr * (T / 2)) * DM) + F.lane + 64 * j);
#pragma unroll
        for (int rr = 0; rr < 2; ++rr) { float s = 0.f; unsigned long long* o8 = (unsigned long long*)(HB + (size_t)(m + rr * (T / 2)) * DM) + F.lane;
#pragma unroll
            for (int j = 0; j < 4; ++j) { const f32x4 q = v[rr][j]; s += (q.x * q.x + q.y * q.y) + (q.z * q.z + q.w * q.w); o8[64 * j] = (unsigned long long)pk2(q.x, q.y) | ((unsigned long long)pk2(q.z, q.w) << 32); }
            s = wave_sum(s); if (F.lane < 16) SS[(size_t)(m + rr * (T / 2)) * 16 + F.lane] = F.lane == 0 ? s : 0.f; } } }
    { const float* pin = KIN(1); bf16* PB = (bf16*)(ws + WS_PB);
      for (int i = gtid; i < 2 * T * DPLE / 16; i += NGT) { f32x4 v[4];
#pragma unroll
        for (int j = 0; j < 4; ++j) v[j] = __builtin_nontemporal_load((const f32x4*)pin + (size_t)j * (2 * T * DPLE / 16) + i);
#pragma unroll
        for (int j = 0; j < 4; ++j) ((unsigned long long*)PB)[(size_t)j * (2 * T * DPLE / 16) + i] = (unsigned long long)pk2(v[j].x, v[j].y) | ((unsigned long long)pk2(v[j].z, v[j].w) << 32); } }
    { const float* fox_w_in = KIN(8); bf16* WFZ = (bf16*)(ws + WS_WFZ);
      for (int i = gtid; i < 16 * 1024; i += NGT) { const int n = i >> 10, k = i & 1023; WFZ[i] = (bf16)f2bf(fox_w_in[(size_t)k * 3088 + 3072 + n] * norm_w[(4 + 1) * DM + k]); } }
#pragma unroll 1
    for (int fi = 0; fi < 4; ++fi) { const int li = fi >> 1, f = fi & 1;
        PREP(KIN(3) + (size_t)fi * DM * 2 * DFF, DM, 2 * DFF, (bf16*)(ws + WS_WFFI) + (size_t)fi * 2 * DFF * DM, 2 * DFF, 1, 0, norm_w + (li * 4 + (f ? 2 : 0)) * DM);
        PREP(KIN(4) + (size_t)fi * DFF * DM, DFF, DM, (bf16*)(ws + WS_WFFO) + (size_t)fi * DM * DFF, DM, 0, 0, (const float*)nullptr); }
    PREP(KIN(5), DM, 6144, (bf16*)(ws + WS_WRIN), 4096, 0, 0, norm_w + 1 * DM);
    PREP(KIN(5), DM, 6144, (bf16*)(ws + WS_WRG), 2048, 0, 4096, norm_w + 1 * DM);
    PREP(KIN(7), 2048, DM, (bf16*)(ws + WS_WRO), DM, 0, 0, (const float*)nullptr);
    PREP(KIN(8), DM, 3088, (bf16*)(ws + WS_WFIN), 3072, 0, 0, norm_w + (4 + 1) * DM);
    PREP(KIN(10), DM, DM, (bf16*)(ws + WS_WFO), DM, 0, 0, (const float*)nullptr);
#pragma unroll 1
    for (int li = 0; li < 2; ++li) {
        PREP(KIN(12) + (size_t)li * DM * DM, DM, DM, (bf16*)(ws + WS_WPG) + (size_t)li * DM * DM, DM, 0, 0, norm_w + (li * 4 + 3) * DM);
        PREP(KIN(11) + (size_t)li * DPLE * DM, DPLE, DM, (bf16*)(ws + WS_WPP) + (size_t)li * DM * DPLE, DM, 0, 0, (const float*)nullptr); }
}

template <int LI> __device__ __forceinline__ bf16* resid() { return LI ? (bf16*)KOUT : (bf16*)(KWS + WS_HB); }
template <int FI, int SITE, bool WITH_PP> __device__ __forceinline__ void ffn_half(const Frame& F, cg::grid_group& grid) {
#ifdef PROBE_FFI
    { unsigned char* ws = KWS; pg8::EpiSwiglu E{(pg8::bf16_t*)(ws + WS_POOL), (const float*)(ws + WS_SS) + (size_t)SITE * T * 16};
      GEMM_PHASE(pg8::EpiSwiglu, resid<(FI >> 1)>(), (bf16*)(ws + WS_WFFI) + (size_t)FI * 2 * DFF * DM, 2 * DFF, DM, E); }
    SEAM();
#endif
    { unsigned char* ws = KWS; pg8::EpiSwiglu E{(pg8::bf16_t*)(ws + WS_POOL), (const float*)(ws + WS_SS) + (size_t)SITE * T * 16};
      GEMM_PHASE(pg8::EpiSwiglu, resid<(FI >> 1)>(), (bf16*)(ws + WS_WFFI) + (size_t)FI * 2 * DFF * DM, 2 * DFF, DM, E); }
    SEAM();
    { unsigned char* ws = KWS; bf16* R = resid<(FI >> 1)>(); pg8::EpiRes E{(const pg8::bf16_t*)R, (pg8::bf16_t*)R, (float*)(ws + WS_SS) + (size_t)(SITE + 1) * T * 16, 0.5f};
      GEMM_PHASE(pg8::EpiRes, ws + WS_POOL, (bf16*)(ws + WS_WFFO) + (size_t)FI * DM * DFF, DM, DFF, E); }
    if (WITH_PP) { unsigned char* ws = KWS; constexpr int LI = FI >> 1; pg8::EpiPlain E{(pg8::bf16_t*)(ws + WS_POOL + 176 * MiB), DM, (const float*)nullptr, 0, 0, 1.0f};
      GEMM_PHASE(pg8::EpiPlain, (bf16*)(ws + WS_PB) + (size_t)LI * T * DPLE, (bf16*)(ws + WS_WPP) + (size_t)LI * DM * DPLE, DM, DPLE, E); }
    SEAM();
}
template <int LI> __device__ __forceinline__ void ple_phase(const Frame& F, cg::grid_group& grid) {
    { unsigned char* ws = KWS; float* SS = (float*)(ws + WS_SS); bf16* R = resid<LI>();
      pg8::EpiPle<LI == 1> E{(const pg8::bf16_t*)R, (pg8::bf16_t*)KOUT, (float*)(ws + WS_POOL), SS + (size_t)(4 * LI + 4) * T * 16, SS + (size_t)(4 * LI + 3) * T * 16, (const pg8::bf16_t*)(ws + WS_POOL + 176 * MiB)};
      GEMM_PHASE(pg8::EpiPle<LI == 1>, R, (bf16*)(ws + WS_WPG) + (size_t)LI * DM * DM, DM, DM, E); }
    SEAM();
}
__device__ __forceinline__ void retention_mixer(const Frame& F, cg::grid_group& grid) {
    { unsigned char* ws = KWS; pg8::EpiRetIn E{(pg8::bf16_t*)(ws + WS_POOL), (pg8::bf16_t*)(ws + WS_POOL + 64 * MiB), (pg8::bf16_t*)(ws + WS_POOL + 128 * MiB), (const float*)(ws + WS_SS) + (size_t)T * 16, (const float*)(ws + WS_ROPE)};
      GEMM_PHASE(pg8::EpiRetIn, ws + WS_HB, ws + WS_WRIN, 4096, DM, E); }
    SEAM();
#ifdef PROBE_RET
    { unsigned char* ws = KWS; ret::ret_phase((LAS char*)F.lds, (const bf16*)(ws + WS_POOL), (const bf16*)(ws + WS_POOL + 64 * MiB), (bf16*)(ws + WS_POOL + 128 * MiB), (float*)(ws + WS_HSS), F.vcu, KARG(15) == 1ull); }
    SEAM();
#endif
    { unsigned char* ws = KWS; ret::ret_phase((LAS char*)F.lds, (const bf16*)(ws + WS_POOL), (const bf16*)(ws + WS_POOL + 64 * MiB), (bf16*)(ws + WS_POOL + 128 * MiB), (float*)(ws + WS_HSS), F.vcu); }
    SEAM();
    { unsigned char* ws = KWS; pg8::EpiRetGate E{(pg8::bf16_t*)(ws + WS_POOL + 128 * MiB), (const float*)(ws + WS_SS) + (size_t)T * 16, (const float*)(ws + WS_HSS), KIN(6)};
      GEMM_PHASE(pg8::EpiRetGate, ws + WS_HB, ws + WS_WRG, 2048, DM, E); }
    SEAM();
    { unsigned char* ws = KWS; pg8::EpiRes E{(const pg8::bf16_t*)(ws + WS_HB), (pg8::bf16_t*)(ws + WS_HB), (float*)(ws + WS_SS) + 2 * (size_t)T * 16, 1.0f};
      GEMM_PHASE(pg8::EpiRes, ws + WS_POOL + 128 * MiB, ws + WS_WRO, DM, 2048, E); }
    SEAM();
}
__device__ __forceinline__ void fox_mixer(const Frame& F, cg::grid_group& grid, unsigned char* lds_generic) {
    { unsigned char* ws = KWS; pg8::EpiPlain E{(pg8::bf16_t*)(ws + WS_POOL), DM, (const float*)(ws + WS_SS) + 5 * (size_t)T * 16, DM, (size_t)(64 * MiB / 2), attn_body::C2};
      GEMM_PHASE(pg8::EpiPlain, KOUT, ws + WS_WFIN, 3072, DM, E); }
    { unsigned char* ws = KWS; const bf16* HB = (const bf16*)KOUT; const bf16* WFZ = (const bf16*)(ws + WS_WFZ); float* LOGF = (float*)(ws + WS_LOGF); const float* ssm = (const float*)(ws + WS_SS) + 5 * (size_t)T * 16; const float* fox_b_f = KIN(9);
      const int gw = F.vcu * NWAVES + F.wave, NGW = F.G * NWAVES;
      for (int task = gw; task < T / 16; task += NGW) {
        const int m16 = F.lane & 15, g = F.lane >> 4; f32x4 a4 = (f32x4){0.f, 0.f, 0.f, 0.f};
        const bf16* ar = HB + (size_t)(16 * task + m16) * DM + 8 * g; const bf16* br = WFZ + (size_t)m16 * DM + 8 * g;
#pragma unroll 8
        for (int s = 0; s < 32; ++s) a4 = __builtin_amdgcn_mfma_f32_16x16x32_bf16(*(const bf16x8*)(ar + 32 * s), *(const bf16x8*)(br + 32 * s), a4, 0, 0, 0);
        const float bfh = fox_b_f[m16];
#pragma unroll
        for (int r = 0; r < 4; ++r) { const int t = 16 * task + 4 * g + r; const float z = a4[r] * pg8::rinv_of(ssm, t) + bfh;
            LOGF[(size_t)t * 16 + m16] = fminf(z, 0.f) - log1pf(__expf(-fabsf(z))); } } }
    SEAM();
    {
        unsigned char* ws = KWS; const float* LOGF = (const float*)(ws + WS_LOGF);
        const int bh = F.vcu >> 1, b = bh >> 4, h = bh & 15; LAS float* nb = (LAS float*)(F.lds + attn_body::LDS_NB); LAS float* wtot = (LAS float*)(F.lds + attn_body::LDS_WS);
        float v[8]; float run = 0.f;
#pragma unroll
        for (int q = 0; q < 8; ++q) { run += LOGF[((size_t)b * SEQ + 8 * F.tid + q) * 16 + h]; v[q] = run; }
        float incl = run;
#pragma unroll
        for (int o = 1; o < 64; o <<= 1) { const float y = __shfl_up(incl, o); if (F.lane >= o) incl += y; }
        if (F.lane == 63) wtot[F.wave] = incl;
        __syncthreads();
        float off = incl - run;
        for (int w2 = 0; w2 < F.wave; ++w2) off += wtot[w2];
#pragma unroll
        for (int q = 0; q < 8; ++q) nb[8 * F.tid + q] = -(off + v[q]) * 1.4426950408889634f;
        __syncthreads();
        const attn_body::bf16* FQ = (const attn_body::bf16*)(ws + WS_POOL);
        const attn_body::AttnTensors AT{FQ, FQ + (size_t)T * DM, FQ + (size_t)2 * T * DM, (attn_body::bf16*)FQ};
        const attn_body::StaticOrder S((int)F.G, (int)blockIdx.x);
#ifdef PROBE_ATTN
        attn_body::attn_phase<attn_body::StaticOrder>((char*)lds_generic, AT, S, KARG(15) == 1ull);
#endif
        attn_body::attn_phase<attn_body::StaticOrder, 64>((char*)lds_generic, AT, S);
    }
    SEAM();
    { unsigned char* ws = KWS; bf16* R = (bf16*)KOUT; pg8::EpiRes E{(const pg8::bf16_t*)R, (pg8::bf16_t*)R, (float*)(ws + WS_SS) + 6 * (size_t)T * 16, 1.0f};
      GEMM_PHASE(pg8::EpiRes, ws + WS_POOL, ws + WS_WFO, DM, DM, E); }
    SEAM();
}

__global__ void __launch_bounds__(NWAVES * 64, 2) hybrid_fwd(Args args) {
    extern __shared__ __attribute__((aligned(16))) unsigned char lds[];
    cg::grid_group grid = cg::this_grid();
    Frame F; F.lds = (LAS unsigned char*)lds; F.tid = threadIdx.x; F.lane = F.tid & 63; F.wave = __builtin_amdgcn_readfirstlane(F.tid >> 6);
    F.G = gridDim.x; { const int bx = blockIdx.x; F.vcu = (F.G % 8 == 0) ? (bx % 8) * (F.G / 8) + bx / 8 : bx; }
    if (F.tid < 64) ((LAS unsigned*)(F.lds + RING_BYTES))[F.tid] = 0u;
    __syncthreads();
    (void)xcd_barrier_post((unsigned*)(KWS + WS_BAR), (volatile LAS unsigned*)(F.lds + RING_BYTES) + 8);
    p0_prologue(F);
    grid.sync();
#ifdef PROBE_P0
    p0_prologue(F);
    SEAM();
#endif
    ffn_half<0, 0, false>(F, grid);
    retention_mixer(F, grid);
    ffn_half<1, 2, true>(F, grid);
    ple_phase<0>(F, grid);
    ffn_half<2, 4, false>(F, grid);
    fox_mixer(F, grid, lds);
    ffn_half<3, 6, true>(F, grid);
    ple_phase<1>(F, grid);
#ifdef PROBE_SYNC
#pragma unroll 1
    for (int i_ = 0; i_ < PROBE_SYNC; ++i_) grid.sync();
#endif
    { float* hres = KOUT; const float* hfin = (const float*)(KWS + WS_POOL); const float* final_norm_w = KIN(13); const int gw = F.vcu * NWAVES + F.wave, NGW = F.G * NWAVES;
      for (int m = gw; m < T; m += NGW) {
        const f32x4* xi = (const f32x4*)(hfin + (size_t)m * DM) + F.lane; f32x4* xr = (f32x4*)(hres + (size_t)m * DM) + F.lane; const f32x4* wr = (const f32x4*)final_norm_w + F.lane; f32x4 v[4]; float s = 0.f;
#pragma unroll
        for (int j = 0; j < 4; ++j) { v[j] = xi[64 * j]; s += (v[j].x * v[j].x + v[j].y * v[j].y) + (v[j].z * v[j].z + v[j].w * v[j].w); }
        const float ri = 1.0f / sqrtf(wave_sum(s) * (1.0f / DM) + 1e-6f);
#pragma unroll
        for (int j = 0; j < 4; ++j) xr[64 * j] = v[j] * ri * wr[64 * j];
      } }
}

extern "C" void kernel_launch(void* const* d_in, const int* in_sizes, int n_in, void* d_out, int out_size, void* d_ws, size_t ws_size, hipStream_t stream) {
    static int grid = 0;
    if (grid == 0) {
        if (n_in != 14 || out_size != T * DM || ws_size < WS_END) { fprintf(stderr, "kernel_launch: unexpected shapes (n_in %d out %d ws %zu)\n", n_in, out_size, ws_size); grid = -1; return; }
        int dev = 0, cus = 0, per_cu = 0;
        if (hipGetDevice(&dev) != hipSuccess || hipDeviceGetAttribute(&cus, hipDeviceAttributeMultiprocessorCount, dev) != hipSuccess) { grid = -1; return; }
        if (hipFuncSetAttribute((const void*)hybrid_fwd, hipFuncAttributeMaxDynamicSharedMemorySize, LDS_BYTES) != hipSuccess) { fprintf(stderr, "kernel_launch: hipFuncSetAttribute failed\n"); grid = -1; return; }
        if (hipOccupancyMaxActiveBlocksPerMultiprocessor(&per_cu, (const void*)hybrid_fwd, NWAVES * 64, LDS_BYTES) != hipSuccess || per_cu < 1) { fprintf(stderr, "kernel_launch: occupancy query says %d\n", per_cu); per_cu = 1; }
        (void)hipGetLastError();
        grid = cus * 1;
    }
    if (grid < 0) return;
    if (hipMemsetAsync((char*)d_ws + WS_BAR, 0, 16384, stream) != hipSuccess) { fprintf(stderr, "kernel_launch: memset failed\n"); return; }
    Args a{};
    for (int i = 0; i < 14; ++i) a.in[i] = (const float*)d_in[i];
    a.out = (float*)d_out; a.ws = (unsigned char*)d_ws;
    void* kargs[] = {&a};
    hipError_t e = hipLaunchCooperativeKernel((const void*)hybrid_fwd, dim3(grid), dim3(NWAVES * 64), kargs, LDS_BYTES, stream);
    if (e != hipSuccess) fprintf(stderr, "cooperative launch failed: %s (grid %d)\n", hipGetErrorString(e), grid);
}
```

```cpp
#include <hip/hip_runtime.h>
#include <hip/hip_cooperative_groups.h>
#include <cstdio>
#include <cstdint>
namespace cg = cooperative_groups;
#define GAS __attribute__((address_space(1)))
#define LAS __attribute__((address_space(3)))
namespace pg8 {
#define PG8_LAS __attribute__((address_space(3)))
typedef unsigned short bf16_t;
typedef short bf16x8 __attribute__((ext_vector_type(8)));
typedef float f32x4 __attribute__((ext_vector_type(4)));
typedef unsigned u32x4 __attribute__((ext_vector_type(4)));
constexpr int BM = 256, BK = 64, HALF = 128, HTB = HALF * BK * 2  , STAGE_BYTES = 8 * HTB, NXCD = 8, WGM = 8;

__host__ __device__ __forceinline__ int lds_byte(int r, int c) { const int st = (r >> 4) * 2 + (c >> 5), rr = r & 15, cc = c & 31, ob = rr * 64 + cc * 2; return st * 1024 + (ob ^ (((ob >> 9) & 1) << 5)); }
__host__ __device__ __forceinline__ void stage_rc(int b, int& R, int& C) { const int st = b / 1024, sb = b % 1024, swz = sb ^ (((sb >> 9) & 1) << 5); R = (st >> 1) * 16 + swz / 64; C = (st & 1) * 32 + (swz % 64) / 2; }
__host__ __device__ __forceinline__ int perm32(int rho) { const int n = rho >> 4, i = rho & 15; return 8 * (i >> 2) + 4 * n + (i & 3); }

struct Unit { int pm, pn; };
struct Gemm { const bf16_t* A; const bf16_t* Bt; int M, N, K; };

struct StaticOrder {
    int nM, nN, nwg, G, c;
    __host__ __device__ void init(int M, int N, int G_, int c_) { nM = M / BM; nN = N / BM; nwg = nM * nN; G = G_; c = c_; }
    __host__ __device__ bool next(int i, Unit& u) const {
        const long L = (long)i * G + c; if (L >= nwg) return false;
        int wgid = (int)L; { const int q = nwg / NXCD, r = nwg % NXCD, xcd = wgid % NXCD, off = wgid / NXCD; wgid = (xcd < r ? xcd * (q + 1) : r * (q + 1) + (xcd - r) * q) + off; }
        const int nig = WGM * nN, gid = wgid / nig, fm = gid * WGM, gsz = (nM - fm) < WGM ? (nM - fm) : WGM;
        u.pm = fm + ((wgid % nig) % gsz); u.pn = (wgid % nig) / gsz; return true;
    }
    __device__ __forceinline__ void a_ready(const Unit&) const {}
    __device__ __forceinline__ void done(const Unit&) const {}
};
typedef float f32x2_t __attribute__((ext_vector_type(2))); typedef __bf16 bf16x2_t __attribute__((ext_vector_type(2)));
__device__ __forceinline__ unsigned cvt_pk_bf16(float lo, float hi) { const f32x2_t v = {lo, hi}; const bf16x2_t b = __builtin_convertvector(v, bf16x2_t); return __builtin_bit_cast(unsigned, b); }
__device__ __forceinline__ u32x4 pack8(const f32x4 v0, const f32x4 v1) { u32x4 w; w.x = cvt_pk_bf16(v0[0], v0[1]); w.y = cvt_pk_bf16(v0[2], v0[3]); w.z = cvt_pk_bf16(v1[0], v1[1]); w.w = cvt_pk_bf16(v1[2], v1[3]); return w; }
__device__ __forceinline__ float bflo(unsigned u) { return __uint_as_float(u << 16); }
__device__ __forceinline__ float bfhi(unsigned u) { return __uint_as_float(u & 0xffff0000u); }
__device__ __forceinline__ void unpack8(const u32x4 w, f32x4& v0, f32x4& v1) { v0 = (f32x4){bflo(w.x), bfhi(w.x), bflo(w.y), bfhi(w.y)}; v1 = (f32x4){bflo(w.z), bfhi(w.z), bflo(w.w), bfhi(w.w)}; }
__device__ __forceinline__ float sigm(float x) { return __builtin_amdgcn_rcpf(1.0f + __builtin_amdgcn_exp2f(-1.4426950408889634f * x)); }
__device__ __forceinline__ f32x4 silu4(const f32x4 x) { return (f32x4){x[0] * sigm(x[0]), x[1] * sigm(x[1]), x[2] * sigm(x[2]), x[3] * sigm(x[3])}; }
__device__ __forceinline__ f32x4 sigm4(const f32x4 x) { return (f32x4){sigm(x[0]), sigm(x[1]), sigm(x[2]), sigm(x[3])}; }
__device__ __forceinline__ float sum16(const float* p) { const f32x4* q = (const f32x4*)p; const f32x4 a = q[0], b = q[1], c = q[2], d = q[3];
    return (((a[0] + a[1]) + (a[2] + a[3])) + ((b[0] + b[1]) + (b[2] + b[3]))) + (((c[0] + c[1]) + (c[2] + c[3])) + ((d[0] + d[1]) + (d[2] + d[3]))); }
__device__ __forceinline__ float rinv_of(const float* ss, int r) { return 1.0f / sqrtf(sum16(ss + (size_t)r * 16) * (1.0f / 1024.0f) + 1e-6f); }
#define EPI_ARGS const f32x4 (&acc)[2][2][4][2], const Unit& u, int wr, int wc, int fr, int fq
#define EPI_ROWS(ai, m) (u.pm * BM + (ai) * HALF + wr * 64 + (m) * 16 + fr)

struct EpiSwiglu { static constexpr bool PERM = true, AFTER_DRAIN = false; bf16_t* act; const float* ss;
    __device__ __forceinline__ void operator()(EPI_ARGS) const {
        const int col0 = u.pn * HALF + wc * 32 + 8 * fq;
#pragma unroll
        for (int ai = 0; ai < 2; ++ai)
#pragma unroll
            for (int m = 0; m < 4; ++m) { const int r = EPI_ROWS(ai, m); const float ri = rinv_of(ss, r);
                const f32x4 a0 = silu4(acc[ai][0][m][0] * ri) * (acc[ai][1][m][0] * ri), a1 = silu4(acc[ai][0][m][1] * ri) * (acc[ai][1][m][1] * ri);
                *(u32x4*)(act + (size_t)r * 2816 + col0) = pack8(a0, a1); }
    }
};
struct EpiRes { static constexpr bool PERM = true, AFTER_DRAIN = false; const bf16_t* rin; bf16_t* rout; float* ssn; float scale;
    __device__ __forceinline__ void operator()(EPI_ARGS) const {
#pragma unroll
        for (int ai = 0; ai < 2; ++ai)
#pragma unroll
            for (int m = 0; m < 4; ++m) { const int r = EPI_ROWS(ai, m); float sq = 0.f;
#pragma unroll
                for (int bj = 0; bj < 2; ++bj) { const size_t off = (size_t)r * 1024 + u.pn * BM + bj * HALF + wc * 32 + 8 * fq;
                    f32x4 h0, h1; unpack8(*(const u32x4*)(rin + off), h0, h1);
                    const f32x4 v0 = h0 + acc[ai][bj][m][0] * scale, v1 = h1 + acc[ai][bj][m][1] * scale;
                    *(u32x4*)(rout + off) = pack8(v0, v1);
                    sq += (v0[0] * v0[0] + v0[1] * v0[1]) + (v0[2] * v0[2] + v0[3] * v0[3]) + (v1[0] * v1[0] + v1[1] * v1[1]) + (v1[2] * v1[2] + v1[3] * v1[3]); }
                sq += __shfl_xor(sq, 16); sq += __shfl_xor(sq, 32); if (fq == 0) ssn[(size_t)r * 16 + u.pn * 4 + wc] = sq; }
    }
};
template <bool F32OUT> struct EpiPle { static constexpr bool PERM = true, AFTER_DRAIN = false; const bf16_t* rin; bf16_t* rout; float* fout; float* ssn; const float* ss; const bf16_t* pp;
    __device__ __forceinline__ void operator()(EPI_ARGS) const {
#pragma unroll
        for (int ai = 0; ai < 2; ++ai)
#pragma unroll
            for (int m = 0; m < 4; ++m) { const int r = EPI_ROWS(ai, m); const float ri = rinv_of(ss, r); float sq = 0.f;
#pragma unroll
                for (int bj = 0; bj < 2; ++bj) { const size_t off = (size_t)r * 1024 + u.pn * BM + bj * HALF + wc * 32 + 8 * fq;
                    f32x4 p0, p1, h0, h1; unpack8(*(const u32x4*)(pp + off), p0, p1); unpack8(*(const u32x4*)(rin + off), h0, h1);
                    const f32x4 v0 = h0 + sigm4(acc[ai][bj][m][0] * ri) * p0, v1 = h1 + sigm4(acc[ai][bj][m][1] * ri) * p1;
                    if (F32OUT) { *(f32x4*)(fout + off) = v0; *(f32x4*)(fout + off + 4) = v1; }
                    else { *(u32x4*)(rout + off) = pack8(v0, v1);
                        sq += (v0[0] * v0[0] + v0[1] * v0[1]) + (v0[2] * v0[2] + v0[3] * v0[3]) + (v1[0] * v1[0] + v1[1] * v1[1]) + (v1[2] * v1[2] + v1[3] * v1[3]); } }
                if (!F32OUT) { sq += __shfl_xor(sq, 16); sq += __shfl_xor(sq, 32); if (fq == 0) ssn[(size_t)r * 16 + u.pn * 4 + wc] = sq; } }
    }
};
struct EpiPlain { static constexpr bool PERM = true, AFTER_DRAIN = false; bf16_t* O; int ldc; const float* ss; int split_cols; size_t split_stride; float scale0;
    __device__ __forceinline__ void operator()(EPI_ARGS) const {
        int colt = u.pn * BM; bf16_t* base = O; float sc = 1.f;
        if (split_cols) { const int t = colt / split_cols; base += (size_t)t * split_stride; colt -= t * split_cols; if (t == 0) sc = scale0; }
        const int col0 = colt + wc * 32 + 8 * fq;
#pragma unroll
        for (int ai = 0; ai < 2; ++ai)
#pragma unroll
            for (int m = 0; m < 4; ++m) { const int r = EPI_ROWS(ai, m); const float ri = (ss ? rinv_of(ss, r) : 1.0f) * sc;
#pragma unroll
                for (int bj = 0; bj < 2; ++bj) *(u32x4*)(base + (size_t)r * ldc + col0 + bj * HALF) = pack8(acc[ai][bj][m][0] * ri, acc[ai][bj][m][1] * ri); }
    }
};
struct EpiRetIn { static constexpr bool PERM = true, AFTER_DRAIN = false; bf16_t* Qt; bf16_t* Kt; bf16_t* V; const float* ss; const float* rope  ;
    __device__ __forceinline__ void operator()(EPI_ARGS) const {
        const int pn = u.pn;
        if (pn >= 8) {
            const int col0 = (pn - 8) * BM + wc * 32 + 8 * fq;
#pragma unroll
            for (int ai = 0; ai < 2; ++ai)
#pragma unroll
                for (int m = 0; m < 4; ++m) { const int r = EPI_ROWS(ai, m); const float ri = rinv_of(ss, r);
#pragma unroll
                    for (int bj = 0; bj < 2; ++bj) *(u32x4*)(V + (size_t)r * 2048 + col0 + bj * HALF) = pack8(acc[ai][bj][m][0] * ri, acc[ai][bj][m][1] * ri); }
            return;
        }
        const bool isk = pn >= 4; const int hd = pn & 3; bf16_t* outp = isk ? Kt : Qt;
        const float lg = log2f(1.0f - exp2f(-5.0f - (float)hd));
        const int j0 = wc * 32 + 8 * fq;
#pragma unroll
        for (int ai = 0; ai < 2; ++ai)
#pragma unroll
            for (int m = 0; m < 4; ++m) { const int r = EPI_ROWS(ai, m); const int pos = r & 4095; const float e1 = (float)((pos & 63) + 1) * lg;
                const float f = rinv_of(ss, r) * (isk ? 0.0625f * exp2f(-e1) : exp2f(e1));
                const f32x4* cs = (const f32x4*)(rope + ((size_t)pos * 128 + j0) * 2);
                const f32x4 c01 = cs[0], c23 = cs[1], c45 = cs[2], c67 = cs[3];
                const f32x4 x10 = acc[ai][0][m][0] * f, x11 = acc[ai][0][m][1] * f, x20 = acc[ai][1][m][0] * f, x21 = acc[ai][1][m][1] * f;
                const f32x4 cc0 = (f32x4){c01[0], c01[2], c23[0], c23[2]}, sn0 = (f32x4){c01[1], c01[3], c23[1], c23[3]};
                const f32x4 cc1 = (f32x4){c45[0], c45[2], c67[0], c67[2]}, sn1 = (f32x4){c45[1], c45[3], c67[1], c67[3]};
                const f32x4 y10 = x10 * cc0 - x20 * sn0, y11 = x11 * cc1 - x21 * sn1, y20 = x10 * sn0 + x20 * cc0, y21 = x11 * sn1 + x21 * cc1;
                bf16_t* rowp = outp + (size_t)r * 1024 + hd * 256 + j0;
                *(u32x4*)(rowp) = pack8(y10, y11); *(u32x4*)(rowp + HALF) = pack8(y20, y21); }
    }
};
struct EpiRetGate { static constexpr bool PERM = true, AFTER_DRAIN = false; bf16_t* Y; const float* ss; const float* hss; const float* gnw;
    __device__ __forceinline__ void operator()(EPI_ARGS) const {
        const int hd = u.pn >> 1;
#pragma unroll
        for (int ai = 0; ai < 2; ++ai)
#pragma unroll
            for (int m = 0; m < 4; ++m) { const int r = EPI_ROWS(ai, m); const float ri = rinv_of(ss, r); const float hr = 1.0f / sqrtf(sum16(hss + ((size_t)r * 4 + hd) * 16) * (1.0f / 512.0f) + 1e-6f);
#pragma unroll
                for (int bj = 0; bj < 2; ++bj) { const int c = u.pn * BM + bj * HALF + wc * 32 + 8 * fq; bf16_t* p = Y + (size_t)r * 2048 + c;
                    f32x4 o0, o1; unpack8(*(const u32x4*)p, o0, o1);
                    const f32x4 g0 = *(const f32x4*)(gnw + c) * hr, g1 = *(const f32x4*)(gnw + c + 4) * hr;
                    *(u32x4*)p = pack8(silu4(acc[ai][bj][m][0] * ri) * o0 * g0, silu4(acc[ai][bj][m][1] * ri) * o1 * g1); }
            }
    }
};
template <class Epi, class Sched, bool ALIGN_EPI = false, bool SP2 = false>
__device__ __forceinline__ void gemm_phase(PG8_LAS unsigned char* lds, const Gemm g, const Sched& S, const Epi& E) {
    int tid_ = threadIdx.x; asm volatile("" : "+v"(tid_));
    const int tid = tid_, wid = __builtin_amdgcn_readfirstlane(tid >> 6), lane = tid & 63, wr = wid >> 2, wc = wid & 3, fr = lane & 15, fq = lane >> 4;
    const int K = g.K, nt = K / BK;
    unsigned voffA[2], voffB[2];
#pragma unroll
    for (int i = 0; i < 2; ++i) { int R, C; stage_rc(tid * 16 + i * 8192, R, C); const int Rb = Epi::PERM ? ((R & ~31) + perm32(R & 31)) : R;
        voffA[i] = (unsigned)(R * K + C) * 2u; voffB[i] = (unsigned)(Rb * K + C) * 2u; }
    const size_t kstep = (size_t)(BK * 2);
    const size_t hstep = (size_t)HALF * K * 2;
    const size_t tstep = 2 * hstep;
    const unsigned ldsw = (unsigned)wid * 1024u;
    const int aoff = lds_byte(wr * 64 + fr, fq * 8), boff = lds_byte(wc * 32 + fr, fq * 8);
#define PG8_SA(b, h) (((b) * 2 + (h)) * HTB)
#define PG8_SB(b, h) ((4 + (b) * 2 + (h)) * HTB)
#define PG8_STAGE(bufoff, gbase, voff) do { _Pragma("unroll") for (int _i = 0; _i < 2; ++_i) \
        __builtin_amdgcn_global_load_lds((const unsigned*)((const char*)(gbase) + (voff)[_i]), (PG8_LAS unsigned*)(lds + (bufoff) + ldsw + _i * 8192), 16, 0, 0); } while (0)
#define PG8_LDA(dst, b, h) do { _Pragma("unroll") for (int m = 0; m < 4; ++m) _Pragma("unroll") for (int k = 0; k < 2; ++k) dst[m][k] = *(const PG8_LAS bf16x8*)(lds + PG8_SA(b, h) + aoff + m * 2048 + k * 1024); } while (0)
#define PG8_LDB(dst, b, h) do { _Pragma("unroll") for (int n = 0; n < 2; ++n) _Pragma("unroll") for (int k = 0; k < 2; ++k) dst[n][k] = *(const PG8_LAS bf16x8*)(lds + PG8_SB(b, h) + boff + n * 2048 + k * 1024); } while (0)
#define PG8_MMA(ai, bj, At, Bt) do { __builtin_amdgcn_s_setprio(1); _Pragma("unroll") for (int m = 0; m < 4; ++m) _Pragma("unroll") for (int n = 0; n < 2; ++n) _Pragma("unroll") for (int k = 0; k < 2; ++k) \
        acc[ai][bj][m][n] = __builtin_amdgcn_mfma_f32_16x16x32_bf16(Bt[n][k], At[m][k], acc[ai][bj][m][n], 0, 0, 0); __builtin_amdgcn_s_setprio(0); } while (0)
#define PG8_WAIT_V(n) asm volatile("s_waitcnt vmcnt(" #n ")" ::: "memory")
#define PG8_WAIT_L(n) asm volatile("s_waitcnt lgkmcnt(" #n ")" ::: "memory")
#define PG8_BAR __builtin_amdgcn_s_barrier()
#define PG8_SCHED __builtin_amdgcn_sched_barrier(0)
    Unit cur, nxt; int ui = 0;
    if (!S.next(0, cur)) return;
    f32x4 acc[2][2][4][2];
#pragma unroll
    for (int a = 0; a < 2; ++a)
#pragma unroll
        for (int b = 0; b < 2; ++b)
#pragma unroll
            for (int m = 0; m < 4; ++m)
#pragma unroll
                for (int n = 0; n < 2; ++n) acc[a][b][m][n] = (f32x4){0.f, 0.f, 0.f, 0.f};
    bf16x8 At[4][2], B0[2][2], B1[2][2];
    const char* cA = (const char*)g.A + (size_t)cur.pm * tstep; const char* cB = (const char*)g.Bt + (size_t)cur.pn * tstep;
    S.a_ready(cur);
    if constexpr (SP2) {
        PG8_STAGE(PG8_SB(0, 0), cB, voffB); PG8_STAGE(PG8_SB(0, 1), cB + hstep, voffB); PG8_STAGE(PG8_SA(0, 0), cA, voffA); PG8_STAGE(PG8_SA(0, 1), cA + hstep, voffA);
        if (wr == 1) PG8_BAR;
        PG8_WAIT_V(2); PG8_BAR;
        PG8_STAGE(PG8_SB(1, 0), cB + kstep, voffB); PG8_STAGE(PG8_SA(1, 0), cA + kstep, voffA); PG8_STAGE(PG8_SB(1, 1), cB + hstep + kstep, voffB);
        PG8_WAIT_V(6); PG8_BAR;
    } else {
        PG8_STAGE(PG8_SB(0, 0), cB, voffB); PG8_STAGE(PG8_SA(0, 0), cA, voffA); PG8_STAGE(PG8_SB(0, 1), cB + hstep, voffB); PG8_STAGE(PG8_SA(0, 1), cA + hstep, voffA);
        if (wr == 1) PG8_BAR;
        PG8_WAIT_V(4); PG8_BAR;
        PG8_STAGE(PG8_SB(1, 0), cB + kstep, voffB); PG8_STAGE(PG8_SA(1, 0), cA + kstep, voffA); PG8_STAGE(PG8_SB(1, 1), cB + hstep + kstep, voffB);
        PG8_WAIT_V(6); PG8_BAR;
    }
    for (;;) {
        const bool has_next = S.next(ui + 1, nxt);
        const char* nA = has_next ? (const char*)g.A + (size_t)nxt.pm * tstep : cA; const char* nB = has_next ? (const char*)g.Bt + (size_t)nxt.pn * tstep : cB;
        for (int t = 0; t < nt; t += 2) {
            const bool last = (t == nt - 2);
            const char* a1 = cA + (size_t)(t + 1) * kstep;
            const char* a2 = last ? nA : cA + (size_t)(t + 2) * kstep; const char* b2 = last ? nB : cB + (size_t)(t + 2) * kstep;
            const char* a3 = a2 + kstep; const char* b3 = b2 + kstep;
            if (last && has_next) S.a_ready(nxt);
            if constexpr (SP2) {
            PG8_LDB(B0, 0, 0); PG8_LDB(B1, 0, 1); PG8_SCHED; PG8_LDA(At, 0, 0); PG8_STAGE(PG8_SA(1, 1), a1 + hstep, voffA);
            PG8_WAIT_V(8); PG8_WAIT_L(0); PG8_BAR; PG8_MMA(0, 0, At, B0); PG8_MMA(0, 1, At, B1); PG8_BAR; PG8_SCHED;
            PG8_LDA(At, 0, 1); PG8_STAGE(PG8_SB(0, 0), b2, voffB); PG8_STAGE(PG8_SB(0, 1), b2 + hstep, voffB); PG8_STAGE(PG8_SA(0, 0), a2, voffA);
            PG8_WAIT_V(8); PG8_WAIT_L(0); PG8_BAR; PG8_MMA(1, 0, At, B0); PG8_MMA(1, 1, At, B1); PG8_BAR; PG8_SCHED;
            PG8_LDB(B0, 1, 0); PG8_LDB(B1, 1, 1); PG8_SCHED; PG8_LDA(At, 1, 0); PG8_STAGE(PG8_SA(0, 1), a2 + hstep, voffA);
            PG8_WAIT_V(8); PG8_WAIT_L(0); PG8_BAR; PG8_MMA(0, 0, At, B0); PG8_MMA(0, 1, At, B1); PG8_BAR; PG8_SCHED;
            PG8_LDA(At, 1, 1); PG8_STAGE(PG8_SB(1, 0), b3, voffB); PG8_STAGE(PG8_SB(1, 1), b3 + hstep, voffB); PG8_STAGE(PG8_SA(1, 0), a3, voffA);
            PG8_WAIT_V(8); PG8_WAIT_L(0); PG8_BAR; PG8_MMA(1, 0, At, B0); PG8_MMA(1, 1, At, B1); PG8_BAR; PG8_SCHED;
            } else {
            PG8_LDB(B0, 0, 0); PG8_SCHED; PG8_LDA(At, 0, 0); PG8_STAGE(PG8_SA(1, 1), a1 + hstep, voffA);
            PG8_WAIT_L(8); PG8_BAR; PG8_WAIT_L(0); PG8_MMA(0, 0, At, B0); PG8_BAR; PG8_SCHED;
            PG8_LDB(B1, 0, 1); PG8_STAGE(PG8_SB(0, 0), b2, voffB);
            PG8_BAR; PG8_WAIT_L(0); PG8_MMA(0, 1, At, B1); PG8_BAR;
            PG8_LDA(At, 0, 1); PG8_STAGE(PG8_SA(0, 0), a2, voffA);
            PG8_BAR; PG8_WAIT_L(0); PG8_MMA(1, 0, At, B0); PG8_BAR; PG8_SCHED;
            PG8_STAGE(PG8_SB(0, 1), b2 + hstep, voffB);
            PG8_WAIT_V(6); PG8_BAR; PG8_MMA(1, 1, At, B1); PG8_BAR;
            PG8_LDB(B0, 1, 0); PG8_SCHED; PG8_LDA(At, 1, 0); PG8_STAGE(PG8_SA(0, 1), a2 + hstep, voffA);
            PG8_WAIT_L(8); PG8_BAR; PG8_WAIT_L(0); PG8_MMA(0, 0, At, B0); PG8_BAR; PG8_SCHED;
            PG8_LDB(B1, 1, 1); PG8_STAGE(PG8_SB(1, 0), b3, voffB);
            PG8_BAR; PG8_WAIT_L(0); PG8_MMA(0, 1, At, B1); PG8_BAR;
            PG8_LDA(At, 1, 1); PG8_STAGE(PG8_SA(1, 0), a3, voffA);
            PG8_BAR; PG8_WAIT_L(0); PG8_MMA(1, 0, At, B0); PG8_BAR; PG8_SCHED;
            PG8_STAGE(PG8_SB(1, 1), b3 + hstep, voffB);
            PG8_WAIT_V(6); PG8_BAR; PG8_MMA(1, 1, At, B1); PG8_BAR;
            }
        }
        if constexpr (ALIGN_EPI) { if (wr == 0) PG8_BAR; }
        if constexpr (!Epi::AFTER_DRAIN) { E(acc, cur, wr, wc, fr, fq); S.done(cur); }
        if (!has_next) break;
#pragma unroll
        for (int a = 0; a < 2; ++a)
#pragma unroll
            for (int b = 0; b < 2; ++b)
#pragma unroll
                for (int m = 0; m < 4; ++m)
#pragma unroll
                    for (int n = 0; n < 2; ++n) acc[a][b][m][n] = (f32x4){0.f, 0.f, 0.f, 0.f};
        cur = nxt; cA = nA; cB = nB; ++ui;
        if constexpr (ALIGN_EPI) { if (wr == 1) PG8_BAR; }
    }
    PG8_WAIT_V(0);
    if constexpr (!ALIGN_EPI) { if (wr == 0) PG8_BAR; }
    PG8_BAR;
    if constexpr (Epi::AFTER_DRAIN) { E.fused(acc, cur, wr, wc, fr, fq, lds, wid, lane); S.done(cur); }
#undef PG8_SA
#undef PG8_SB
#undef PG8_STAGE
#undef PG8_LDA
#undef PG8_LDB
#undef PG8_MMA
#undef PG8_WAIT_V
#undef PG8_WAIT_L
#undef PG8_BAR
#undef PG8_SCHED
}
}
#include <hip/hip_bf16.h>
#include <cmath>
namespace attn_body {
using bf16=__hip_bfloat16;
using bf16x8=__attribute__((ext_vector_type(8)))short;
using s16x4=__attribute__((ext_vector_type(4)))short;
using f32x16=__attribute__((ext_vector_type(16)))float;
using u32x4=__attribute__((ext_vector_type(4)))unsigned;
constexpr int BATCH=8,NHEAD=16,SEQ=4096,D=64,DM=NHEAD*D;
constexpr int NW=8,QBLK=32,QB=QBLK*NW,KVBLK=64,NQB=SEQ/QB;
constexpr int ATTN_PITCH=DM, ATTN_UNIT_ROWS=QB;
__device__ __forceinline__ int crow(int r,int hi){return (r&3)+8*(r>>2)+4*hi;}
#define SBAR() __builtin_amdgcn_sched_barrier(0)
__device__ __forceinline__ void cmask(f32x16&p0,f32x16&p1,int jb,int qrel,int hi){
  const float NEG=-INFINITY; int kb=64*jb+4*hi;
  #pragma unroll
  for(int r=0;r<16;++r){int kv=kb+(r&3)+8*(r>>2); if(kv>qrel)p0[r]=NEG; if(kv+32>qrel)p1[r]=NEG;}
}

constexpr int NSLOT=3, SLOTB=8192;
typedef float f32x4_t __attribute__((ext_vector_type(4)));
constexpr int LDS_K=0, LDS_V=NSLOT*SLOTB, LDS_WS=2*NSLOT*SLOTB, LDS_OST=LDS_WS+NW*64*4, LDS_NB=LDS_OST+NW*4096, LDS_BYTES=LDS_NB+SEQ*4;
constexpr float C2=0.125f*1.4426950408889634f;
__device__ __forceinline__ void glds16(const void*gsrc,unsigned lds_dst){unsigned keep;
  asm volatile("s_mov_b32 %0, m0\n\ts_mov_b32 m0, %2\n\ts_nop 0\n\tglobal_load_lds_dwordx4 %1, off\n\ts_mov_b32 m0, %0":"=&s"(keep):"v"(gsrc),"s"(lds_dst):"memory");}
__device__ __forceinline__ float max3f(float a,float b,float c){float r;asm("v_max3_f32 %0, %1, %2, %3":"=v"(r):"v"(a),"v"(b),"v"(c));return r;}
__device__ __forceinline__ float max2f(float a,float b){float r;asm("v_max_f32_e32 %0, %1, %2":"=v"(r):"v"(a),"v"(b));return r;}
__device__ __forceinline__ float fadd_s(float a,float b){float r;asm("v_add_f32_e32 %0, %1, %2":"=v"(r):"v"(a),"v"(b));return r;}
__device__ __forceinline__ float fsub_s(float a,float b){float r;asm("v_sub_f32_e32 %0, %1, %2":"=v"(r):"v"(a),"v"(b));return r;}
typedef float f32x2_t __attribute__((ext_vector_type(2))); typedef __bf16 bf16x2_t __attribute__((ext_vector_type(2)));
__device__ __forceinline__ unsigned cvtpk_s(float lo,float hi){f32x2_t v={lo,hi};bf16x2_t b=__builtin_convertvector(v,bf16x2_t);return __builtin_bit_cast(unsigned,b);}
#define WAIT_BAR(N) asm volatile("s_waitcnt vmcnt(" #N ") lgkmcnt(0)\n\ts_barrier":::"memory")

__device__ __forceinline__ void qkt(f32x16&p0,f32x16&p1,const char*Kslot,const bf16x8*qr,int r32,int hi){
  const char*kb=Kslot+hi*1024+r32*16;
  #pragma unroll
  for(int d0=0;d0<4;++d0){
    const bf16x8 b0=*reinterpret_cast<const bf16x8*>(kb+d0*2048);
    const bf16x8 b1=*reinterpret_cast<const bf16x8*>(kb+d0*2048+512);
    p0=__builtin_amdgcn_mfma_f32_32x32x16_bf16(b0,qr[d0],p0,0,0,0);p1=__builtin_amdgcn_mfma_f32_32x32x16_bf16(b1,qr[d0],p1,0,0,0);}
}
typedef __attribute__((address_space(3))) const char* lds_cptr;
typedef short v4i16_t __attribute__((ext_vector_type(4)));
__device__ __forceinline__ void kload8(bf16x8*kf,lds_cptr kp){
  kf[0]=*(const __attribute__((address_space(3))) bf16x8*)(kp);      kf[1]=*(const __attribute__((address_space(3))) bf16x8*)(kp+512);
  kf[2]=*(const __attribute__((address_space(3))) bf16x8*)(kp+2048); kf[3]=*(const __attribute__((address_space(3))) bf16x8*)(kp+2560);
  kf[4]=*(const __attribute__((address_space(3))) bf16x8*)(kp+4096); kf[5]=*(const __attribute__((address_space(3))) bf16x8*)(kp+4608);
  kf[6]=*(const __attribute__((address_space(3))) bf16x8*)(kp+6144); kf[7]=*(const __attribute__((address_space(3))) bf16x8*)(kp+6656);
}
__device__ __forceinline__ void kload2(bf16x8*kf,lds_cptr kp,int j){ kf[2*j]=*(const __attribute__((address_space(3))) bf16x8*)(kp+j*2048); kf[2*j+1]=*(const __attribute__((address_space(3))) bf16x8*)(kp+j*2048+512); }
__device__ __forceinline__ s16x4 vtr(lds_cptr p){ return __builtin_bit_cast(s16x4,__builtin_amdgcn_ds_read_tr16_b64_v4i16((__attribute__((address_space(3))) v4i16_t*)p)); }
__device__ __forceinline__ float rowmax(const f32x16&p0,const f32x16&p1){
  float a=max3f(p0[0],p0[1],p1[0]),b=max3f(p0[2],p0[3],p1[1]);a=max3f(a,p1[2],p1[3]);
  #pragma unroll
  for(int r=4;r<16;r+=4){a=max3f(a,p0[r],p0[r+1]);b=max3f(b,p0[r+2],p0[r+3]);a=max3f(a,p1[r],p1[r+1]);b=max3f(b,p1[r+2],p1[r+3]);}
  const float m=max2f(a,b);
  auto rr=__builtin_amdgcn_permlane32_swap(__float_as_uint(m),__float_as_uint(m),false,false);
  return max2f(__uint_as_float(rr[0]),__uint_as_float(rr[1]));
}
__device__ __forceinline__ void pv(f32x16*o,int vb,bf16x8 pa0,bf16x8 pa1,bf16x8 pa2,bf16x8 pa3){
  #pragma unroll
  for(int d0=0;d0<2;++d0){s16x4 lo[4],hi[4];
    #pragma unroll
    for(int ks=0;ks<4;++ks){
      asm volatile("ds_read_b64_tr_b16 %0,%1 offset:%c2":"=&v"(lo[ks]):"v"(vb),"i"(d0*4096+ks*1024):"memory");
      asm volatile("ds_read_b64_tr_b16 %0,%1 offset:%c2":"=&v"(hi[ks]):"v"(vb),"i"(d0*4096+ks*1024+512):"memory");}
    asm volatile("s_waitcnt lgkmcnt(0)":::"memory");SBAR();
    #define PK(k) (bf16x8){lo[k][0],lo[k][1],lo[k][2],lo[k][3],hi[k][0],hi[k][1],hi[k][2],hi[k][3]}
    o[d0]=__builtin_amdgcn_mfma_f32_32x32x16_bf16(pa0,PK(0),o[d0],0,0,0);
    o[d0]=__builtin_amdgcn_mfma_f32_32x32x16_bf16(pa1,PK(1),o[d0],0,0,0);
    o[d0]=__builtin_amdgcn_mfma_f32_32x32x16_bf16(pa2,PK(2),o[d0],0,0,0);
    o[d0]=__builtin_amdgcn_mfma_f32_32x32x16_bf16(pa3,PK(3),o[d0],0,0,0);
    #undef PK
  }
}

#ifndef ATTN_STORE16
#define ATTN_STORE16(p,v) (*(u32x4*)(p)=(v))
#endif
template<int THRL> __device__ __forceinline__ void attn_unit(int b,int h,int qb,const bf16*Q,const bf16*__restrict__ K,const bf16*__restrict__ V,bf16*O,char*shm,bool live){
  const __attribute__((address_space(3))) float* nbp=(const __attribute__((address_space(3))) float*)(lds_cptr)(shm+LDS_NB);
  #define BIASC(C0,C1,t) do{ const __attribute__((address_space(3))) float* bp_=nbp+(t)*64+4*hi; \
    _Pragma("unroll") for(int g_=0;g_<4;++g_){ const f32x4_t a_=*(const __attribute__((address_space(3))) f32x4_t*)(bp_+8*g_); const f32x4_t b_=*(const __attribute__((address_space(3))) f32x4_t*)(bp_+32+8*g_); \
      C0[4*g_]=a_[0]-mhat;C0[4*g_+1]=a_[1]-mhat;C0[4*g_+2]=a_[2]-mhat;C0[4*g_+3]=a_[3]-mhat; C1[4*g_]=b_[0]-mhat;C1[4*g_+1]=b_[1]-mhat;C1[4*g_+2]=b_[2]-mhat;C1[4*g_+3]=b_[3]-mhat; } }while(0)

  int tid_=threadIdx.x; asm volatile("":"+v"(tid_)); const int tid=tid_,lane=tid&63,r32=lane&31,hi=lane>>5; const int wid=__builtin_amdgcn_readfirstlane(tid>>6);
  const long rowbase=(long)b*SEQ; const int q0=qb*QB;
  const bf16*Qw=Q+(rowbase+q0+wid*QBLK)*DM+h*D;
  const bf16*Kh=K+rowbase*DM+h*D,*Vh=V+rowbase*DM+h*D;
  const unsigned lds0=(unsigned)(uintptr_t)shm;
  float*wsf=(float*)(shm+LDS_WS)+wid*64;
  const bf16*ksrc=Kh+(long)lane*DM+wid*8;
  const bf16*vsrc=Vh+(long)(16*(wid&3)+(lane>>2))*DM+(wid>>2)*32+(lane&3)*8;
  const unsigned kdst=lds0+LDS_K+wid*1024, vdst=lds0+LDS_V+wid*1024;
  #define DMA_K(t,slot) glds16(ksrc+(long)(t)*KVBLK*DM,(unsigned)__builtin_amdgcn_readfirstlane(kdst+(slot)))
  #define DMA_V(t,slot) glds16(vsrc+(long)(t)*KVBLK*DM,(unsigned)__builtin_amdgcn_readfirstlane(vdst+(slot)))
  const int vb0=(int)(lds0+LDS_V)+((lane>>4)&1)*32+(lane&3)*8+(4*hi+((lane&15)>>2))*64;
  const char*Kbase=shm+LDS_K; bf16x8 kf[8];
  const lds_cptr shm3=(lds_cptr)shm; const lds_cptr kp0=shm3+LDS_K+hi*1024+r32*16; const lds_cptr vp0=shm3+LDS_V+((lane>>4)&1)*32+(lane&3)*8+(4*hi+((lane&15)>>2))*64;
  const int NT=(q0+QB)/KVBLK;
  DMA_K(0,0);DMA_V(0,0);DMA_K(1,SLOTB);
  bf16x8 qr[4];
  #pragma unroll
  for(int d0=0;d0<4;++d0)qr[d0]=*reinterpret_cast<const bf16x8*>(&Qw[(long)r32*DM+d0*16+hi*8]);
  float mhat=0.f,l_reg=0.f;f32x16 o[2];o[0]=f32x16{};o[1]=f32x16{};
  const int qrel=wid*QBLK+r32;
  #define CMASK(P0,P1,t) do{int jb_=(t)-(NT-4); if(jb_>=0)cmask(P0,P1,jb_,qrel,hi);}while(0)
  bool resc=false;
  #define START(P0,P1) do{ const float rm=rowmax(P0,P1); resc=false; \
    { const float dl=rm; mhat=fadd_s(mhat,dl); \
      _Pragma("unroll") for(int r=0;r<16;++r){P0[r]=fsub_s(P0[r],dl);P1[r]=fsub_s(P1[r],dl);} \
      } \
    _Pragma("unroll") for(int r=0;r<16;++r)P0[r]=__builtin_amdgcn_exp2f(P0[r]); }while(0)
  #define RESC() do{ if(resc){ asm volatile("s_waitcnt lgkmcnt(0)":::"memory"); \
      _Pragma("unroll") for(int d_=0;d_<2;++d_) _Pragma("unroll") for(int r=0;r<16;++r)o[d_][r]*=wsf[crow(r,hi)]; } }while(0)
  f32x16 pA0,pA1,pB0,pB1;
  int sl_prev=0,sl_cur=0,sl_next=SLOTB;
  #define ROT() do{sl_prev=sl_cur;sl_cur=sl_next;sl_next=(sl_next==(NSLOT-1)*SLOTB)?0:sl_next+SLOTB;}while(0)
  DMA_K(2,2*SLOTB);
  WAIT_BAR(3);
  BIASC(pA0,pA1,0); qkt(pA0,pA1,Kbase,qr,r32,hi);asm volatile("s_nop 15\n\ts_nop 7":"+v"(pA0),"+v"(pA1));CMASK(pA0,pA1,0);
  START(pA0,pA1);
  _Pragma("unroll") for(int r=0;r<16;++r)pA1[r]=__builtin_amdgcn_exp2f(pA1[r]);
  BIASC(pB0,pB1,1);
  WAIT_BAR(0);
  DMA_K(3,0);DMA_V(1,SLOTB);
  ROT();
  kload8(kf,kp0+sl_cur);
  WAIT_BAR(2);
  s16x4 vlo[8],vhi[8]; u32x4 pw0,pw1,pw2,pw3;
  #define PKW(P,B) cvtpk_s(P[B],P[B+1])
  #define PAF(k) __builtin_bit_cast(bf16x8,pw##k)
  #define VFR(i) (bf16x8){vlo[i][0],vlo[i][1],vlo[i][2],vlo[i][3],vhi[i][0],vhi[i][1],vhi[i][2],vhi[i][3]}
  #define PIN(x) asm volatile("":"+v"(x))
  #define MX3(a,b,c) __builtin_fmaxf(__builtin_fmaxf((a),(b)),(c))
  #define GAPA(MF,A0,A1,A2,A3,W0,W1,PW) do{ MF; sacc+=A0; sacc+=A1; sacc+=A2; sacc+=A3; PIN(sacc); W0; W1; PIN(PW); SBAR(); }while(0)
  #define EX(v) __builtin_amdgcn_exp2f(v)
  #define GAPB(MF,X,B,Z) do{ MF; X[B]=EX(X[B]); X[B+1]=EX(X[B+1]); X[B+2]=EX(X[B+2]); X[B+3]=EX(X[B+3]); PIN(X); Z[B]-=mhat; Z[B+1]-=mhat; Z[B+2]-=mhat; Z[B+3]-=mhat; PIN(Z); SBAR(); }while(0)
  #define BIASLD(Z0,Z1,t) do{ const __attribute__((address_space(3))) float* bp_=nbp+(t)*64+4*hi; \
    _Pragma("unroll") for(int g_=0;g_<4;++g_){ const f32x4_t a_=*(const __attribute__((address_space(3))) f32x4_t*)(bp_+8*g_); const f32x4_t b_=*(const __attribute__((address_space(3))) f32x4_t*)(bp_+32+8*g_); \
      Z0[4*g_]=a_[0];Z0[4*g_+1]=a_[1];Z0[4*g_+2]=a_[2];Z0[4*g_+3]=a_[3]; Z1[4*g_]=b_[0];Z1[4*g_+1]=b_[1];Z1[4*g_+2]=b_[2];Z1[4*g_+3]=b_[3]; } }while(0)
  #define VRD(i) do{ vlo[i]=vtr(vp_+(((i)>>2)*4096+((i)&3)*1024)); vhi[i]=vtr(vp_+(((i)>>2)*4096+((i)&3)*1024+512)); }while(0)
  #define KRD(G,j) do{ if(G){ kload2(kf,kp0+sl_next,j); SBAR(); } }while(0)
  #define STEP(C0,C1,P0,P1,t,GK,GV,GL) do{ SBAR(); \
    const lds_cptr vp_=vp0+sl_prev; \
    VRD(0); SBAR(); float sacc=(P0[0]+P0[1]); \
    GAPA(C0=__builtin_amdgcn_mfma_f32_32x32x16_bf16(kf[0],qr[0],C0,0,0,0), P0[2],P0[3],P0[4],P0[5],     pw0[0]=PKW(P0,0), pw0[1]=PKW(P0,2), pw0); \
    VRD(4); SBAR(); GAPA(C1=__builtin_amdgcn_mfma_f32_32x32x16_bf16(kf[1],qr[0],C1,0,0,0), P0[6],P0[7],P0[8],P0[9],     pw0[2]=PKW(P0,4), pw0[3]=PKW(P0,6), pw0); \
    VRD(1); SBAR(); GAPA(C0=__builtin_amdgcn_mfma_f32_32x32x16_bf16(kf[2],qr[1],C0,0,0,0),   P0[10],P0[11],P0[12],P0[13], pw1[0]=PKW(P0,8), pw1[1]=PKW(P0,10), pw1); \
    VRD(5); SBAR(); GAPA(C1=__builtin_amdgcn_mfma_f32_32x32x16_bf16(kf[3],qr[1],C1,0,0,0),   P0[14],P0[15],P1[0],P1[1],   pw1[2]=PKW(P0,12),pw1[3]=PKW(P0,14), pw1); \
    VRD(2); SBAR(); GAPA(C0=__builtin_amdgcn_mfma_f32_32x32x16_bf16(kf[4],qr[2],C0,0,0,0),   P1[2],P1[3],P1[4],P1[5],     pw2[0]=PKW(P1,0), pw2[1]=PKW(P1,2), pw2); \
    VRD(6); SBAR(); GAPA(C1=__builtin_amdgcn_mfma_f32_32x32x16_bf16(kf[5],qr[2],C1,0,0,0),   P1[6],P1[7],P1[8],P1[9],     pw2[2]=PKW(P1,4), pw2[3]=PKW(P1,6), pw2); \
    VRD(3); SBAR(); GAPA(C0=__builtin_amdgcn_mfma_f32_32x32x16_bf16(kf[6],qr[3],C0,0,0,0),   P1[10],P1[11],P1[12],P1[13], pw3[0]=PKW(P1,8), pw3[1]=PKW(P1,10), pw3); \
    VRD(7); SBAR(); GAPA(C1=__builtin_amdgcn_mfma_f32_32x32x16_bf16(kf[7],qr[3],C1,0,0,0),   P1[14],P1[15],0.f,0.f,       pw3[2]=PKW(P1,12),pw3[3]=PKW(P1,14), pw3); \
    l_reg+=sacc; \
    if(GK){DMA_K((t)+3,sl_cur);} if(GV){DMA_V((t)+1,sl_next);} \
    CMASK(C0,C1,t); \
    { float a=MX3(C0[0],C0[1],C1[0]),b=MX3(C0[2],C0[3],C1[1]); a=MX3(a,C1[2],C1[3]); \
      _Pragma("unroll") for(int r=4;r<16;r+=4){a=MX3(a,C0[r],C0[r+1]);b=MX3(b,C0[r+2],C0[r+3]);a=MX3(a,C1[r],C1[r+1]);b=MX3(b,C1[r+2],C1[r+3]);} \
      float rm=__builtin_fmaxf(a,b); { auto rr=__builtin_amdgcn_permlane32_swap(__float_as_uint(rm),__float_as_uint(rm),false,false); rm=__builtin_fmaxf(__uint_as_float(rr[0]),__uint_as_float(rr[1])); } \
      resc=false; \
      if(__builtin_expect(__any(rm>(float)THRL),0)){ const float dl=__builtin_fmaxf(rm,0.f); mhat+=dl; \
        _Pragma("unroll") for(int r=0;r<16;++r){C0[r]-=dl;C1[r]-=dl;} \
        const float f=__builtin_amdgcn_exp2f(-dl); l_reg*=f; if(hi==0)wsf[r32]=f; resc=true; } } \
    SBAR(); BIASLD(P0,P1,(t)+1); SBAR(); \
    GAPB(o[0]=__builtin_amdgcn_mfma_f32_32x32x16_bf16(PAF(0),VFR(0),o[0],0,0,0), C0,0,P0); \
    GAPB(o[1]=__builtin_amdgcn_mfma_f32_32x32x16_bf16(PAF(0),VFR(4),o[1],0,0,0), C0,4,P0); \
    KRD(GL,0); GAPB(o[0]=__builtin_amdgcn_mfma_f32_32x32x16_bf16(PAF(1),VFR(1),o[0],0,0,0), C0,8,P0); \
    KRD(GL,1); GAPB(o[1]=__builtin_amdgcn_mfma_f32_32x32x16_bf16(PAF(1),VFR(5),o[1],0,0,0), C0,12,P0); \
    KRD(GL,2); GAPB(o[0]=__builtin_amdgcn_mfma_f32_32x32x16_bf16(PAF(2),VFR(2),o[0],0,0,0), C1,0,P1); \
    KRD(GL,3); GAPB(o[1]=__builtin_amdgcn_mfma_f32_32x32x16_bf16(PAF(2),VFR(6),o[1],0,0,0), C1,4,P1); \
    GAPB(o[0]=__builtin_amdgcn_mfma_f32_32x32x16_bf16(PAF(3),VFR(3),o[0],0,0,0), C1,8,P1); \
    GAPB(o[1]=__builtin_amdgcn_mfma_f32_32x32x16_bf16(PAF(3),VFR(7),o[1],0,0,0), C1,12,P1); \
    }while(0)
  int t=1;
  #undef CMASK
  #define CMASK(P0,P1,t) do{}while(0)
  for(;t+5<NT;t+=2){
    STEP(pB0,pB1,pA0,pA1,t,true,true,true);     WAIT_BAR(2); RESC(); ROT();
    STEP(pA0,pA1,pB0,pB1,t+1,true,true,true);   WAIT_BAR(2); RESC(); ROT();
  }
  #undef CMASK
  #define CMASK(P0,P1,t) do{int jb_=(t)-(NT-4); if(jb_>=0)cmask(P0,P1,jb_,qrel,hi);}while(0)
  #define ENDW(tt) do{ if((tt)+3<NT){WAIT_BAR(2);} else if((tt)+2<NT){WAIT_BAR(1);} else {WAIT_BAR(0);} }while(0)
  for(;t+1<NT;t+=2){
    STEP(pB0,pB1,pA0,pA1,t,(t+3<NT),(t+1<NT),(t+1<NT));       ENDW(t);   RESC(); ROT();
    STEP(pA0,pA1,pB0,pB1,t+1,(t+4<NT),(t+2<NT),(t+2<NT));     ENDW(t+1); RESC(); ROT();
  }
  STEP(pB0,pB1,pA0,pA1,NT-1,false,false,false); RESC();
  { float sacc=pB0[0]+pB0[1]; _Pragma("unroll") for(int r=2;r<16;++r)sacc+=pB0[r]; _Pragma("unroll") for(int r=0;r<16;++r)sacc+=pB1[r]; l_reg+=sacc;
    pw0=(u32x4){PKW(pB0,0),PKW(pB0,2),PKW(pB0,4),PKW(pB0,6)};pw1=(u32x4){PKW(pB0,8),PKW(pB0,10),PKW(pB0,12),PKW(pB0,14)};pw2=(u32x4){PKW(pB1,0),PKW(pB1,2),PKW(pB1,4),PKW(pB1,6)};pw3=(u32x4){PKW(pB1,8),PKW(pB1,10),PKW(pB1,12),PKW(pB1,14)};
    SBAR(); pv(o,vb0+sl_cur,PAF(0),PAF(1),PAF(2),PAF(3)); }
  #undef PKW
  #undef PAF
  #undef VFR
  #undef PIN
  #undef MX3
  #undef GAPA
  #undef GAPB
  #undef BIASLD
  #undef EX
  #undef VRD
  #undef KRD
  #undef STEP
  #undef ENDW
  {auto rr=__builtin_amdgcn_permlane32_swap(__float_as_uint(l_reg),__float_as_uint(l_reg),false,false);l_reg=__uint_as_float(rr[0])+__uint_as_float(rr[1]);}
  if(hi==0)wsf[32+r32]=l_reg;asm volatile("s_waitcnt lgkmcnt(0)":::"memory");
  float rli[16];
  #pragma unroll
  for(int r=0;r<16;++r)rli[r]=__builtin_amdgcn_rcpf(wsf[32+crow(r,hi)]);
  bf16*Ow=O+(rowbase+q0+wid*QBLK)*DM+h*D;
  { bf16*stg=(bf16*)(shm+LDS_OST)+wid*2048;
    #pragma unroll
    for(int r=0;r<16;++r){const int orow=crow(r,hi);
      #pragma unroll
      for(int d0=0;d0<2;++d0)stg[orow*64+d0*32+r32]=__float2bfloat16(o[d0][r]*rli[r]);}
    asm volatile("s_waitcnt lgkmcnt(0)":::"memory");
    #pragma unroll
    for(int i=0;i<4;++i){const int row=i*8+(lane>>3),ch=lane&7; const u32x4 v=*(const u32x4*)(stg+row*64+ch*8); if(live){ATTN_STORE16(Ow+(long)row*DM+ch*8,v);}} }
  asm volatile("s_waitcnt lgkmcnt(0)\n\ts_barrier":::"memory");
  #undef BIASC
  #undef DMA_K
  #undef DMA_V
  #undef CMASK
  #undef START
  #undef RESC
  #undef ROT
}
constexpr int ATTN_LDS_BYTES=LDS_BYTES;
struct AttnTensors { const bf16* Q; const bf16* K; const bf16* V; bf16* O; };
struct AttnUnit { int bh; int qb; };
struct StaticOrder {
  int vcu;
  __device__ __forceinline__ explicit StaticOrder(int grid,int block):vcu((block%8)*(grid/8)+block/8){}
  __device__ __forceinline__ bool next(int i,AttnUnit&u)const{ if(i>=8)return false; const int p=vcu&1; u.bh=vcu>>1; const int base=4*(i>>1); u.qb=(i&1)?base+3-p:base+p; return true; }
  __device__ __forceinline__ void a_ready(const AttnUnit&)const{}
  __device__ __forceinline__ void done(const AttnUnit&)const{}
};
template<class Sched,int THRL=8> __device__ __forceinline__ void attn_phase(char*lds,const AttnTensors&T,const Sched&S,bool live=true){
  AttnUnit u;
  for(int i=0;S.next(i,u);++i){ S.a_ready(u); attn_unit<THRL>(u.bh/NHEAD,u.bh%NHEAD,u.qb,T.Q,T.K,T.V,T.O,lds,live); S.done(u); }
}
#undef SBAR
#undef WAIT_BAR
}
#define XB_TMO      128
#define XB_XCNT(j)  (256  + 64 * (j))
#define XB_XSUB(j)  (1280 + 64 * (j))
#define XB_XGEN(j)  (2304 + 64 * (j))
#define XB_TOP      3328
#define XB_TOPGEN   3392
#define XCD_BAR_WORDS 3456
#define XB_SPIN_CAP (1u << 18)

__device__ __forceinline__ unsigned xb_ld(unsigned* p)              { return __hip_atomic_load(p, __ATOMIC_RELAXED, __HIP_MEMORY_SCOPE_AGENT); }
__device__ __forceinline__ unsigned xb_add(unsigned* p, unsigned v) { return __hip_atomic_fetch_add(p, v, __ATOMIC_RELAXED, __HIP_MEMORY_SCOPE_AGENT); }
__device__ __forceinline__ unsigned xb_xcc_id() { return (unsigned)__builtin_amdgcn_s_getreg((3 << 11) | 20) & 0xFu; }
#define XB_SPIN(cond, bar) do { unsigned _sp = 0; while (cond) { __builtin_amdgcn_s_sleep(1); \
    if ((++_sp & 255u) == 0u) { if (xb_ld(&(bar)[XB_TMO])) break; if (_sp > XB_SPIN_CAP) { atomicAdd(&(bar)[XB_TMO], 1u); break; } } } } while (0)

struct XcdBarrier {
    unsigned* bar; unsigned x;
    volatile LAS unsigned* st;
};

__device__ __forceinline__ XcdBarrier xcd_barrier_post(unsigned* bar, volatile LAS unsigned* st) {
    XcdBarrier b; b.bar = bar; b.x = xb_xcc_id(); b.st = st;
    if (threadIdx.x == 0) (void)xb_add(&bar[XB_XCNT(b.x)], 1u);
    return b;
}
__device__ __forceinline__ void xcd_barrier_complete(unsigned* bar, unsigned x, unsigned& nloc, unsigned& nx) {
    const unsigned G = gridDim.x * gridDim.y * gridDim.z;
    unsigned sum, cnt, mine, sp = 0u;
    for (;;) {
        sum = 0u; cnt = 0u; mine = 0u;
#pragma unroll
        for (unsigned j = 0; j < 16; ++j) { const unsigned c = xb_ld(&bar[XB_XCNT(j)]); sum += c; cnt += (c > 0u) ? 1u : 0u; mine = (j == x) ? c : mine; }
        if (sum == G) break;
        __builtin_amdgcn_s_sleep(1);
        if ((++sp & 255u) == 0u) { if (xb_ld(&bar[XB_TMO])) break; if (sp > XB_SPIN_CAP) { atomicAdd(&bar[XB_TMO], 1u); break; } }
    }
    nloc = mine > 0u ? mine : 1u; nx = cnt > 0u ? cnt : 1u;
}

__device__ __forceinline__ void xcd_barrier(const XcdBarrier& b) {
    asm volatile("s_waitcnt vmcnt(0)" ::: "memory");
    __syncthreads();
    if (threadIdx.x == 0) {
        unsigned* bar = b.bar;
        __builtin_amdgcn_s_waitcnt(0);
        unsigned nloc = b.st[0], nx = b.st[1];
        if (nloc == 0u) { xcd_barrier_complete(bar, b.x, nloc, nx); b.st[0] = nloc; b.st[1] = nx; }
        const unsigned old = xb_add(&bar[XB_XSUB(b.x)], 1u);
        const unsigned gen = old / nloc;
        if (old + 1u == (gen + 1u) * nloc) {
            __builtin_amdgcn_fence(__ATOMIC_RELEASE, "agent");
            asm volatile("s_waitcnt vmcnt(0)" ::: "memory");
            const unsigned og = xb_add(&bar[XB_TOP], 1u);
            const unsigned tg = og / nx;
            if (og + 1u == (tg + 1u) * nx) xb_add(&bar[XB_TOPGEN], 1u);
            else XB_SPIN(xb_ld(&bar[XB_TOPGEN]) == tg, bar);
            __builtin_amdgcn_fence(__ATOMIC_ACQUIRE, "agent");
            xb_add(&bar[XB_XGEN(b.x)], 1u);
            asm volatile("s_waitcnt vmcnt(0)" ::: "memory");
        } else {
            XB_SPIN(xb_ld(&bar[XB_XGEN(b.x)]) == gen, bar);
            __builtin_amdgcn_fence(__ATOMIC_ACQUIRE, "agent");
            asm volatile("s_waitcnt vmcnt(0)" ::: "memory");
        }
    }
    __syncthreads();
}
constexpr int BATCH = 8, SEQ = 4096, DM = 1024, T = BATCH * SEQ, DFF = 2816, DPLE = 256;
constexpr int NWAVES = 8;
typedef unsigned short bf16;
typedef unsigned v4u __attribute__((ext_vector_type(4)));
typedef unsigned v2u __attribute__((ext_vector_type(2)));
typedef float f32x4 __attribute__((ext_vector_type(4)));
typedef short bf16x8 __attribute__((ext_vector_type(8)));
typedef short v4i16 __attribute__((ext_vector_type(4)));
__device__ __forceinline__ unsigned f2bf(float f) { unsigned u = __builtin_bit_cast(unsigned, f); return (u + 0x7fffu + ((u >> 16) & 1u)) >> 16; }
__device__ __forceinline__ unsigned pk2(float lo, float hi) { return f2bf(lo) | (f2bf(hi) << 16); }

constexpr size_t MiB = 1u << 20;
constexpr size_t WS_SS = 456 * MiB;
constexpr size_t WS_HSS = 474 * MiB;
constexpr size_t WS_BAR = 1856 * 1024;
constexpr size_t WS_LOGF = 2 * MiB;
constexpr size_t WS_ROPE = 4 * MiB;
constexpr size_t WS_WFFI = 8 * MiB;
constexpr size_t WS_WFFO = 52 * MiB;
constexpr size_t WS_WRIN = 74 * MiB;
constexpr size_t WS_WRG = 82 * MiB;
constexpr size_t WS_WRO = 86 * MiB;
constexpr size_t WS_WFIN = 90 * MiB;
constexpr size_t WS_WFZ = 96 * MiB;
constexpr size_t WS_WFO = 97 * MiB;
constexpr size_t WS_WPG = 99 * MiB;
constexpr size_t WS_WPP = 103 * MiB;
constexpr size_t WS_HB = 104 * MiB;
constexpr size_t WS_PB = 168 * MiB;
constexpr size_t WS_POOL = 200 * MiB;
constexpr size_t WS_END = 482 * MiB;
constexpr int LDS_BYTES = 147456, RING_BYTES = 131072;

namespace ret {
constexpr int KP = 528, VP = 144, PPI = 144;
constexpr int L_K = 0, L_V = L_K + 2 * 64 * KP, L_P = L_V + 2 * 64 * VP, L_ST = L_P + 64 * PPI, L_END = L_ST + 64 * KP;
static_assert(L_END <= RING_BYTES, "retention LDS");
#define MFMA16(a, b, c) __builtin_amdgcn_mfma_f32_16x16x32_bf16((a), (b), (c), 0, 0, 0)
__device__ __forceinline__ bf16x8 trfrag(const LAS char* p, int pitch) {
    const v4i16 lo = __builtin_amdgcn_ds_read_tr16_b64_v4i16((LAS v4i16*)p), hi = __builtin_amdgcn_ds_read_tr16_b64_v4i16((LAS v4i16*)(p + 4 * pitch));
    return (bf16x8){lo[0], lo[1], lo[2], lo[3], hi[0], hi[1], hi[2], hi[3]};
}
__device__ __forceinline__ v2u pk4(const f32x4 v) { return (v2u){pg8::cvt_pk_bf16(v[0], v[1]), pg8::cvt_pk_bf16(v[2], v[3])}; }
__device__ __forceinline__ void ret_phase(LAS char* L, const bf16* Qt, const bf16* Kt, bf16* VO, float* hss, int vcu, bool live = true) {
    int tid_ = threadIdx.x; asm volatile("" : "+v"(tid_));
    const int tid = tid_, lane = tid & 63, w = __builtin_amdgcn_readfirstlane(tid >> 6), m16 = lane & 15, g = lane >> 4, q4 = m16 >> 2, p4 = lane & 3;
    const int ib = w >> 1, half = w & 1;
    const int bh = vcu >> 3, es = vcu & 7, b = bh >> 2, h = bh & 3;
    const float lg = log2f(1.0f - exp2f(-5.0f - (float)h)), gC = exp2f(64.0f * lg);
    const size_t tok0 = (size_t)b * SEQ;
    const bf16* kbase = Kt + tok0 * 1024 + h * 256 + (size_t)(tid >> 5) * 1024 + (tid & 31) * 8;
    const bf16* vbase = VO + tok0 * 2048 + h * 512 + es * 64 + (size_t)(tid >> 3) * 2048 + (tid & 7) * 8;
    const bf16* qbase = Qt + tok0 * 1024 + h * 256 + (size_t)(16 * ib + m16) * 1024 + 8 * g;
    for (int i = tid; i < 64 * KP / 16; i += 512) *(LAS v4u*)(L + L_ST + 16 * i) = (v4u){0u, 0u, 0u, 0u};
    f32x4 st[2][4];
#pragma unroll
    for (int a = 0; a < 2; ++a)
#pragma unroll
        for (int e = 0; e < 4; ++e) st[a][e] = (f32x4){0.f, 0.f, 0.f, 0.f};
    v4u kreg[4], vreg; bf16x8 qn[8];
#define RET_LOADKV(c) do { _Pragma("unroll") for (int u_ = 0; u_ < 4; ++u_) kreg[u_] = *(const v4u*)(kbase + (size_t)((c) * 64 + 16 * u_) * 1024); \
        vreg = *(const v4u*)(vbase + (size_t)(c) * 64 * 2048); } while (0)
#define RET_LOADQ(c) do { _Pragma("unroll") for (int s_ = 0; s_ < 8; ++s_) qn[s_] = *(const bf16x8*)(qbase + (size_t)(c) * 64 * 1024 + 32 * s_); } while (0)
#define RET_STAGE(bf) do { _Pragma("unroll") for (int u_ = 0; u_ < 4; ++u_) *(LAS v4u*)(L + L_K + (bf) * 64 * KP + ((tid >> 5) + 16 * u_) * KP + (tid & 31) * 16) = kreg[u_]; \
        *(LAS v4u*)(L + L_V + (bf) * 64 * VP + (tid >> 3) * VP + (tid & 7) * 16) = vreg; } while (0)
    v2u opk[2]; float osq = 0.f; opk[0] = (v2u){0u, 0u}; opk[1] = (v2u){0u, 0u};
#define RET_OSTORE(c) do { const size_t tok_ = tok0 + (size_t)(c) * 64 + 16 * ib + m16; if (live) { \
        *(v2u*)(VO + tok_ * 2048 + h * 512 + es * 64 + 16 * (2 * half) + 4 * g) = opk[0]; *(v2u*)(VO + tok_ * 2048 + h * 512 + es * 64 + 16 * (2 * half + 1) + 4 * g) = opk[1]; \
        if (g == 0) hss[(tok_ * 4 + h) * 16 + es * 2 + half] = osq; } } while (0)
    RET_LOADKV(0); RET_LOADQ(0);
    RET_STAGE(0);
    RET_LOADKV(1);
    const int troff_k = (8 * g + q4) * KP + 8 * p4, troff_v = (8 * g + q4) * VP + 8 * p4;
    for (int c = 0; c < 64; ++c) {
        const LAS char* LK = L + L_K + (c & 1) * 64 * KP; const LAS char* LV = L + L_V + (c & 1) * 64 * VP;
        bf16x8 qf[8];
#pragma unroll
        for (int s = 0; s < 8; ++s) qf[s] = qn[s];
        __syncthreads();
        if (c + 1 < 64) { RET_STAGE((c + 1) & 1); RET_LOADQ(c + 1); if (c + 2 < 64) RET_LOADKV(c + 2); }
        if (c > 0) RET_OSTORE(c - 1);
        bf16x8 fr0[8], fr1[8];
#pragma unroll
        for (int s = 0; s < 8; ++s) { fr0[s] = *(const LAS bf16x8*)(LK + (16 * (2 * half) + m16) * KP + (32 * s + 8 * g) * 2); fr1[s] = *(const LAS bf16x8*)(LK + (16 * (2 * half + 1) + m16) * KP + (32 * s + 8 * g) * 2); }
        __builtin_amdgcn_sched_barrier(0);
        f32x4 sab[2]; sab[0] = (f32x4){0.f, 0.f, 0.f, 0.f}; sab[1] = (f32x4){0.f, 0.f, 0.f, 0.f};
#pragma unroll
        for (int s = 0; s < 8; ++s) { sab[0] = MFMA16(fr0[s], qf[s], sab[0]); sab[1] = MFMA16(fr1[s], qf[s], sab[1]); }
#pragma unroll
        for (int s = 0; s < 8; ++s) { fr0[s] = *(const LAS bf16x8*)(L + L_ST + (16 * (2 * half) + m16) * KP + (32 * s + 8 * g) * 2); fr1[s] = *(const LAS bf16x8*)(L + L_ST + (16 * (2 * half + 1) + m16) * KP + (32 * s + 8 * g) * 2); }
        __builtin_amdgcn_sched_barrier(0);
#pragma unroll
        for (int jj = 0; jj < 2; ++jj) { const int jb = 2 * half + jj; const f32x4 sa = sab[jj];
            const int il = 16 * ib + m16, j0 = 16 * jb + 4 * g;
            const f32x4 sm = (f32x4){(j0 + 0 <= il) ? sa[0] : 0.f, (j0 + 1 <= il) ? sa[1] : 0.f, (j0 + 2 <= il) ? sa[2] : 0.f, (j0 + 3 <= il) ? sa[3] : 0.f};
            *(LAS v2u*)(L + L_P + il * PPI + j0 * 2) = pk4(sm); }
        f32x4 oa[2]; oa[0] = (f32x4){0.f, 0.f, 0.f, 0.f}; oa[1] = (f32x4){0.f, 0.f, 0.f, 0.f};
#pragma unroll
        for (int s = 0; s < 8; ++s) { oa[0] = MFMA16(fr0[s], qf[s], oa[0]); oa[1] = MFMA16(fr1[s], qf[s], oa[1]); }
        __syncthreads();
        bf16x8 vt[2][4];
#pragma unroll
        for (int ks = 0; ks < 2; ++ks)
#pragma unroll
            for (int eb = 0; eb < 4; ++eb) vt[ks][eb] = trfrag(LV + (32 * ks) * VP + (16 * eb) * 2 + troff_v, VP);
#pragma unroll
        for (int ks = 0; ks < 2; ++ks) { const bf16x8 pf = *(const LAS bf16x8*)(L + L_P + (16 * ib + m16) * PPI + (32 * ks + 8 * g) * 2);
            if (half == 0) { oa[0] = MFMA16(vt[ks][0], pf, oa[0]); oa[1] = MFMA16(vt[ks][1], pf, oa[1]); }
            else           { oa[0] = MFMA16(vt[ks][2], pf, oa[0]); oa[1] = MFMA16(vt[ks][3], pf, oa[1]); } }
        { float sq = 0.f;
#pragma unroll
            for (int ee = 0; ee < 2; ++ee) { const f32x4 o = oa[ee]; sq += (o[0] * o[0] + o[1] * o[1]) + (o[2] * o[2] + o[3] * o[3]); opk[ee] = pk4(o); }
            sq += __shfl_xor(sq, 16); sq += __shfl_xor(sq, 32); osq = sq; }
#pragma unroll
        for (int ks = 0; ks < 2; ++ks)
#pragma unroll
            for (int dd = 0; dd < 2; ++dd) { const bf16x8 kt = trfrag(LK + (32 * ks) * KP + (16 * (2 * w + dd)) * 2 + troff_k, KP);
#pragma unroll
                for (int eb = 0; eb < 4; ++eb) st[dd][eb] = MFMA16(kt, vt[ks][eb], st[dd][eb]); }
#pragma unroll
        for (int dd = 0; dd < 2; ++dd)
#pragma unroll
            for (int eb = 0; eb < 4; ++eb) { st[dd][eb] = st[dd][eb] * gC;
                *(LAS v2u*)(L + L_ST + (16 * eb + m16) * KP + (16 * (2 * w + dd) + 4 * g) * 2) = pk4(st[dd][eb]); }
    }
    RET_OSTORE(63);
    __syncthreads();
#undef RET_OSTORE
#undef RET_LOADKV
#undef RET_LOADQ
#undef RET_STAGE
}
}

struct Args { const float* in[14]; float* out; unsigned char* ws; };
struct Frame { LAS unsigned char* lds; int tid, lane, wave, vcu, G; };

__device__ __forceinline__ float wave_sum(float v) {
#pragma unroll
    for (int o = 1; o < 64; o <<= 1) v += __shfl_xor(v, o);
    return v;
}
__device__ __forceinline__ void prep_item(const float* W, int K, int Nsrc, bf16* WT, int rows, int mode, int coloff, const float* ks, LAS float* scr, int item, int lane) {
    const int nblk = rows / 32, kb = item / nblk, nb = item % nblk, k0 = 64 * kb, n0 = 32 * nb;
    const int src0 = mode ? (((n0 >> 7) & 1) * DFF + 128 * (n0 >> 8) + (n0 & 127)) : (coloff + n0);
    float wv[32];
#pragma unroll
    for (int i = 0; i < 32; ++i) { const int kk = 2 * i + (lane >> 5); wv[i] = __builtin_nontemporal_load(W + (size_t)(k0 + kk) * Nsrc + src0 + (lane & 31)); }
#pragma unroll
    for (int i = 0; i < 32; ++i) { const int kk = 2 * i + (lane >> 5); scr[kk * 33 + (lane & 31)] = wv[i]; }
    asm volatile("s_waitcnt lgkmcnt(0)" ::: "memory");
    const int c = lane & 7;
    float sc[8];
#pragma unroll
    for (int x = 0; x < 8; ++x) sc[x] = ks ? ks[k0 + 8 * c + x] : 1.0f;
#pragma unroll
    for (int j = 0; j < 4; ++j) { const int n = (lane >> 3) + 8 * j; const LAS float* s = scr + (8 * c) * 33 + n;
        v4u o; o.x = pk2(s[0 * 33] * sc[0], s[1 * 33] * sc[1]); o.y = pk2(s[2 * 33] * sc[2], s[3 * 33] * sc[3]); o.z = pk2(s[4 * 33] * sc[4], s[5 * 33] * sc[5]); o.w = pk2(s[6 * 33] * sc[6], s[7 * 33] * sc[7]);
        *(v4u*)(WT + (size_t)(n0 + n) * K + k0 + 8 * c) = o; }
    asm volatile("s_waitcnt lgkmcnt(0)" ::: "memory");
}
#define PREP(Wp, K_, Nsrc_, WTp, rows_, mode_, coloff_, ksp) do { const int nit_ = ((K_) / 64) * ((rows_) / 32); \
    for (int it_ = gw; it_ < nit_; it_ += NGW) prep_item((Wp), (K_), (Nsrc_), (WTp), (rows_), (mode_), (coloff_), (ksp), scr, it_, F.lane); } while (0)

typedef const volatile __attribute__((address_space(4))) unsigned long long* kargp_t;
#define KARG(i) ((unsigned long long)(*((kargp_t)__builtin_amdgcn_kernarg_segment_ptr() + (i))))
#define KIN(i) ((const float*)(const GAS float*)KARG(i))
#define KOUT ((float*)(GAS float*)KARG(14))
#define KWS ((unsigned char*)(GAS unsigned char*)KARG(15))
#define SEAM() do { XcdBarrier b_; b_.bar = (unsigned*)(KWS + WS_BAR); b_.x = xb_xcc_id(); b_.st = (volatile LAS unsigned*)(F.lds + RING_BYTES) + 8; xcd_barrier(b_); } while (0)
#define GEMM_PHASE(EpiT, Aop, Bop, N_, K_, Eobj) do { pg8::Gemm g_{(const pg8::bf16_t*)(Aop), (const pg8::bf16_t*)(Bop), T, (N_), (K_)}; pg8::StaticOrder S_; S_.init(T, (N_), F.G, (int)blockIdx.x); \
        pg8::gemm_phase<EpiT, pg8::StaticOrder, true, true>(F.lds, g_, S_, (Eobj)); } while (0)

__device__ __forceinline__ void p0_prologue(const Frame& F) {
    unsigned char* ws = KWS;
    const float* norm_w = KIN(2);
    float* SS = (float*)(ws + WS_SS); float* HSS = (float*)(ws + WS_HSS);
    const int gw = F.vcu * NWAVES + F.wave, NGW = F.G * NWAVES, gtid = gw * 64 + F.lane, NGT = NGW * 64;
    LAS float* scr = (LAS float*)(F.lds + F.wave * 16384);
    { float* ROPE = (float*)(ws + WS_ROPE);
      for (int i = gtid; i < 4096 * 128; i += NGT) { const int pos = i >> 7, j = i & 127;
        const float inv = exp2f(-(float)j * (13.287712379549449f / 128.0f)); const float ang = (float)pos * inv;
        double tr = (double)ang * 0.15915494309189535; tr -= rint(tr); const float tf = (float)tr;
        ROPE[2 * i] = __builtin_amdgcn_cosf(tf); ROPE[2 * i + 1] = __builtin_amdgcn_sinf(tf); } }
    { const float* x = KIN(0); bf16* HB = (bf16*)(ws + WS_HB);
      for (int m = gw; m < T / 2; m += NGW) {
        f32x4 v[2][4];
#pragma unroll
        for (int rr = 0; rr < 2; ++rr)
#pragma unroll
            for (int j = 0; j < 4; ++j) v[rr][j] = __builtin_nontemporal_load((const f32x4*)(x + (size_t)(m + rr * (T / 2)) * DM) + F.lane + 64 * j);
#pragma unroll
        for (int rr = 0; rr < 2; ++rr) { float s = 0.f; unsigned long long* o8 = (unsigned long long*)(HB + (size_t)(m + rr * (T / 2)) * DM) + F.lane;
#pragma unroll
            for (int j = 0; j < 4; ++j) { const f32x4 q = v[rr][j]; s += (q.x * q.x + q.y * q.y) + (q.z * q.z + q.w * q.w); o8[64 * j] = (unsigned long long)pk2(q.x, q.y) | ((unsigned long long)pk2(q.z, q.w) << 32); }
            s = wave_sum(s); if (F.lane < 16) SS[(size_t)(m + rr * (T / 2)) * 16 + F.lane] = F.lane == 0 ? s : 0.f; } } }
    { const float* pin = KIN(1); bf16* PB = (bf16*)(ws + WS_PB);
      for (int i = gtid; i < 2 * T * DPLE / 16; i += NGT) { f32x4 v[4];
#pragma unroll
        for (int j = 0; j < 4; ++j) v[j] = __builtin_nontemporal_load((const f32x4*)pin + (size_t)j * (2 * T * DPLE / 16) + i);
#pragma unroll
        for (int j = 0; j < 4; ++j) ((unsigned long long*)PB)[(size_t)j * (2 * T * DPLE / 16) + i] = (unsigned long long)pk2(v[j].x, v[j].y) | ((unsigned long long)pk2(v[j].z, v[j].w) << 32); } }
    { const float* fox_w_in = KIN(8); bf16* WFZ = (bf16*)(ws + WS_WFZ);
      for (int i = gtid; i < 16 * 1024; i += NGT) { const int n = i >> 10, k = i & 1023; WFZ[i] = (bf16)f2bf(fox_w_in[(size_t)k * 3088 + 3072 + n] * norm_w[(4 + 1) * DM + k]); } }
#pragma unroll 1
    for (int fi = 0; fi < 4; ++fi) { const int li = fi >> 1, f = fi & 1;
        PREP(KIN(3) + (size_t)fi * DM * 2 * DFF, DM, 2 * DFF, (bf16*)(ws + WS_WFFI) + (size_t)fi * 2 * DFF * DM, 2 * DFF, 1, 0, norm_w + (li * 4 + (f ? 2 : 0)) * DM);
        PREP(KIN(4) + (size_t)fi * DFF * DM, DFF, DM, (bf16*)(ws + WS_WFFO) + (size_t)fi * DM * DFF, DM, 0, 0, (const float*)nullptr); }
    PREP(KIN(5), DM, 6144, (bf16*)(ws + WS_WRIN), 4096, 0, 0, norm_w + 1 * DM);
    PREP(KIN(5), DM, 6144, (bf16*)(ws + WS_WRG), 2048, 0, 4096, norm_w + 1 * DM);
    PREP(KIN(7), 2048, DM, (bf16*)(ws + WS_WRO), DM, 0, 0, (const float*)nullptr);
    PREP(KIN(8), DM, 3088, (bf16*)(ws + WS_WFIN), 3072, 0, 0, norm_w + (4 + 1) * DM);
    PREP(KIN(10), DM, DM, (bf16*)(ws + WS_WFO), DM, 0, 0, (const float*)nullptr);
#pragma unroll 1
    for (int li = 0; li < 2; ++li) {
        PREP(KIN(12) + (size_t)li * DM * DM, DM, DM, (bf16*)(ws + WS_WPG) + (size_t)li * DM * DM, DM, 0, 0, norm_w + (li * 4 + 3) * DM);
        PREP(KIN(11) + (size_t)li * DPLE * DM, DPLE, DM, (bf16*)(ws + WS_WPP) + (size_t)li * DM * DPLE, DM, 0, 0, (const float*)nullptr); }
}

template <int LI> __device__ __forceinline__ bf16* resid() { return LI ? (bf16*)KOUT : (bf16*)(KWS + WS_HB); }
template <int FI, int SITE, bool WITH_PP> __device__ __forceinline__ void ffn_half(const Frame& F, cg::grid_group& grid) {
#ifdef PROBE_FFI
    { unsigned char* ws = KWS; pg8::EpiSwiglu E{(pg8::bf16_t*)(ws + WS_POOL), (const float*)(ws + WS_SS) + (size_t)SITE * T * 16};
      GEMM_PHASE(pg8::EpiSwiglu, resid<(FI >> 1)>(), (bf16*)(ws + WS_WFFI) + (size_t)FI * 2 * DFF * DM, 2 * DFF, DM, E); }
    SEAM();
#endif
    { unsigned char* ws = KWS; pg8::EpiSwiglu E{(pg8::bf16_t*)(ws + WS_POOL), (const float*)(ws + WS_SS) + (size_t)SITE * T * 16};
      GEMM_PHASE(pg8::EpiSwiglu, resid<(FI >> 1)>(), (bf16*)(ws + WS_WFFI) + (size_t)FI * 2 * DFF * DM, 2 * DFF, DM, E); }
    SEAM();
    { unsigned char* ws = KWS; bf16* R = resid<(FI >> 1)>(); pg8::EpiRes E{(const pg8::bf16_t*)R, (pg8::bf16_t*)R, (float*)(ws + WS_SS) + (size_t)(SITE + 1) * T * 16, 0.5f};
      GEMM_PHASE(pg8::EpiRes, ws + WS_POOL, (bf16*)(ws + WS_WFFO) + (size_t)FI * DM * DFF, DM, DFF, E); }
    if (WITH_PP) { unsigned char* ws = KWS; constexpr int LI = FI >> 1; pg8::EpiPlain E{(pg8::bf16_t*)(ws + WS_POOL + 176 * MiB), DM, (const float*)nullptr, 0, 0, 1.0f};
      GEMM_PHASE(pg8::EpiPlain, (bf16*)(ws + WS_PB) + (size_t)LI * T * DPLE, (bf16*)(ws + WS_WPP) + (size_t)LI * DM * DPLE, DM, DPLE, E); }
    SEAM();
}
template <int LI> __device__ __forceinline__ void ple_phase(const Frame& F, cg::grid_group& grid) {
    { unsigned char* ws = KWS; float* SS = (float*)(ws + WS_SS); bf16* R = resid<LI>();
      pg8::EpiPle<LI == 1> E{(const pg8::bf16_t*)R, (pg8::bf16_t*)KOUT, (float*)(ws + WS_POOL), SS + (size_t)(4 * LI + 4) * T * 16, SS + (size_t)(4 * LI + 3) * T * 16, (const pg8::bf16_t*)(ws + WS_POOL + 176 * MiB)};
      GEMM_PHASE(pg8::EpiPle<LI == 1>, R, (bf16*)(ws + WS_WPG) + (size_t)LI * DM * DM, DM, DM, E); }
    SEAM();
}
__device__ __forceinline__ void retention_mixer(const Frame& F, cg::grid_group& grid) {
    { unsigned char* ws = KWS; pg8::EpiRetIn E{(pg8::bf16_t*)(ws + WS_POOL), (pg8::bf16_t*)(ws + WS_POOL + 64 * MiB), (pg8::bf16_t*)(ws + WS_POOL + 128 * MiB), (const float*)(ws + WS_SS) + (size_t)T * 16, (const float*)(ws + WS_ROPE)};
      GEMM_PHASE(pg8::EpiRetIn, ws + WS_HB, ws + WS_WRIN, 4096, DM, E); }
    SEAM();
#ifdef PROBE_RET
    { unsigned char* ws = KWS; ret::ret_phase((LAS char*)F.lds, (const bf16*)(ws + WS_POOL), (const bf16*)(ws + WS_POOL + 64 * MiB), (bf16*)(ws + WS_POOL + 128 * MiB), (float*)(ws + WS_HSS), F.vcu, KARG(15) == 1ull); }
    SEAM();
#endif
    { unsigned char* ws = KWS; ret::ret_phase((LAS char*)F.lds, (const bf16*)(ws + WS_POOL), (const bf16*)(ws + WS_POOL + 64 * MiB), (bf16*)(ws + WS_POOL + 128 * MiB), (float*)(ws + WS_HSS), F.vcu); }
    SEAM();
    { unsigned char* ws = KWS; pg8::EpiRetGate E{(pg8::bf16_t*)(ws + WS_POOL + 128 * MiB), (const float*)(ws + WS_SS) + (size_t)T * 16, (const float*)(ws + WS_HSS), KIN(6)};
      GEMM_PHASE(pg8::EpiRetGate, ws + WS_HB, ws + WS_WRG, 2048, DM, E); }
    SEAM();
    { unsigned char* ws = KWS; pg8::EpiRes E{(const pg8::bf16_t*)(ws + WS_HB), (pg8::bf16_t*)(ws + WS_HB), (float*)(ws + WS_SS) + 2 * (size_t)T * 16, 1.0f};
      GEMM_PHASE(pg8::EpiRes, ws + WS_POOL + 128 * MiB, ws + WS_WRO, DM, 2048, E); }
    SEAM();
}
__device__ __forceinline__ void fox_mixer(const Frame& F, cg::grid_group& grid, unsigned char* lds_generic) {
    { unsigned char* ws = KWS; pg8::EpiPlain E{(pg8::bf16_t*)(ws + WS_POOL), DM, (const float*)(ws + WS_SS) + 5 * (size_t)T * 16, DM, (size_t)(64 * MiB / 2), attn_body::C2};
      GEMM_PHASE(pg8::EpiPlain, KOUT, ws + WS_WFIN, 3072, DM, E); }
    { unsigned char* ws = KWS; const bf16* HB = (const bf16*)KOUT; const bf16* WFZ = (const bf16*)(ws + WS_WFZ); float* LOGF = (float*)(ws + WS_LOGF); const float* ssm = (const float*)(ws + WS_SS) + 5 * (size_t)T * 16; const float* fox_b_f = KIN(9);
      const int gw = F.vcu * NWAVES + F.wave, NGW = F.G * NWAVES;
      for (int task = gw; task < T / 16; task += NGW) {
        const int m16 = F.lane & 15, g = F.lane >> 4; f32x4 a4 = (f32x4){0.f, 0.f, 0.f, 0.f};
        const bf16* ar = HB + (size_t)(16 * task + m16) * DM + 8 * g; const bf16* br = WFZ + (size_t)m16 * DM + 8 * g;
#pragma unroll 8
        for (int s = 0; s < 32; ++s) a4 = __builtin_amdgcn_mfma_f32_16x16x32_bf16(*(const bf16x8*)(ar + 32 * s), *(const bf16x8*)(br + 32 * s), a4, 0, 0, 0);
        const float bfh = fox_b_f[m16];
#pragma unroll
        for (int r = 0; r < 4; ++r) { const int t = 16 * task + 4 * g + r; const float z = a4[r] * pg8::rinv_of(ssm, t) + bfh;
            LOGF[(size_t)t * 16 + m16] = fminf(z, 0.f) - log1pf(__expf(-fabsf(z))); } } }
    SEAM();
    {
        unsigned char* ws = KWS; const float* LOGF = (const float*)(ws + WS_LOGF);
        const int bh = F.vcu >> 1, b = bh >> 4, h = bh & 15; LAS float* nb = (LAS float*)(F.lds + attn_body::LDS_NB); LAS float* wtot = (LAS float*)(F.lds + attn_body::LDS_WS);
        float v[8]; float run = 0.f;
#pragma unroll
        for (int q = 0; q < 8; ++q) { run += LOGF[((size_t)b * SEQ + 8 * F.tid + q) * 16 + h]; v[q] = run; }
        float incl = run;
#pragma unroll
        for (int o = 1; o < 64; o <<= 1) { const float y = __shfl_up(incl, o); if (F.lane >= o) incl += y; }
        if (F.lane == 63) wtot[F.wave] = incl;
        __syncthreads();
        float off = incl - run;
        for (int w2 = 0; w2 < F.wave; ++w2) off += wtot[w2];
#pragma unroll
        for (int q = 0; q < 8; ++q) nb[8 * F.tid + q] = -(off + v[q]) * 1.4426950408889634f;
        __syncthreads();
        const attn_body::bf16* FQ = (const attn_body::bf16*)(ws + WS_POOL);
        const attn_body::AttnTensors AT{FQ, FQ + (size_t)T * DM, FQ + (size_t)2 * T * DM, (attn_body::bf16*)FQ};
        const attn_body::StaticOrder S((int)F.G, (int)blockIdx.x);
#ifdef PROBE_ATTN
        attn_body::attn_phase<attn_body::StaticOrder>((char*)lds_generic, AT, S, KARG(15) == 1ull);
#endif
        attn_body::attn_phase<attn_body::StaticOrder, 64>((char*)lds_generic, AT, S);
    }
    SEAM();
    { unsigned char* ws = KWS; bf16* R = (bf16*)KOUT; pg8::EpiRes E{(const pg8::bf16_t*)R, (pg8::bf16_t*)R, (float*)(ws + WS_SS) + 6 * (size_t)T * 16, 1.0f};
      GEMM_PHASE(pg8::EpiRes, ws + WS_POOL, ws + WS_WFO, DM, DM, E); }
    SEAM();
}

__global__ void __launch_bounds__(NWAVES * 64, 2) hybrid_fwd(Args args) {
    extern __shared__ __attribute__((aligned(16))) unsigned char lds[];
    cg::grid_group grid = cg::this_grid();
    Frame F; F.lds = (LAS unsigned char*)lds; F.tid = threadIdx.x; F.lane = F.tid & 63; F.wave = __builtin_amdgcn_readfirstlane(F.tid >> 6);
    F.G = gridDim.x; { const int bx = blockIdx.x; F.vcu = (F.G % 8 == 0) ? (bx % 8) * (F.G / 8) + bx / 8 : bx; }
    if (F.tid < 64) ((LAS unsigned*)(F.lds + RING_BYTES))[F.tid] = 0u;
    __syncthreads();
    (void)xcd_barrier_post((unsigned*)(KWS + WS_BAR), (volatile LAS unsigned*)(F.lds + RING_BYTES) + 8);
    p0_prologue(F);
    grid.sync();
#ifdef PROBE_P0
    p0_prologue(F);
    SEAM();
#endif
    ffn_half<0, 0, false>(F, grid);
    retention_mixer(F, grid);
    ffn_half<1, 2, true>(F, grid);
    ple_phase<0>(F, grid);
    ffn_half<2, 4, false>(F, grid);
    fox_mixer(F, grid, lds);
    ffn_half<3, 6, true>(F, grid);
    ple_phase<1>(F, grid);
#ifdef PROBE_SYNC
#pragma unroll 1
    for (int i_ = 0; i_ < PROBE_SYNC; ++i_) grid.sync();
#endif
    { float* hres = KOUT; const float* hfin = (const float*)(KWS + WS_POOL); const float* final_norm_w = KIN(13); const int gw = F.vcu * NWAVES + F.wave, NGW = F.G * NWAVES;
      for (int m = gw; m < T; m += NGW) {
        const f32x4* xi = (const f32x4*)(hfin + (size_t)m * DM) + F.lane; f32x4* xr = (f32x4*)(hres + (size_t)m * DM) + F.lane; const f32x4* wr = (const f32x4*)final_norm_w + F.lane; f32x4 v[4]; float s = 0.f;
#pragma unroll
        for (int j = 0; j < 4; ++j) { v[j] = xi[64 * j]; s += (v[j].x * v[j].x + v[j].y * v[j].y) + (v[j].z * v[j].z + v[j].w * v[j].w); }
        const float ri = 1.0f / sqrtf(wave_sum(s) * (1.0f / DM) + 1e-6f);
#pragma unroll
        for (int j = 0; j < 4; ++j) xr[64 * j] = v[j] * ri * wr[64 * j];
      } }
}

extern "C" void kernel_launch(void* const* d_in, const int* in_sizes, int n_in, void* d_out, int out_size, void* d_ws, size_t ws_size, hipStream_t stream) {
    static int grid = 0;
    if (grid == 0) {
        if (n_in != 14 || out_size != T * DM || ws_size < WS_END) { fprintf(stderr, "kernel_launch: unexpected shapes (n_in %d out %d ws %zu)\n", n_in, out_size, ws_size); grid = -1; return; }
        int dev = 0, cus = 0, per_cu = 0;
        if (hipGetDevice(&dev) != hipSuccess || hipDeviceGetAttribute(&cus, hipDeviceAttributeMultiprocessorCount, dev) != hipSuccess) { grid = -1; return; }
        if (hipFuncSetAttribute((const void*)hybrid_fwd, hipFuncAttributeMaxDynamicSharedMemorySize, LDS_BYTES) != hipSuccess) { fprintf(stderr, "kernel_launch: hipFuncSetAttribute failed\n"); grid = -1; return; }
        if (hipOccupancyMaxActiveBlocksPerMultiprocessor(&per_cu, (const void*)hybrid_fwd, NWAVES * 64, LDS_BYTES) != hipSuccess || per_cu < 1) { fprintf(stderr, "kernel_launch: occupancy query says %d\n", per_cu); per_cu = 1; }
        (void)hipGetLastError();
        grid = cus * 1;
    }
    if (grid < 0) return;
    if (hipMemsetAsync((char*)d_ws + WS_BAR, 0, 16384, stream) != hipSuccess) { fprintf(stderr, "kernel_launch: memset failed\n"); return; }
    Args a{};
    for (int i = 0; i < 14; ++i) a.in[i] = (const float*)d_in[i];
    a.out = (float*)d_out; a.ws = (unsigned char*)d_ws;
    void* kargs[] = {&a};
    hipError_t e = hipLaunchCooperativeKernel((const void*)hybrid_fwd, dim3(grid), dim3(NWAVES * 64), kargs, LDS_BYTES, stream);
    if (e != hipSuccess) fprintf(stderr, "cooperative launch failed: %s (grid %d)\n", hipGetErrorString(e), grid);
}
```

```cpp
#include <hip/hip_runtime.h>
#include <hip/hip_cooperative_groups.h>
#include <cstdio>
#include <cstdint>
namespace cg = cooperative_groups;
#define GAS __attribute__((address_space(1)))
#define LAS __attribute__((address_space(3)))
namespace pg8 {
#define PG8_LAS __attribute__((address_space(3)))
typedef unsigned short bf16_t;
typedef short bf16x8 __attribute__((ext_vector_type(8)));
typedef float f32x4 __attribute__((ext_vector_type(4)));
typedef unsigned u32x4 __attribute__((ext_vector_type(4)));
constexpr int BM = 256, BK = 64, HALF = 128, HTB = HALF * BK * 2  , STAGE_BYTES = 8 * HTB, NXCD = 8, WGM = 8;

__host__ __device__ __forceinline__ int lds_byte(int r, int c) { const int st = (r >> 4) * 2 + (c >> 5), rr = r & 15, cc = c & 31, ob = rr * 64 + cc * 2; return st * 1024 + (ob ^ (((ob >> 9) & 1) << 5)); }
__host__ __device__ __forceinline__ void stage_rc(int b, int& R, int& C) { const int st = b / 1024, sb = b % 1024, swz = sb ^ (((sb >> 9) & 1) << 5); R = (st >> 1) * 16 + swz / 64; C = (st & 1) * 32 + (swz % 64) / 2; }
__host__ __device__ __forceinline__ int perm32(int rho) { const int n = rho >> 4, i = rho & 15; return 8 * (i >> 2) + 4 * n + (i & 3); }

struct Unit { int pm, pn; };
struct Gemm { const bf16_t* A; const bf16_t* Bt; int M, N, K; };

struct StaticOrder {
    int nM, nN, nwg, G, c;
    __host__ __device__ void init(int M, int N, int G_, int c_) { nM = M / BM; nN = N / BM; nwg = nM * nN; G = G_; c = c_; }
    __host__ __device__ bool next(int i, Unit& u) const {
        const long L = (long)i * G + c; if (L >= nwg) return false;
        int wgid = (int)L; { const int q = nwg / NXCD, r = nwg % NXCD, xcd = wgid % NXCD, off = wgid / NXCD; wgid = (xcd < r ? xcd * (q + 1) : r * (q + 1) + (xcd - r) * q) + off; }
        const int nig = WGM * nN, gid = wgid / nig, fm = gid * WGM, gsz = (nM - fm) < WGM ? (nM - fm) : WGM;
        u.pm = fm + ((wgid % nig) % gsz); u.pn = (wgid % nig) / gsz; return true;
    }
    __device__ __forceinline__ void a_ready(const Unit&) const {}
    __device__ __forceinline__ void done(const Unit&) const {}
};
typedef float f32x2_t __attribute__((ext_vector_type(2))); typedef __bf16 bf16x2_t __attribute__((ext_vector_type(2)));
__device__ __forceinline__ unsigned cvt_pk_bf16(float lo, float hi) { const f32x2_t v = {lo, hi}; const bf16x2_t b = __builtin_convertvector(v, bf16x2_t); return __builtin_bit_cast(unsigned, b); }
__device__ __forceinline__ u32x4 pack8(const f32x4 v0, const f32x4 v1) { u32x4 w; w.x = cvt_pk_bf16(v0[0], v0[1]); w.y = cvt_pk_bf16(v0[2], v0[3]); w.z = cvt_pk_bf16(v1[0], v1[1]); w.w = cvt_pk_bf16(v1[2], v1[3]); return w; }
__device__ __forceinline__ float bflo(unsigned u) { return __uint_as_float(u << 16); }
__device__ __forceinline__ float bfhi(unsigned u) { return __uint_as_float(u & 0xffff0000u); }
__device__ __forceinline__ void unpack8(const u32x4 w, f32x4& v0, f32x4& v1) { v0 = (f32x4){bflo(w.x), bfhi(w.x), bflo(w.y), bfhi(w.y)}; v1 = (f32x4){bflo(w.z), bfhi(w.z), bflo(w.w), bfhi(w.w)}; }
__device__ __forceinline__ float sigm(float x) { return __builtin_amdgcn_rcpf(1.0f + __builtin_amdgcn_exp2f(-1.4426950408889634f * x)); }
__device__ __forceinline__ f32x4 silu4(const f32x4 x) { return (f32x4){x[0] * sigm(x[0]), x[1] * sigm(x[1]), x[2] * sigm(x[2]), x[3] * sigm(x[3])}; }
__device__ __forceinline__ f32x4 sigm4(const f32x4 x) { return (f32x4){sigm(x[0]), sigm(x[1]), sigm(x[2]), sigm(x[3])}; }
__device__ __forceinline__ float sum4v(const f32x4 a) { return (a[0] + a[1]) + (a[2] + a[3]); }
__device__ __forceinline__ float sum16(const float* p) { const f32x4* q = (const f32x4*)p; const f32x4 a = q[0], b = q[1], c = q[2], d = q[3]; return (sum4v(a) + sum4v(b)) + (sum4v(c) + sum4v(d)); }
__device__ __forceinline__ float rinv_of(const float* ss, int r) { return __builtin_amdgcn_rsqf(sum4v(*(const f32x4*)(ss + (size_t)r * 4)) * (1.0f / 1024.0f) + 1e-6f); }
#define EPI_ARGS const f32x4 (&acc)[2][2][4][2], const Unit& u, int wr, int wc, int fr, int fq
#define EPI_ROWS(ai, m) (u.pm * BM + (ai) * HALF + wr * 64 + (m) * 16 + fr)
#define EPI_RINV8(ri, ss) float ri[2][4]; { f32x4 p_[2][4]; _Pragma("unroll") for (int ai = 0; ai < 2; ++ai) _Pragma("unroll") for (int m = 0; m < 4; ++m) p_[ai][m] = *(const f32x4*)((ss) + (size_t)EPI_ROWS(ai, m) * 4); \
    _Pragma("unroll") for (int ai = 0; ai < 2; ++ai) _Pragma("unroll") for (int m = 0; m < 4; ++m) ri[ai][m] = __builtin_amdgcn_rsqf(sum4v(p_[ai][m]) * (1.0f / 1024.0f) + 1e-6f); }
__device__ __forceinline__ void tile_sumsq(const float (&sqv)[2][4], const Unit& u, int wr, int wc, int fr, int fq, PG8_LAS float* xs, float* ssn) {
#pragma unroll
    for (int ai = 0; ai < 2; ++ai)
#pragma unroll
        for (int m = 0; m < 4; ++m) if (fq == 0) xs[(ai * HALF + wr * 64 + m * 16 + fr) * 4 + wc] = sqv[ai][m];
    asm volatile("s_waitcnt lgkmcnt(0)" ::: "memory"); __builtin_amdgcn_s_barrier(); asm volatile("" ::: "memory");
    const int tid = (wr * 4 + wc) * 64 + fq * 16 + fr;
    if (tid < BM) { const f32x4 p = *(const PG8_LAS f32x4*)(xs + tid * 4); ssn[(size_t)(u.pm * BM + tid) * 4 + u.pn] = sum4v(p); }
}
__device__ __forceinline__ float xsum_fq(float x) { auto a = __builtin_amdgcn_permlane16_swap(__float_as_uint(x), __float_as_uint(x), false, false); x = __uint_as_float(a[0]) + __uint_as_float(a[1]);
    auto b = __builtin_amdgcn_permlane32_swap(__float_as_uint(x), __float_as_uint(x), false, false); return __uint_as_float(b[0]) + __uint_as_float(b[1]); }
#define SQ8(v0, v1) ((v0[0] * v0[0] + v0[1] * v0[1]) + (v0[2] * v0[2] + v0[3] * v0[3]) + (v1[0] * v1[0] + v1[1] * v1[1]) + (v1[2] * v1[2] + v1[3] * v1[3]))

struct EpiSwiglu { static constexpr bool PERM = true, AFTER_DRAIN = false; bf16_t* act; const float* ss;
    __device__ __forceinline__ void operator()(EPI_ARGS) const {
        const int col0 = u.pn * HALF + wc * 32 + 8 * fq;
        EPI_RINV8(ri, ss)
#pragma unroll
        for (int ai = 0; ai < 2; ++ai)
#pragma unroll
            for (int m = 0; m < 4; ++m) { const int r = EPI_ROWS(ai, m); const float rv = ri[ai][m];
                const f32x4 a0 = silu4(acc[ai][0][m][0] * rv) * (acc[ai][1][m][0] * rv), a1 = silu4(acc[ai][0][m][1] * rv) * (acc[ai][1][m][1] * rv);
                *(u32x4*)(act + (size_t)r * 2816 + col0) = pack8(a0, a1); }
    }
};
struct EpiRes { static constexpr bool PERM = true, AFTER_DRAIN = false; const bf16_t* rin; bf16_t* rout; float* ssn; float scale; PG8_LAS float* xs;
    __device__ __forceinline__ void operator()(EPI_ARGS) const {
        float sqv[2][4];
#pragma unroll
        for (int ai = 0; ai < 2; ++ai)
#pragma unroll
          for (int mh = 0; mh < 4; mh += 2) { u32x4 hv[4][2];
#pragma unroll
            for (int m = mh; m < mh + 2; ++m)
#pragma unroll
                for (int bj = 0; bj < 2; ++bj) hv[m][bj] = *(const u32x4*)(rin + (size_t)EPI_ROWS(ai, m) * 1024 + u.pn * BM + bj * HALF + wc * 32 + 8 * fq);
#pragma unroll
            for (int m = mh; m < mh + 2; ++m) { float sq = 0.f;
#pragma unroll
                for (int bj = 0; bj < 2; ++bj) { const size_t off = (size_t)EPI_ROWS(ai, m) * 1024 + u.pn * BM + bj * HALF + wc * 32 + 8 * fq;
                    f32x4 h0, h1; unpack8(hv[m][bj], h0, h1);
                    const f32x4 v0 = h0 + acc[ai][bj][m][0] * scale, v1 = h1 + acc[ai][bj][m][1] * scale;
                    *(u32x4*)(rout + off) = pack8(v0, v1); sq += SQ8(v0, v1); }
                sq = xsum_fq(sq); sqv[ai][m] = sq; }
            asm volatile("" ::: "memory"); }
        tile_sumsq(sqv, u, wr, wc, fr, fq, xs, ssn);
    }
};
template <bool F32OUT> struct EpiPle { static constexpr bool PERM = true, AFTER_DRAIN = false; const bf16_t* rin; bf16_t* rout; float* fout; float* ssn; const float* ss; const bf16_t* pp; PG8_LAS float* xs;
    __device__ __forceinline__ void operator()(EPI_ARGS) const {
        float sqv[2][4];
#pragma unroll
        for (int ai = 0; ai < 2; ++ai) { float ri4[4]; { f32x4 p_[4];
#pragma unroll
            for (int m = 0; m < 4; ++m) p_[m] = *(const f32x4*)(ss + (size_t)EPI_ROWS(ai, m) * 4);
#pragma unroll
            for (int m = 0; m < 4; ++m) ri4[m] = __builtin_amdgcn_rsqf(sum4v(p_[m]) * (1.0f / 1024.0f) + 1e-6f); }
#pragma unroll
          for (int mh = 0; mh < 4; mh += 2) { u32x4 hv[4][2], pv[4][2];
#pragma unroll
            for (int m = mh; m < mh + 2; ++m)
#pragma unroll
                for (int bj = 0; bj < 2; ++bj) { const size_t off = (size_t)EPI_ROWS(ai, m) * 1024 + u.pn * BM + bj * HALF + wc * 32 + 8 * fq; hv[m][bj] = *(const u32x4*)(rin + off); pv[m][bj] = *(const u32x4*)(pp + off); }
#pragma unroll
            for (int m = mh; m < mh + 2; ++m) { float sq = 0.f; const float rv = ri4[m];
#pragma unroll
                for (int bj = 0; bj < 2; ++bj) { const size_t off = (size_t)EPI_ROWS(ai, m) * 1024 + u.pn * BM + bj * HALF + wc * 32 + 8 * fq;
                    f32x4 p0, p1, h0, h1; unpack8(pv[m][bj], p0, p1); unpack8(hv[m][bj], h0, h1);
                    const f32x4 v0 = h0 + sigm4(acc[ai][bj][m][0] * rv) * p0, v1 = h1 + sigm4(acc[ai][bj][m][1] * rv) * p1;
                    if (F32OUT) { *(f32x4*)(fout + off) = v0; *(f32x4*)(fout + off + 4) = v1; }
                    else { *(u32x4*)(rout + off) = pack8(v0, v1); sq += SQ8(v0, v1); } }
                sq = xsum_fq(sq); sqv[ai][m] = sq; }
            asm volatile("" ::: "memory"); } }
        if (!F32OUT) tile_sumsq(sqv, u, wr, wc, fr, fq, xs, ssn);
    }
};
template <bool HAS_SS> struct EpiPlain { static constexpr bool PERM = true, AFTER_DRAIN = false; bf16_t* O; int ldc; const float* ss; int split_cols; size_t split_stride; float scale0;
    __device__ __forceinline__ void operator()(EPI_ARGS) const {
        int colt = u.pn * BM; bf16_t* base = O; float sc = 1.f;
        if (split_cols) { const int t = colt / split_cols; base += (size_t)t * split_stride; colt -= t * split_cols; if (t == 0) sc = scale0; }
        const int col0 = colt + wc * 32 + 8 * fq;
        float ri[2][4];
        if (HAS_SS) { EPI_RINV8(rq, ss)
#pragma unroll
            for (int ai = 0; ai < 2; ++ai)
#pragma unroll
                for (int m = 0; m < 4; ++m) ri[ai][m] = rq[ai][m] * sc; }
        else {
#pragma unroll
            for (int ai = 0; ai < 2; ++ai)
#pragma unroll
                for (int m = 0; m < 4; ++m) ri[ai][m] = sc; }
#pragma unroll
        for (int ai = 0; ai < 2; ++ai)
#pragma unroll
            for (int m = 0; m < 4; ++m) { const int r = EPI_ROWS(ai, m); const float rv = ri[ai][m];
#pragma unroll
                for (int bj = 0; bj < 2; ++bj) *(u32x4*)(base + (size_t)r * ldc + col0 + bj * HALF) = pack8(acc[ai][bj][m][0] * rv, acc[ai][bj][m][1] * rv); }
    }
};
struct EpiRetIn { static constexpr bool PERM = true, AFTER_DRAIN = false; bf16_t* Qt; bf16_t* Kt; bf16_t* V; const float* ss; const float* rope  ;
    __device__ __forceinline__ void operator()(EPI_ARGS) const {
        const int pn = u.pn;
        EPI_RINV8(ri, ss)
        if (pn >= 8) {
            const int col0 = (pn - 8) * BM + wc * 32 + 8 * fq;
#pragma unroll
            for (int ai = 0; ai < 2; ++ai)
#pragma unroll
                for (int m = 0; m < 4; ++m) { const int r = EPI_ROWS(ai, m); const float rv = ri[ai][m];
#pragma unroll
                    for (int bj = 0; bj < 2; ++bj) *(u32x4*)(V + (size_t)r * 2048 + col0 + bj * HALF) = pack8(acc[ai][bj][m][0] * rv, acc[ai][bj][m][1] * rv); }
            return;
        }
        const bool isk = pn >= 4; const int hd = pn & 3; bf16_t* outp = isk ? Kt : Qt;
        const float lg = __builtin_amdgcn_logf(1.0f - __builtin_amdgcn_exp2f(-5.0f - (float)hd));
        const int j0 = wc * 32 + 8 * fq;
#pragma unroll
        for (int ai = 0; ai < 2; ++ai)
#pragma unroll
          for (int mh = 0; mh < 4; mh += 2) { f32x4 cs[4][4];
#pragma unroll
            for (int m = mh; m < mh + 2; ++m) { const f32x4* cp = (const f32x4*)(rope + ((size_t)(EPI_ROWS(ai, m) & 4095) * 128 + j0) * 2);
#pragma unroll
                for (int q = 0; q < 4; ++q) cs[m][q] = cp[q]; }
#pragma unroll
            for (int m = mh; m < mh + 2; ++m) { const int r = EPI_ROWS(ai, m); const int pos = r & 4095; const float e1 = (float)((pos & 63) + 1) * lg;
                const float f = ri[ai][m] * (isk ? 0.0625f * __builtin_amdgcn_exp2f(-e1) : __builtin_amdgcn_exp2f(e1));
                const f32x4 c01 = cs[m][0], c23 = cs[m][1], c45 = cs[m][2], c67 = cs[m][3];
                const f32x4 x10 = acc[ai][0][m][0] * f, x11 = acc[ai][0][m][1] * f, x20 = acc[ai][1][m][0] * f, x21 = acc[ai][1][m][1] * f;
                const f32x4 cc0 = (f32x4){c01[0], c01[2], c23[0], c23[2]}, sn0 = (f32x4){c01[1], c01[3], c23[1], c23[3]};
                const f32x4 cc1 = (f32x4){c45[0], c45[2], c67[0], c67[2]}, sn1 = (f32x4){c45[1], c45[3], c67[1], c67[3]};
                const f32x4 y10 = x10 * cc0 - x20 * sn0, y11 = x11 * cc1 - x21 * sn1, y20 = x10 * sn0 + x20 * cc0, y21 = x11 * sn1 + x21 * cc1;
                bf16_t* rowp = outp + (size_t)r * 1024 + hd * 256 + j0;
                *(u32x4*)(rowp) = pack8(y10, y11); *(u32x4*)(rowp + HALF) = pack8(y20, y21); }
            asm volatile("" ::: "memory"); }
    }
};
struct EpiRetGate { static constexpr bool PERM = true, AFTER_DRAIN = false; bf16_t* Y; const float* ss; const float* hss; const float* gnw;
    __device__ __forceinline__ void operator()(EPI_ARGS) const {
        const int hd = u.pn >> 1;
        EPI_RINV8(ri, ss)
        float hr[2][4];
#pragma unroll
        for (int ai = 0; ai < 2; ++ai)
#pragma unroll
          for (int mh = 0; mh < 4; mh += 2) { f32x4 hp[4][4];
#pragma unroll
            for (int m = mh; m < mh + 2; ++m)
#pragma unroll
                for (int q = 0; q < 4; ++q) hp[m][q] = *(const f32x4*)(hss + ((size_t)EPI_ROWS(ai, m) * 4 + hd) * 16 + 4 * q);
#pragma unroll
            for (int m = mh; m < mh + 2; ++m) hr[ai][m] = __builtin_amdgcn_rsqf(((sum4v(hp[m][0]) + sum4v(hp[m][1])) + (sum4v(hp[m][2]) + sum4v(hp[m][3]))) * (1.0f / 512.0f) + 1e-6f); }
        f32x4 gw[2][2];
#pragma unroll
        for (int bj = 0; bj < 2; ++bj) { const int c = u.pn * BM + bj * HALF + wc * 32 + 8 * fq; gw[bj][0] = *(const f32x4*)(gnw + c); gw[bj][1] = *(const f32x4*)(gnw + c + 4); }
#pragma unroll
        for (int ai = 0; ai < 2; ++ai)
#pragma unroll
          for (int mh = 0; mh < 4; mh += 2) { u32x4 ov[4][2];
#pragma unroll
            for (int m = mh; m < mh + 2; ++m)
#pragma unroll
                for (int bj = 0; bj < 2; ++bj) ov[m][bj] = *(const u32x4*)(Y + (size_t)EPI_ROWS(ai, m) * 2048 + u.pn * BM + bj * HALF + wc * 32 + 8 * fq);
#pragma unroll
            for (int m = mh; m < mh + 2; ++m) { const float rv = ri[ai][m], hv = hr[ai][m];
#pragma unroll
                for (int bj = 0; bj < 2; ++bj) { bf16_t* p = Y + (size_t)EPI_ROWS(ai, m) * 2048 + u.pn * BM + bj * HALF + wc * 32 + 8 * fq;
                    f32x4 o0, o1; unpack8(ov[m][bj], o0, o1);
                    *(u32x4*)p = pack8(silu4(acc[ai][bj][m][0] * rv) * o0 * (gw[bj][0] * hv), silu4(acc[ai][bj][m][1] * rv) * o1 * (gw[bj][1] * hv)); } }
            asm volatile("" ::: "memory"); }
    }
};
template <class Epi, class Sched, bool ALIGN_EPI = false, bool SP2 = false>
__device__ __forceinline__ void gemm_phase(PG8_LAS unsigned char* lds, const Gemm g, const Sched& S, const Epi& E) {
    int tid_ = threadIdx.x; asm volatile("" : "+v"(tid_));
    const int tid = tid_, wid = __builtin_amdgcn_readfirstlane(tid >> 6), lane = tid & 63, wr = wid >> 2, wc = wid & 3, fr = lane & 15, fq = lane >> 4;
    const int K = g.K, nt = K / BK;
    unsigned voffA[2], voffB[2];
#pragma unroll
    for (int i = 0; i < 2; ++i) { int R, C; stage_rc(tid * 16 + i * 8192, R, C); const int Rb = Epi::PERM ? ((R & ~31) + perm32(R & 31)) : R;
        voffA[i] = (unsigned)(R * K + C) * 2u; voffB[i] = (unsigned)(Rb * K + C) * 2u; }
    const size_t kstep = (size_t)(BK * 2);
    const size_t hstep = (size_t)HALF * K * 2;
    const size_t tstep = 2 * hstep;
    const unsigned ldsw = (unsigned)wid * 1024u;
    const int aoff = lds_byte(wr * 64 + fr, fq * 8), boff = lds_byte(wc * 32 + fr, fq * 8);
#define PG8_SA(b, h) (((b) * 2 + (h)) * HTB)
#define PG8_SB(b, h) ((4 + (b) * 2 + (h)) * HTB)
#define PG8_STAGE(bufoff, gbase, voff) do { _Pragma("unroll") for (int _i = 0; _i < 2; ++_i) \
        __builtin_amdgcn_global_load_lds((const unsigned*)((const char*)(gbase) + (voff)[_i]), (PG8_LAS unsigned*)(lds + (bufoff) + ldsw + _i * 8192), 16, 0, 0); } while (0)
#define PG8_LDA(dst, b, h) do { _Pragma("unroll") for (int m = 0; m < 4; ++m) _Pragma("unroll") for (int k = 0; k < 2; ++k) dst[m][k] = *(const PG8_LAS bf16x8*)(lds + PG8_SA(b, h) + aoff + m * 2048 + k * 1024); } while (0)
#define PG8_LDB(dst, b, h) do { _Pragma("unroll") for (int n = 0; n < 2; ++n) _Pragma("unroll") for (int k = 0; k < 2; ++k) dst[n][k] = *(const PG8_LAS bf16x8*)(lds + PG8_SB(b, h) + boff + n * 2048 + k * 1024); } while (0)
#define PG8_MMA(ai, bj, At, Bt) do { __builtin_amdgcn_s_setprio(1); _Pragma("unroll") for (int m = 0; m < 4; ++m) _Pragma("unroll") for (int n = 0; n < 2; ++n) _Pragma("unroll") for (int k = 0; k < 2; ++k) \
        acc[ai][bj][m][n] = __builtin_amdgcn_mfma_f32_16x16x32_bf16(Bt[n][k], At[m][k], acc[ai][bj][m][n], 0, 0, 0); __builtin_amdgcn_s_setprio(0); } while (0)
#define PG8_WAIT_V(n) asm volatile("s_waitcnt vmcnt(" #n ")" ::: "memory")
#define PG8_WAIT_L(n) asm volatile("s_waitcnt lgkmcnt(" #n ")" ::: "memory")
#define PG8_BAR __builtin_amdgcn_s_barrier()
#define PG8_SCHED __builtin_amdgcn_sched_barrier(0)
    Unit cur, nxt; int ui = 0;
    if (!S.next(0, cur)) return;
    f32x4 acc[2][2][4][2];
#pragma unroll
    for (int a = 0; a < 2; ++a)
#pragma unroll
        for (int b = 0; b < 2; ++b)
#pragma unroll
            for (int m = 0; m < 4; ++m)
#pragma unroll
                for (int n = 0; n < 2; ++n) acc[a][b][m][n] = (f32x4){0.f, 0.f, 0.f, 0.f};
    bf16x8 At[4][2], B0[2][2], B1[2][2];
    const char* cA = (const char*)g.A + (size_t)cur.pm * tstep; const char* cB = (const char*)g.Bt + (size_t)cur.pn * tstep;
    S.a_ready(cur);
    if constexpr (SP2) {
        PG8_STAGE(PG8_SB(0, 0), cB, voffB); PG8_STAGE(PG8_SB(0, 1), cB + hstep, voffB); PG8_STAGE(PG8_SA(0, 0), cA, voffA); PG8_STAGE(PG8_SA(0, 1), cA + hstep, voffA);
        if (wr == 1) PG8_BAR;
        PG8_WAIT_V(2); PG8_BAR;
        PG8_STAGE(PG8_SB(1, 0), cB + kstep, voffB); PG8_STAGE(PG8_SA(1, 0), cA + kstep, voffA); PG8_STAGE(PG8_SB(1, 1), cB + hstep + kstep, voffB);
        PG8_WAIT_V(6); PG8_BAR;
    } else {
        PG8_STAGE(PG8_SB(0, 0), cB, voffB); PG8_STAGE(PG8_SA(0, 0), cA, voffA); PG8_STAGE(PG8_SB(0, 1), cB + hstep, voffB); PG8_STAGE(PG8_SA(0, 1), cA + hstep, voffA);
        if (wr == 1) PG8_BAR;
        PG8_WAIT_V(4); PG8_BAR;
        PG8_STAGE(PG8_SB(1, 0), cB + kstep, voffB); PG8_STAGE(PG8_SA(1, 0), cA + kstep, voffA); PG8_STAGE(PG8_SB(1, 1), cB + hstep + kstep, voffB);
        PG8_WAIT_V(6); PG8_BAR;
    }
    for (;;) {
        const bool has_next = S.next(ui + 1, nxt);
        const char* nA = has_next ? (const char*)g.A + (size_t)nxt.pm * tstep : cA; const char* nB = has_next ? (const char*)g.Bt + (size_t)nxt.pn * tstep : cB;
        for (int t = 0; t < nt; t += 2) {
            const bool last = (t == nt - 2);
            const char* a1 = cA + (size_t)(t + 1) * kstep;
            const char* a2 = last ? nA : cA + (size_t)(t + 2) * kstep; const char* b2 = last ? nB : cB + (size_t)(t + 2) * kstep;
            const char* a3 = a2 + kstep; const char* b3 = b2 + kstep;
            if (last && has_next) S.a_ready(nxt);
            if constexpr (SP2) {
            PG8_LDB(B0, 0, 0); PG8_LDB(B1, 0, 1); PG8_SCHED; PG8_LDA(At, 0, 0); PG8_STAGE(PG8_SA(1, 1), a1 + hstep, voffA);
            PG8_WAIT_V(8); PG8_WAIT_L(0); PG8_BAR; PG8_MMA(0, 0, At, B0); PG8_MMA(0, 1, At, B1); PG8_BAR; PG8_SCHED;
            PG8_LDA(At, 0, 1); PG8_STAGE(PG8_SB(0, 0), b2, voffB); PG8_STAGE(PG8_SB(0, 1), b2 + hstep, voffB); PG8_STAGE(PG8_SA(0, 0), a2, voffA);
            PG8_WAIT_V(8); PG8_WAIT_L(0); PG8_BAR; PG8_MMA(1, 0, At, B0); PG8_MMA(1, 1, At, B1); PG8_BAR; PG8_SCHED;
            PG8_LDB(B0, 1, 0); PG8_LDB(B1, 1, 1); PG8_SCHED; PG8_LDA(At, 1, 0); PG8_STAGE(PG8_SA(0, 1), a2 + hstep, voffA);
            PG8_WAIT_V(8); PG8_WAIT_L(0); PG8_BAR; PG8_MMA(0, 0, At, B0); PG8_MMA(0, 1, At, B1); PG8_BAR; PG8_SCHED;
            PG8_LDA(At, 1, 1); PG8_STAGE(PG8_SB(1, 0), b3, voffB); PG8_STAGE(PG8_SB(1, 1), b3 + hstep, voffB); PG8_STAGE(PG8_SA(1, 0), a3, voffA);
            PG8_WAIT_V(8); PG8_WAIT_L(0); PG8_BAR; PG8_MMA(1, 0, At, B0); PG8_MMA(1, 1, At, B1); PG8_BAR; PG8_SCHED;
            } else {
            PG8_LDB(B0, 0, 0); PG8_SCHED; PG8_LDA(At, 0, 0); PG8_STAGE(PG8_SA(1, 1), a1 + hstep, voffA);
            PG8_WAIT_L(8); PG8_BAR; PG8_WAIT_L(0); PG8_MMA(0, 0, At, B0); PG8_BAR; PG8_SCHED;
            PG8_LDB(B1, 0, 1); PG8_STAGE(PG8_SB(0, 0), b2, voffB);
            PG8_BAR; PG8_WAIT_L(0); PG8_MMA(0, 1, At, B1); PG8_BAR;
            PG8_LDA(At, 0, 1); PG8_STAGE(PG8_SA(0, 0), a2, voffA);
            PG8_BAR; PG8_WAIT_L(0); PG8_MMA(1, 0, At, B0); PG8_BAR; PG8_SCHED;
            PG8_STAGE(PG8_SB(0, 1), b2 + hstep, voffB);
            PG8_WAIT_V(6); PG8_BAR; PG8_MMA(1, 1, At, B1); PG8_BAR;
            PG8_LDB(B0, 1, 0); PG8_SCHED; PG8_LDA(At, 1, 0); PG8_STAGE(PG8_SA(0, 1), a2 + hstep, voffA);
            PG8_WAIT_L(8); PG8_BAR; PG8_WAIT_L(0); PG8_MMA(0, 0, At, B0); PG8_BAR; PG8_SCHED;
            PG8_LDB(B1, 1, 1); PG8_STAGE(PG8_SB(1, 0), b3, voffB);
            PG8_BAR; PG8_WAIT_L(0); PG8_MMA(0, 1, At, B1); PG8_BAR;
            PG8_LDA(At, 1, 1); PG8_STAGE(PG8_SA(1, 0), a3, voffA);
            PG8_BAR; PG8_WAIT_L(0); PG8_MMA(1, 0, At, B0); PG8_BAR; PG8_SCHED;
            PG8_STAGE(PG8_SB(1, 1), b3 + hstep, voffB);
            PG8_WAIT_V(6); PG8_BAR; PG8_MMA(1, 1, At, B1); PG8_BAR;
            }
        }
        if constexpr (ALIGN_EPI) { if (wr == 0) PG8_BAR; }
        if constexpr (!Epi::AFTER_DRAIN) { int te_ = tid; asm volatile("" : "+v"(te_)); const int le_ = te_ & 63;
            E(acc, cur, wr, wc, le_ & 15, le_ >> 4); S.done(cur); }
        if (!has_next) break;
#pragma unroll
        for (int a = 0; a < 2; ++a)
#pragma unroll
            for (int b = 0; b < 2; ++b)
#pragma unroll
                for (int m = 0; m < 4; ++m)
#pragma unroll
                    for (int n = 0; n < 2; ++n) acc[a][b][m][n] = (f32x4){0.f, 0.f, 0.f, 0.f};
        cur = nxt; cA = nA; cB = nB; ++ui;
        if constexpr (ALIGN_EPI) { if (wr == 1) PG8_BAR; }
    }
    PG8_WAIT_V(0);
    if constexpr (!ALIGN_EPI) { if (wr == 0) PG8_BAR; }
    PG8_BAR;
    if constexpr (Epi::AFTER_DRAIN) { E.fused(acc, cur, wr, wc, fr, fq, lds, wid, lane); S.done(cur); }
#undef PG8_SA
#undef PG8_SB
#undef PG8_STAGE
#undef PG8_LDA
#undef PG8_LDB
#undef PG8_MMA
#undef PG8_WAIT_V
#undef PG8_WAIT_L
#undef PG8_BAR
#undef PG8_SCHED
}
}
#include <hip/hip_bf16.h>
#include <cmath>
namespace attn_body {
using bf16=__hip_bfloat16;
using bf16x8=__attribute__((ext_vector_type(8)))short;
using s16x4=__attribute__((ext_vector_type(4)))short;
using f32x16=__attribute__((ext_vector_type(16)))float;
using u32x4=__attribute__((ext_vector_type(4)))unsigned;
constexpr int BATCH=8,NHEAD=16,SEQ=4096,D=64,DM=NHEAD*D;
constexpr int NW=8,QBLK=32,QB=QBLK*NW,KVBLK=64,NQB=SEQ/QB;
constexpr int ATTN_PITCH=DM, ATTN_UNIT_ROWS=QB;
__device__ __forceinline__ int crow(int r,int hi){return (r&3)+8*(r>>2)+4*hi;}
#define SBAR() __builtin_amdgcn_sched_barrier(0)
__device__ __forceinline__ void cmask(f32x16&p0,f32x16&p1,int jb,int qrel,int hi){
  const float NEG=-INFINITY; int kb=64*jb+4*hi;
  #pragma unroll
  for(int r=0;r<16;++r){int kv=kb+(r&3)+8*(r>>2); if(kv>qrel)p0[r]=NEG; if(kv+32>qrel)p1[r]=NEG;}
}

constexpr int NSLOT=3, SLOTB=8192;
typedef float f32x4_t __attribute__((ext_vector_type(4)));
constexpr int LDS_K=0, LDS_V=NSLOT*SLOTB, LDS_WS=2*NSLOT*SLOTB, LDS_OST=LDS_WS+NW*64*4, LDS_NB=LDS_OST+NW*4096, LDS_BYTES=LDS_NB+SEQ*4;
constexpr float C2=0.125f*1.4426950408889634f;
__device__ __forceinline__ void glds16(const void*gsrc,unsigned lds_dst){unsigned keep;
  asm volatile("s_mov_b32 %0, m0\n\ts_mov_b32 m0, %2\n\ts_nop 0\n\tglobal_load_lds_dwordx4 %1, off\n\ts_mov_b32 m0, %0":"=&s"(keep):"v"(gsrc),"s"(lds_dst):"memory");}
__device__ __forceinline__ float max3f(float a,float b,float c){float r;asm("v_max3_f32 %0, %1, %2, %3":"=v"(r):"v"(a),"v"(b),"v"(c));return r;}
__device__ __forceinline__ float max2f(float a,float b){float r;asm("v_max_f32_e32 %0, %1, %2":"=v"(r):"v"(a),"v"(b));return r;}
__device__ __forceinline__ float fadd_s(float a,float b){float r;asm("v_add_f32_e32 %0, %1, %2":"=v"(r):"v"(a),"v"(b));return r;}
__device__ __forceinline__ float fsub_s(float a,float b){float r;asm("v_sub_f32_e32 %0, %1, %2":"=v"(r):"v"(a),"v"(b));return r;}
typedef float f32x2_t __attribute__((ext_vector_type(2))); typedef __bf16 bf16x2_t __attribute__((ext_vector_type(2)));
__device__ __forceinline__ unsigned cvtpk_s(float lo,float hi){f32x2_t v={lo,hi};bf16x2_t b=__builtin_convertvector(v,bf16x2_t);return __builtin_bit_cast(unsigned,b);}
#define WAIT_BAR(N) asm volatile("s_waitcnt vmcnt(" #N ") lgkmcnt(0)\n\ts_barrier":::"memory")

__device__ __forceinline__ void qkt(f32x16&p0,f32x16&p1,const char*Kslot,const bf16x8*qr,int r32,int hi){
  const char*kb=Kslot+hi*1024+r32*16;
  #pragma unroll
  for(int d0=0;d0<4;++d0){
    const bf16x8 b0=*reinterpret_cast<const bf16x8*>(kb+d0*2048);
    const bf16x8 b1=*reinterpret_cast<const bf16x8*>(kb+d0*2048+512);
    p0=__builtin_amdgcn_mfma_f32_32x32x16_bf16(b0,qr[d0],p0,0,0,0);p1=__builtin_amdgcn_mfma_f32_32x32x16_bf16(b1,qr[d0],p1,0,0,0);}
}
typedef __attribute__((address_space(3))) const char* lds_cptr;
typedef short v4i16_t __attribute__((ext_vector_type(4)));
__device__ __forceinline__ void kload8(bf16x8*kf,lds_cptr kp){
  kf[0]=*(const __attribute__((address_space(3))) bf16x8*)(kp);      kf[1]=*(const __attribute__((address_space(3))) bf16x8*)(kp+512);
  kf[2]=*(const __attribute__((address_space(3))) bf16x8*)(kp+2048); kf[3]=*(const __attribute__((address_space(3))) bf16x8*)(kp+2560);
  kf[4]=*(const __attribute__((address_space(3))) bf16x8*)(kp+4096); kf[5]=*(const __attribute__((address_space(3))) bf16x8*)(kp+4608);
  kf[6]=*(const __attribute__((address_space(3))) bf16x8*)(kp+6144); kf[7]=*(const __attribute__((address_space(3))) bf16x8*)(kp+6656);
}
__device__ __forceinline__ void kload2(bf16x8*kf,lds_cptr kp,int j){ kf[2*j]=*(const __attribute__((address_space(3))) bf16x8*)(kp+j*2048); kf[2*j+1]=*(const __attribute__((address_space(3))) bf16x8*)(kp+j*2048+512); }
__device__ __forceinline__ s16x4 vtr(lds_cptr p){ return __builtin_bit_cast(s16x4,__builtin_amdgcn_ds_read_tr16_b64_v4i16((__attribute__((address_space(3))) v4i16_t*)p)); }
__device__ __forceinline__ float rowmax(const f32x16&p0,const f32x16&p1){
  float a=max3f(p0[0],p0[1],p1[0]),b=max3f(p0[2],p0[3],p1[1]);a=max3f(a,p1[2],p1[3]);
  #pragma unroll
  for(int r=4;r<16;r+=4){a=max3f(a,p0[r],p0[r+1]);b=max3f(b,p0[r+2],p0[r+3]);a=max3f(a,p1[r],p1[r+1]);b=max3f(b,p1[r+2],p1[r+3]);}
  const float m=max2f(a,b);
  auto rr=__builtin_amdgcn_permlane32_swap(__float_as_uint(m),__float_as_uint(m),false,false);
  return max2f(__uint_as_float(rr[0]),__uint_as_float(rr[1]));
}
__device__ __forceinline__ void pv(f32x16*o,int vb,bf16x8 pa0,bf16x8 pa1,bf16x8 pa2,bf16x8 pa3){
  #pragma unroll
  for(int d0=0;d0<2;++d0){s16x4 lo[4],hi[4];
    #pragma unroll
    for(int ks=0;ks<4;++ks){
      asm volatile("ds_read_b64_tr_b16 %0,%1 offset:%c2":"=&v"(lo[ks]):"v"(vb),"i"(d0*4096+ks*1024):"memory");
      asm volatile("ds_read_b64_tr_b16 %0,%1 offset:%c2":"=&v"(hi[ks]):"v"(vb),"i"(d0*4096+ks*1024+512):"memory");}
    asm volatile("s_waitcnt lgkmcnt(0)":::"memory");SBAR();
    #define PK(k) (bf16x8){lo[k][0],lo[k][1],lo[k][2],lo[k][3],hi[k][0],hi[k][1],hi[k][2],hi[k][3]}
    o[d0]=__builtin_amdgcn_mfma_f32_32x32x16_bf16(pa0,PK(0),o[d0],0,0,0);
    o[d0]=__builtin_amdgcn_mfma_f32_32x32x16_bf16(pa1,PK(1),o[d0],0,0,0);
    o[d0]=__builtin_amdgcn_mfma_f32_32x32x16_bf16(pa2,PK(2),o[d0],0,0,0);
    o[d0]=__builtin_amdgcn_mfma_f32_32x32x16_bf16(pa3,PK(3),o[d0],0,0,0);
    #undef PK
  }
}

#ifndef ATTN_STORE16
#define ATTN_STORE16(p,v) (*(u32x4*)(p)=(v))
#endif
template<int THRL> __device__ __forceinline__ void attn_unit(int b,int h,int qb,const bf16*Q,const bf16*__restrict__ K,const bf16*__restrict__ V,bf16*O,char*shm,bool live){
  const __attribute__((address_space(3))) float* nbp=(const __attribute__((address_space(3))) float*)(lds_cptr)(shm+LDS_NB);
  #define BIASC(C0,C1,t) do{ const __attribute__((address_space(3))) float* bp_=nbp+(t)*64+4*hi; \
    _Pragma("unroll") for(int g_=0;g_<4;++g_){ const f32x4_t a_=*(const __attribute__((address_space(3))) f32x4_t*)(bp_+8*g_); const f32x4_t b_=*(const __attribute__((address_space(3))) f32x4_t*)(bp_+32+8*g_); \
      C0[4*g_]=a_[0]-mhat;C0[4*g_+1]=a_[1]-mhat;C0[4*g_+2]=a_[2]-mhat;C0[4*g_+3]=a_[3]-mhat; C1[4*g_]=b_[0]-mhat;C1[4*g_+1]=b_[1]-mhat;C1[4*g_+2]=b_[2]-mhat;C1[4*g_+3]=b_[3]-mhat; } }while(0)

  int tid_=threadIdx.x; asm volatile("":"+v"(tid_)); const int tid=tid_,lane=tid&63,r32=lane&31,hi=lane>>5; const int wid=__builtin_amdgcn_readfirstlane(tid>>6);
  const long rowbase=(long)b*SEQ; const int q0=qb*QB;
  const bf16*Qw=Q+(rowbase+q0+wid*QBLK)*DM+h*D;
  const bf16*Kh=K+rowbase*DM+h*D,*Vh=V+rowbase*DM+h*D;
  const unsigned lds0=(unsigned)(uintptr_t)shm;
  float*wsf=(float*)(shm+LDS_WS)+wid*64;
  const bf16*ksrc=Kh+(long)lane*DM+wid*8;
  const bf16*vsrc=Vh+(long)(16*(wid&3)+(lane>>2))*DM+(wid>>2)*32+(lane&3)*8;
  const unsigned kdst=lds0+LDS_K+wid*1024, vdst=lds0+LDS_V+wid*1024;
  #define DMA_K(t,slot) glds16(ksrc+(long)(t)*KVBLK*DM,(unsigned)__builtin_amdgcn_readfirstlane(kdst+(slot)))
  #define DMA_V(t,slot) glds16(vsrc+(long)(t)*KVBLK*DM,(unsigned)__builtin_amdgcn_readfirstlane(vdst+(slot)))
  const int vb0=(int)(lds0+LDS_V)+((lane>>4)&1)*32+(lane&3)*8+(4*hi+((lane&15)>>2))*64;
  const char*Kbase=shm+LDS_K; bf16x8 kf[8];
  const lds_cptr shm3=(lds_cptr)shm; const lds_cptr kp0=shm3+LDS_K+hi*1024+r32*16; const lds_cptr vp0=shm3+LDS_V+((lane>>4)&1)*32+(lane&3)*8+(4*hi+((lane&15)>>2))*64;
  const int NT=(q0+QB)/KVBLK;
  DMA_K(0,0);DMA_V(0,0);DMA_K(1,SLOTB);
  bf16x8 qr[4];
  #pragma unroll
  for(int d0=0;d0<4;++d0)qr[d0]=*reinterpret_cast<const bf16x8*>(&Qw[(long)r32*DM+d0*16+hi*8]);
  float mhat=0.f,l_reg=0.f;f32x16 o[2];o[0]=f32x16{};o[1]=f32x16{};
  const int qrel=wid*QBLK+r32;
  #define CMASK(P0,P1,t) do{int jb_=(t)-(NT-4); if(jb_>=0)cmask(P0,P1,jb_,qrel,hi);}while(0)
  bool resc=false;
  #define START(P0,P1) do{ const float rm=rowmax(P0,P1); resc=false; \
    { const float dl=rm; mhat=fadd_s(mhat,dl); \
      _Pragma("unroll") for(int r=0;r<16;++r){P0[r]=fsub_s(P0[r],dl);P1[r]=fsub_s(P1[r],dl);} \
      } \
    _Pragma("unroll") for(int r=0;r<16;++r)P0[r]=__builtin_amdgcn_exp2f(P0[r]); }while(0)
  #define RESC() do{ if(resc){ asm volatile("s_waitcnt lgkmcnt(0)":::"memory"); \
      _Pragma("unroll") for(int d_=0;d_<2;++d_) _Pragma("unroll") for(int r=0;r<16;++r)o[d_][r]*=wsf[crow(r,hi)]; } }while(0)
  f32x16 pA0,pA1,pB0,pB1;
  int sl_prev=0,sl_cur=0,sl_next=SLOTB;
  #define ROT() do{sl_prev=sl_cur;sl_cur=sl_next;sl_next=(sl_next==(NSLOT-1)*SLOTB)?0:sl_next+SLOTB;}while(0)
  DMA_K(2,2*SLOTB);
  WAIT_BAR(3);
  BIASC(pA0,pA1,0); qkt(pA0,pA1,Kbase,qr,r32,hi);asm volatile("s_nop 15\n\ts_nop 7":"+v"(pA0),"+v"(pA1));CMASK(pA0,pA1,0);
  START(pA0,pA1);
  _Pragma("unroll") for(int r=0;r<16;++r)pA1[r]=__builtin_amdgcn_exp2f(pA1[r]);
  BIASC(pB0,pB1,1);
  WAIT_BAR(0);
  DMA_K(3,0);DMA_V(1,SLOTB);
  ROT();
  kload8(kf,kp0+sl_cur);
  WAIT_BAR(2);
  s16x4 vlo[8],vhi[8]; u32x4 pw0,pw1,pw2,pw3;
  #define PKW(P,B) cvtpk_s(P[B],P[B+1])
  #define PAF(k) __builtin_bit_cast(bf16x8,pw##k)
  #define VFR(i) (bf16x8){vlo[i][0],vlo[i][1],vlo[i][2],vlo[i][3],vhi[i][0],vhi[i][1],vhi[i][2],vhi[i][3]}
  #define PIN(x) asm volatile("":"+v"(x))
  #define MX3(a,b,c) __builtin_fmaxf(__builtin_fmaxf((a),(b)),(c))
  #define GAPA(MF,A0,A1,A2,A3,W0,W1,PW) do{ MF; sacc+=A0; sacc+=A1; sacc+=A2; sacc+=A3; PIN(sacc); W0; W1; PIN(PW); SBAR(); }while(0)
  #define EX(v) __builtin_amdgcn_exp2f(v)
  #define GAPB(MF,X,B,Z) do{ MF; X[B]=EX(X[B]); X[B+1]=EX(X[B+1]); X[B+2]=EX(X[B+2]); X[B+3]=EX(X[B+3]); PIN(X); Z[B]-=mhat; Z[B+1]-=mhat; Z[B+2]-=mhat; Z[B+3]-=mhat; PIN(Z); SBAR(); }while(0)
  #define BIASLD(Z0,Z1,t) do{ const __attribute__((address_space(3))) float* bp_=nbp+(t)*64+4*hi; \
    _Pragma("unroll") for(int g_=0;g_<4;++g_){ const f32x4_t a_=*(const __attribute__((address_space(3))) f32x4_t*)(bp_+8*g_); const f32x4_t b_=*(const __attribute__((address_space(3))) f32x4_t*)(bp_+32+8*g_); \
      Z0[4*g_]=a_[0];Z0[4*g_+1]=a_[1];Z0[4*g_+2]=a_[2];Z0[4*g_+3]=a_[3]; Z1[4*g_]=b_[0];Z1[4*g_+1]=b_[1];Z1[4*g_+2]=b_[2];Z1[4*g_+3]=b_[3]; } }while(0)
  #define VRD(i) do{ vlo[i]=vtr(vp_+(((i)>>2)*4096+((i)&3)*1024)); vhi[i]=vtr(vp_+(((i)>>2)*4096+((i)&3)*1024+512)); }while(0)
  #define KRD(G,j) do{ if(G){ kload2(kf,kp0+sl_next,j); SBAR(); } }while(0)
  #define STEP(C0,C1,P0,P1,t,GK,GV,GL) do{ SBAR(); \
    const lds_cptr vp_=vp0+sl_prev; \
    VRD(0); SBAR(); float sacc=(P0[0]+P0[1]); \
    GAPA(C0=__builtin_amdgcn_mfma_f32_32x32x16_bf16(kf[0],qr[0],C0,0,0,0), P0[2],P0[3],P0[4],P0[5],     pw0[0]=PKW(P0,0), pw0[1]=PKW(P0,2), pw0); \
    VRD(4); SBAR(); GAPA(C1=__builtin_amdgcn_mfma_f32_32x32x16_bf16(kf[1],qr[0],C1,0,0,0), P0[6],P0[7],P0[8],P0[9],     pw0[2]=PKW(P0,4), pw0[3]=PKW(P0,6), pw0); \
    VRD(1); SBAR(); GAPA(C0=__builtin_amdgcn_mfma_f32_32x32x16_bf16(kf[2],qr[1],C0,0,0,0),   P0[10],P0[11],P0[12],P0[13], pw1[0]=PKW(P0,8), pw1[1]=PKW(P0,10), pw1); \
    VRD(5); SBAR(); GAPA(C1=__builtin_amdgcn_mfma_f32_32x32x16_bf16(kf[3],qr[1],C1,0,0,0),   P0[14],P0[15],P1[0],P1[1],   pw1[2]=PKW(P0,12),pw1[3]=PKW(P0,14), pw1); \
    VRD(2); SBAR(); GAPA(C0=__builtin_amdgcn_mfma_f32_32x32x16_bf16(kf[4],qr[2],C0,0,0,0),   P1[2],P1[3],P1[4],P1[5],     pw2[0]=PKW(P1,0), pw2[1]=PKW(P1,2), pw2); \
    VRD(6); SBAR(); GAPA(C1=__builtin_amdgcn_mfma_f32_32x32x16_bf16(kf[5],qr[2],C1,0,0,0),   P1[6],P1[7],P1[8],P1[9],     pw2[2]=PKW(P1,4), pw2[3]=PKW(P1,6), pw2); \
    VRD(3); SBAR(); GAPA(C0=__builtin_amdgcn_mfma_f32_32x32x16_bf16(kf[6],qr[3],C0,0,0,0),   P1[10],P1[11],P1[12],P1[13], pw3[0]=PKW(P1,8), pw3[1]=PKW(P1,10), pw3); \
    VRD(7); SBAR(); GAPA(C1=__builtin_amdgcn_mfma_f32_32x32x16_bf16(kf[7],qr[3],C1,0,0,0),   P1[14],P1[15],0.f,0.f,       pw3[2]=PKW(P1,12),pw3[3]=PKW(P1,14), pw3); \
    l_reg+=sacc; \
    if(GK){DMA_K((t)+3,sl_cur);} if(GV){DMA_V((t)+1,sl_next);} \
    CMASK(C0,C1,t); \
    { float a=MX3(C0[0],C0[1],C1[0]),b=MX3(C0[2],C0[3],C1[1]); a=MX3(a,C1[2],C1[3]); \
      _Pragma("unroll") for(int r=4;r<16;r+=4){a=MX3(a,C0[r],C0[r+1]);b=MX3(b,C0[r+2],C0[r+3]);a=MX3(a,C1[r],C1[r+1]);b=MX3(b,C1[r+2],C1[r+3]);} \
      float rm=__builtin_fmaxf(a,b); { auto rr=__builtin_amdgcn_permlane32_swap(__float_as_uint(rm),__float_as_uint(rm),false,false); rm=__builtin_fmaxf(__uint_as_float(rr[0]),__uint_as_float(rr[1])); } \
      resc=false; \
      if(__builtin_expect(__any(rm>(float)THRL),0)){ const float dl=__builtin_fmaxf(rm,0.f); mhat+=dl; \
        _Pragma("unroll") for(int r=0;r<16;++r){C0[r]-=dl;C1[r]-=dl;} \
        const float f=__builtin_amdgcn_exp2f(-dl); l_reg*=f; if(hi==0)wsf[r32]=f; resc=true; } } \
    SBAR(); BIASLD(P0,P1,(t)+1); SBAR(); \
    GAPB(o[0]=__builtin_amdgcn_mfma_f32_32x32x16_bf16(PAF(0),VFR(0),o[0],0,0,0), C0,0,P0); \
    GAPB(o[1]=__builtin_amdgcn_mfma_f32_32x32x16_bf16(PAF(0),VFR(4),o[1],0,0,0), C0,4,P0); \
    KRD(GL,0); GAPB(o[0]=__builtin_amdgcn_mfma_f32_32x32x16_bf16(PAF(1),VFR(1),o[0],0,0,0), C0,8,P0); \
    KRD(GL,1); GAPB(o[1]=__builtin_amdgcn_mfma_f32_32x32x16_bf16(PAF(1),VFR(5),o[1],0,0,0), C0,12,P0); \
    KRD(GL,2); GAPB(o[0]=__builtin_amdgcn_mfma_f32_32x32x16_bf16(PAF(2),VFR(2),o[0],0,0,0), C1,0,P1); \
    KRD(GL,3); GAPB(o[1]=__builtin_amdgcn_mfma_f32_32x32x16_bf16(PAF(2),VFR(6),o[1],0,0,0), C1,4,P1); \
    GAPB(o[0]=__builtin_amdgcn_mfma_f32_32x32x16_bf16(PAF(3),VFR(3),o[0],0,0,0), C1,8,P1); \
    GAPB(o[1]=__builtin_amdgcn_mfma_f32_32x32x16_bf16(PAF(3),VFR(7),o[1],0,0,0), C1,12,P1); \
    }while(0)
  int t=1;
  #undef CMASK
  #define CMASK(P0,P1,t) do{}while(0)
  for(;t+5<NT;t+=2){
    STEP(pB0,pB1,pA0,pA1,t,true,true,true);     WAIT_BAR(2); RESC(); ROT();
    STEP(pA0,pA1,pB0,pB1,t+1,true,true,true);   WAIT_BAR(2); RESC(); ROT();
  }
  #undef CMASK
  #define CMASK(P0,P1,t) do{int jb_=(t)-(NT-4); if(jb_>=0)cmask(P0,P1,jb_,qrel,hi);}while(0)
  #define ENDW(tt) do{ if((tt)+3<NT){WAIT_BAR(2);} else if((tt)+2<NT){WAIT_BAR(1);} else {WAIT_BAR(0);} }while(0)
  for(;t+1<NT;t+=2){
    STEP(pB0,pB1,pA0,pA1,t,(t+3<NT),(t+1<NT),(t+1<NT));       ENDW(t);   RESC(); ROT();
    STEP(pA0,pA1,pB0,pB1,t+1,(t+4<NT),(t+2<NT),(t+2<NT));     ENDW(t+1); RESC(); ROT();
  }
  STEP(pB0,pB1,pA0,pA1,NT-1,false,false,false); RESC();
  { float sacc=pB0[0]+pB0[1]; _Pragma("unroll") for(int r=2;r<16;++r)sacc+=pB0[r]; _Pragma("unroll") for(int r=0;r<16;++r)sacc+=pB1[r]; l_reg+=sacc;
    pw0=(u32x4){PKW(pB0,0),PKW(pB0,2),PKW(pB0,4),PKW(pB0,6)};pw1=(u32x4){PKW(pB0,8),PKW(pB0,10),PKW(pB0,12),PKW(pB0,14)};pw2=(u32x4){PKW(pB1,0),PKW(pB1,2),PKW(pB1,4),PKW(pB1,6)};pw3=(u32x4){PKW(pB1,8),PKW(pB1,10),PKW(pB1,12),PKW(pB1,14)};
    SBAR(); pv(o,vb0+sl_cur,PAF(0),PAF(1),PAF(2),PAF(3)); }
  #undef PKW
  #undef PAF
  #undef VFR
  #undef PIN
  #undef MX3
  #undef GAPA
  #undef GAPB
  #undef BIASLD
  #undef EX
  #undef VRD
  #undef KRD
  #undef STEP
  #undef ENDW
  {auto rr=__builtin_amdgcn_permlane32_swap(__float_as_uint(l_reg),__float_as_uint(l_reg),false,false);l_reg=__uint_as_float(rr[0])+__uint_as_float(rr[1]);}
  if(hi==0)wsf[32+r32]=l_reg;asm volatile("s_waitcnt lgkmcnt(0)":::"memory");
  float rli[16];
  #pragma unroll
  for(int r=0;r<16;++r)rli[r]=__builtin_amdgcn_rcpf(wsf[32+crow(r,hi)]);
  bf16*Ow=O+(rowbase+q0+wid*QBLK)*DM+h*D;
  { bf16*stg=(bf16*)(shm+LDS_OST)+wid*2048;
    #pragma unroll
    for(int r=0;r<16;++r){const int orow=crow(r,hi);
      #pragma unroll
      for(int d0=0;d0<2;++d0)stg[orow*64+d0*32+r32]=__float2bfloat16(o[d0][r]*rli[r]);}
    asm volatile("s_waitcnt lgkmcnt(0)":::"memory");
    #pragma unroll
    for(int i=0;i<4;++i){const int row=i*8+(lane>>3),ch=lane&7; const u32x4 v=*(const u32x4*)(stg+row*64+ch*8); if(live){ATTN_STORE16(Ow+(long)row*DM+ch*8,v);}} }
  asm volatile("s_waitcnt lgkmcnt(0)\n\ts_barrier":::"memory");
  #undef BIASC
  #undef DMA_K
  #undef DMA_V
  #undef CMASK
  #undef START
  #undef RESC
  #undef ROT
}
constexpr int ATTN_LDS_BYTES=LDS_BYTES;
struct AttnTensors { const bf16* Q; const bf16* K; const bf16* V; bf16* O; };
struct AttnUnit { int bh; int qb; };
struct StaticOrder {
  int vcu;
  __device__ __forceinline__ explicit StaticOrder(int grid,int block):vcu((block%8)*(grid/8)+block/8){}
  __device__ __forceinline__ bool next(int i,AttnUnit&u)const{ if(i>=8)return false; const int p=vcu&1; u.bh=vcu>>1; const int base=4*(i>>1); u.qb=(i&1)?base+3-p:base+p; return true; }
  __device__ __forceinline__ void a_ready(const AttnUnit&)const{}
  __device__ __forceinline__ void done(const AttnUnit&)const{}
};
template<class Sched,int THRL=8> __device__ __forceinline__ void attn_phase(char*lds,const AttnTensors&T,const Sched&S,bool live=true){
  AttnUnit u;
  for(int i=0;S.next(i,u);++i){ S.a_ready(u); attn_unit<THRL>(u.bh/NHEAD,u.bh%NHEAD,u.qb,T.Q,T.K,T.V,T.O,lds,live); S.done(u); }
}
#undef SBAR
#undef WAIT_BAR
}
#define XB_TMO      128
#define XB_XCNT(j)  (256  + 64 * (j))
#define XB_XSUB(j)  (1280 + 64 * (j))
#define XB_XGEN(j)  (2304 + 64 * (j))
#define XB_TOP      3328
#define XB_TOPGEN   3392
#define XCD_BAR_WORDS 3456
#define XB_SPIN_CAP (1u << 18)

__device__ __forceinline__ unsigned xb_ld(unsigned* p)              { return __hip_atomic_load(p, __ATOMIC_RELAXED, __HIP_MEMORY_SCOPE_AGENT); }
__device__ __forceinline__ unsigned xb_add(unsigned* p, unsigned v) { return __hip_atomic_fetch_add(p, v, __ATOMIC_RELAXED, __HIP_MEMORY_SCOPE_AGENT); }
__device__ __forceinline__ unsigned xb_xcc_id() { return (unsigned)__builtin_amdgcn_s_getreg((3 << 11) | 20) & 0xFu; }
#define XB_SPIN(cond, bar) do { unsigned _sp = 0; while (cond) { __builtin_amdgcn_s_sleep(1); \
    if ((++_sp & 255u) == 0u) { if (xb_ld(&(bar)[XB_TMO])) break; if (_sp > XB_SPIN_CAP) { atomicAdd(&(bar)[XB_TMO], 1u); break; } } } } while (0)

struct XcdBarrier {
    unsigned* bar; unsigned x;
    volatile LAS unsigned* st;
};

__device__ __forceinline__ XcdBarrier xcd_barrier_post(unsigned* bar, volatile LAS unsigned* st) {
    XcdBarrier b; b.bar = bar; b.x = xb_xcc_id(); b.st = st;
    if (threadIdx.x == 0) (void)xb_add(&bar[XB_XCNT(b.x)], 1u);
    return b;
}
__device__ __forceinline__ void xcd_barrier_complete(unsigned* bar, unsigned x, unsigned& nloc, unsigned& nx) {
    const unsigned G = gridDim.x * gridDim.y * gridDim.z;
    unsigned sum, cnt, mine, sp = 0u;
    for (;;) {
        sum = 0u; cnt = 0u; mine = 0u;
#pragma unroll
        for (unsigned j = 0; j < 16; ++j) { const unsigned c = xb_ld(&bar[XB_XCNT(j)]); sum += c; cnt += (c > 0u) ? 1u : 0u; mine = (j == x) ? c : mine; }
        if (sum == G) break;
        __builtin_amdgcn_s_sleep(1);
        if ((++sp & 255u) == 0u) { if (xb_ld(&bar[XB_TMO])) break; if (sp > XB_SPIN_CAP) { atomicAdd(&bar[XB_TMO], 1u); break; } }
    }
    nloc = mine > 0u ? mine : 1u; nx = cnt > 0u ? cnt : 1u;
}

__device__ __forceinline__ void xcd_barrier(const XcdBarrier& b) {
    asm volatile("s_waitcnt vmcnt(0)" ::: "memory");
    __syncthreads();
    if (threadIdx.x == 0) {
        unsigned* bar = b.bar;
        __builtin_amdgcn_s_waitcnt(0);
        unsigned nloc = b.st[0], nx = b.st[1];
        if (nloc == 0u) { xcd_barrier_complete(bar, b.x, nloc, nx); b.st[0] = nloc; b.st[1] = nx; }
        const unsigned old = xb_add(&bar[XB_XSUB(b.x)], 1u);
        const unsigned gen = old / nloc;
        if (old + 1u == (gen + 1u) * nloc) {
            __builtin_amdgcn_fence(__ATOMIC_RELEASE, "agent");
            asm volatile("s_waitcnt vmcnt(0)" ::: "memory");
            const unsigned og = xb_add(&bar[XB_TOP], 1u);
            const unsigned tg = og / nx;
            if (og + 1u == (tg + 1u) * nx) xb_add(&bar[XB_TOPGEN], 1u);
            else XB_SPIN(xb_ld(&bar[XB_TOPGEN]) == tg, bar);
            __builtin_amdgcn_fence(__ATOMIC_ACQUIRE, "agent");
            xb_add(&bar[XB_XGEN(b.x)], 1u);
            asm volatile("s_waitcnt vmcnt(0)" ::: "memory");
        } else {
            XB_SPIN(xb_ld(&bar[XB_XGEN(b.x)]) == gen, bar);
            __builtin_amdgcn_fence(__ATOMIC_ACQUIRE, "agent");
            asm volatile("s_waitcnt vmcnt(0)" ::: "memory");
        }
    }
    __syncthreads();
}
constexpr int BATCH = 8, SEQ = 4096, DM = 1024, T = BATCH * SEQ, DFF = 2816, DPLE = 256;
constexpr int NWAVES = 8;
typedef unsigned short bf16;
typedef unsigned v4u __attribute__((ext_vector_type(4)));
typedef unsigned v2u __attribute__((ext_vector_type(2)));
typedef float f32x4 __attribute__((ext_vector_type(4)));
typedef short bf16x8 __attribute__((ext_vector_type(8)));
typedef short v4i16 __attribute__((ext_vector_type(4)));
__device__ __forceinline__ unsigned f2bf(float f) { unsigned u = __builtin_bit_cast(unsigned, f); return (u + 0x7fffu + ((u >> 16) & 1u)) >> 16; }
__device__ __forceinline__ unsigned pk2(float lo, float hi) { return f2bf(lo) | (f2bf(hi) << 16); }

constexpr size_t MiB = 1u << 20;
constexpr size_t WS_SS = 456 * MiB;
constexpr size_t WS_HSS = 474 * MiB;
constexpr size_t WS_BAR = 1856 * 1024;
constexpr size_t WS_LOGF = 2 * MiB;
constexpr size_t WS_ROPE = 4 * MiB;
constexpr size_t WS_WFFI = 8 * MiB;
constexpr size_t WS_WFFO = 52 * MiB;
constexpr size_t WS_WRIN = 74 * MiB;
constexpr size_t WS_WRG = 82 * MiB;
constexpr size_t WS_WRO = 86 * MiB;
constexpr size_t WS_WFIN = 90 * MiB;
constexpr size_t WS_WFZ = 96 * MiB;
constexpr size_t WS_WFO = 97 * MiB;
constexpr size_t WS_WPG = 99 * MiB;
constexpr size_t WS_WPP = 103 * MiB;
constexpr size_t WS_HB = 104 * MiB;
constexpr size_t WS_PB = 168 * MiB;
constexpr size_t WS_POOL = 200 * MiB;
constexpr size_t WS_END = 482 * MiB;
constexpr int LDS_BYTES = 147456, RING_BYTES = 131072;

namespace ret {
constexpr int KP = 528, VP = 144, PPI = 144;
constexpr int L_K = 0, L_V = L_K + 2 * 64 * KP, L_P = L_V + 2 * 64 * VP, L_ST = L_P + 64 * PPI, L_END = L_ST + 64 * KP;
static_assert(L_END <= RING_BYTES, "retention LDS");
#define MFMA16(a, b, c) __builtin_amdgcn_mfma_f32_16x16x32_bf16((a), (b), (c), 0, 0, 0)
__device__ __forceinline__ bf16x8 trfrag(const LAS char* p, int pitch) {
    const v4i16 lo = __builtin_amdgcn_ds_read_tr16_b64_v4i16((LAS v4i16*)p), hi = __builtin_amdgcn_ds_read_tr16_b64_v4i16((LAS v4i16*)(p + 4 * pitch));
    return (bf16x8){lo[0], lo[1], lo[2], lo[3], hi[0], hi[1], hi[2], hi[3]};
}
__device__ __forceinline__ v2u pk4(const f32x4 v) { return (v2u){pg8::cvt_pk_bf16(v[0], v[1]), pg8::cvt_pk_bf16(v[2], v[3])}; }
__device__ __forceinline__ void ret_phase(LAS char* L, const bf16* Qt, const bf16* Kt, bf16* VO, float* hss, int vcu, bool live = true) {
    int tid_ = threadIdx.x; asm volatile("" : "+v"(tid_));
    const int tid = tid_, lane = tid & 63, w = __builtin_amdgcn_readfirstlane(tid >> 6), m16 = lane & 15, g = lane >> 4, q4 = m16 >> 2, p4 = lane & 3;
    const int ib = w >> 1, half = w & 1;
    const int bh = vcu >> 3, es = vcu & 7, b = bh >> 2, h = bh & 3;
    const float lg = log2f(1.0f - exp2f(-5.0f - (float)h)), gC = exp2f(64.0f * lg);
    const size_t tok0 = (size_t)b * SEQ;
    const bf16* kbase = Kt + tok0 * 1024 + h * 256 + (size_t)(tid >> 5) * 1024 + (tid & 31) * 8;
    const bf16* vbase = VO + tok0 * 2048 + h * 512 + es * 64 + (size_t)(tid >> 3) * 2048 + (tid & 7) * 8;
    const bf16* qbase = Qt + tok0 * 1024 + h * 256 + (size_t)(16 * ib + m16) * 1024 + 8 * g;
    for (int i = tid; i < 64 * KP / 16; i += 512) *(LAS v4u*)(L + L_ST + 16 * i) = (v4u){0u, 0u, 0u, 0u};
    f32x4 st[2][4];
#pragma unroll
    for (int a = 0; a < 2; ++a)
#pragma unroll
        for (int e = 0; e < 4; ++e) st[a][e] = (f32x4){0.f, 0.f, 0.f, 0.f};
    v4u kreg[4], vreg; bf16x8 qn[8];
#define RET_LOADKV(c) do { _Pragma("unroll") for (int u_ = 0; u_ < 4; ++u_) kreg[u_] = *(const v4u*)(kbase + (size_t)((c) * 64 + 16 * u_) * 1024); \
        vreg = *(const v4u*)(vbase + (size_t)(c) * 64 * 2048); } while (0)
#define RET_LOADQ(c) do { _Pragma("unroll") for (int s_ = 0; s_ < 8; ++s_) qn[s_] = *(const bf16x8*)(qbase + (size_t)(c) * 64 * 1024 + 32 * s_); } while (0)
#define RET_STAGE(bf) do { _Pragma("unroll") for (int u_ = 0; u_ < 4; ++u_) *(LAS v4u*)(L + L_K + (bf) * 64 * KP + ((tid >> 5) + 16 * u_) * KP + (tid & 31) * 16) = kreg[u_]; \
        *(LAS v4u*)(L + L_V + (bf) * 64 * VP + (tid >> 3) * VP + (tid & 7) * 16) = vreg; } while (0)
    v2u opk[2]; float osq = 0.f; opk[0] = (v2u){0u, 0u}; opk[1] = (v2u){0u, 0u};
#define RET_OSTORE(c) do { const size_t tok_ = tok0 + (size_t)(c) * 64 + 16 * ib + m16; if (live) { \
        *(v2u*)(VO + tok_ * 2048 + h * 512 + es * 64 + 16 * (2 * half) + 4 * g) = opk[0]; *(v2u*)(VO + tok_ * 2048 + h * 512 + es * 64 + 16 * (2 * half + 1) + 4 * g) = opk[1]; \
        if (g == 0) hss[(tok_ * 4 + h) * 16 + es * 2 + half] = osq; } } while (0)
    RET_LOADKV(0); RET_LOADQ(0);
    RET_STAGE(0);
    RET_LOADKV(1);
    const int troff_k = (8 * g + q4) * KP + 8 * p4, troff_v = (8 * g + q4) * VP + 8 * p4;
    for (int c = 0; c < 64; ++c) {
        const LAS char* LK = L + L_K + (c & 1) * 64 * KP; const LAS char* LV = L + L_V + (c & 1) * 64 * VP;
        bf16x8 qf[8];
#pragma unroll
        for (int s = 0; s < 8; ++s) qf[s] = qn[s];
        __syncthreads();
        if (c + 1 < 64) { RET_STAGE((c + 1) & 1); RET_LOADQ(c + 1); if (c + 2 < 64) RET_LOADKV(c + 2); }
        if (c > 0) RET_OSTORE(c - 1);
        bf16x8 fr0[8], fr1[8];
#pragma unroll
        for (int s = 0; s < 8; ++s) { fr0[s] = *(const LAS bf16x8*)(LK + (16 * (2 * half) + m16) * KP + (32 * s + 8 * g) * 2); fr1[s] = *(const LAS bf16x8*)(LK + (16 * (2 * half + 1) + m16) * KP + (32 * s + 8 * g) * 2); }
        __builtin_amdgcn_sched_barrier(0);
        f32x4 sab[2]; sab[0] = (f32x4){0.f, 0.f, 0.f, 0.f}; sab[1] = (f32x4){0.f, 0.f, 0.f, 0.f};
#pragma unroll
        for (int s = 0; s < 8; ++s) { sab[0] = MFMA16(fr0[s], qf[s], sab[0]); sab[1] = MFMA16(fr1[s], qf[s], sab[1]); }
#pragma unroll
        for (int s = 0; s < 8; ++s) { fr0[s] = *(const LAS bf16x8*)(L + L_ST + (16 * (2 * half) + m16) * KP + (32 * s + 8 * g) * 2); fr1[s] = *(const LAS bf16x8*)(L + L_ST + (16 * (2 * half + 1) + m16) * KP + (32 * s + 8 * g) * 2); }
        __builtin_amdgcn_sched_barrier(0);
#pragma unroll
        for (int jj = 0; jj < 2; ++jj) { const int jb = 2 * half + jj; const f32x4 sa = sab[jj];
            const int il = 16 * ib + m16, j0 = 16 * jb + 4 * g;
            const f32x4 sm = (f32x4){(j0 + 0 <= il) ? sa[0] : 0.f, (j0 + 1 <= il) ? sa[1] : 0.f, (j0 + 2 <= il) ? sa[2] : 0.f, (j0 + 3 <= il) ? sa[3] : 0.f};
            *(LAS v2u*)(L + L_P + il * PPI + j0 * 2) = pk4(sm); }
        f32x4 oa[2]; oa[0] = (f32x4){0.f, 0.f, 0.f, 0.f}; oa[1] = (f32x4){0.f, 0.f, 0.f, 0.f};
#pragma unroll
        for (int s = 0; s < 8; ++s) { oa[0] = MFMA16(fr0[s], qf[s], oa[0]); oa[1] = MFMA16(fr1[s], qf[s], oa[1]); }
        __syncthreads();
        bf16x8 vt[2][4];
#pragma unroll
        for (int ks = 0; ks < 2; ++ks)
#pragma unroll
            for (int eb = 0; eb < 4; ++eb) vt[ks][eb] = trfrag(LV + (32 * ks) * VP + (16 * eb) * 2 + troff_v, VP);
#pragma unroll
        for (int ks = 0; ks < 2; ++ks) { const bf16x8 pf = *(const LAS bf16x8*)(L + L_P + (16 * ib + m16) * PPI + (32 * ks + 8 * g) * 2);
            if (half == 0) { oa[0] = MFMA16(vt[ks][0], pf, oa[0]); oa[1] = MFMA16(vt[ks][1], pf, oa[1]); }
            else           { oa[0] = MFMA16(vt[ks][2], pf, oa[0]); oa[1] = MFMA16(vt[ks][3], pf, oa[1]); } }
        { float sq = 0.f;
#pragma unroll
            for (int ee = 0; ee < 2; ++ee) { const f32x4 o = oa[ee]; sq += (o[0] * o[0] + o[1] * o[1]) + (o[2] * o[2] + o[3] * o[3]); opk[ee] = pk4(o); }
            sq = pg8::xsum_fq(sq); osq = sq; }
#pragma unroll
        for (int ks = 0; ks < 2; ++ks)
#pragma unroll
            for (int dd = 0; dd < 2; ++dd) { const bf16x8 kt = trfrag(LK + (32 * ks) * KP + (16 * (2 * w + dd)) * 2 + troff_k, KP);
#pragma unroll
                for (int eb = 0; eb < 4; ++eb) st[dd][eb] = MFMA16(kt, vt[ks][eb], st[dd][eb]); }
#pragma unroll
        for (int dd = 0; dd < 2; ++dd)
#pragma unroll
            for (int eb = 0; eb < 4; ++eb) { st[dd][eb] = st[dd][eb] * gC;
                *(LAS v2u*)(L + L_ST + (16 * eb + m16) * KP + (16 * (2 * w + dd) + 4 * g) * 2) = pk4(st[dd][eb]); }
    }
    RET_OSTORE(63);
    __syncthreads();
#undef RET_OSTORE
#undef RET_LOADKV
#undef RET_LOADQ
#undef RET_STAGE
}
}

struct Args { const float* in[14]; float* out; unsigned char* ws; };
struct Frame { LAS unsigned char* lds; int vcu, G; };
#define TID_FRESH(tid, lane, wave) int tid##_ = threadIdx.x; asm volatile("" : "+v"(tid##_)); const int tid = tid##_, lane = tid & 63, wave = __builtin_amdgcn_readfirstlane(tid >> 6); (void)lane; (void)wave;

#define swz_xor(v, pat) __int_as_float(__builtin_amdgcn_ds_swizzle(__float_as_int(v), (pat)))
__device__ __forceinline__ float wave_sum(float v) {
    v += swz_xor(v, (1 << 10) | 0x1f); v += swz_xor(v, (2 << 10) | 0x1f); v += swz_xor(v, (4 << 10) | 0x1f); v += swz_xor(v, (8 << 10) | 0x1f); v += swz_xor(v, (16 << 10) | 0x1f);
    auto b = __builtin_amdgcn_permlane32_swap(__float_as_uint(v), __float_as_uint(v), false, false); return __uint_as_float(b[0]) + __uint_as_float(b[1]);
}
__device__ __forceinline__ void prep_item(const float* W, int K, int Nsrc, bf16* WT, int rows, int mode, int coloff, const float* ks, LAS float* scr, int item, int lane) {
    const int nblk = rows / 32, kb = item / nblk, nb = item % nblk, k0 = 64 * kb, n0 = 32 * nb;
    const int src0 = mode ? (((n0 >> 7) & 1) * DFF + 128 * (n0 >> 8) + (n0 & 127)) : (coloff + n0);
    float wv[32];
#pragma unroll
    for (int i = 0; i < 32; ++i) { const int kk = 2 * i + (lane >> 5); wv[i] = __builtin_nontemporal_load(W + (size_t)(k0 + kk) * Nsrc + src0 + (lane & 31)); }
#pragma unroll
    for (int i = 0; i < 32; ++i) { const int kk = 2 * i + (lane >> 5); scr[kk * 33 + (lane & 31)] = wv[i]; }
    asm volatile("s_waitcnt lgkmcnt(0)" ::: "memory");
    const int c = lane & 7;
    float sc[8];
#pragma unroll
    for (int x = 0; x < 8; ++x) sc[x] = ks ? ks[k0 + 8 * c + x] : 1.0f;
#pragma unroll
    for (int j = 0; j < 4; ++j) { const int n = (lane >> 3) + 8 * j; const LAS float* s = scr + (8 * c) * 33 + n;
        v4u o; o.x = pk2(s[0 * 33] * sc[0], s[1 * 33] * sc[1]); o.y = pk2(s[2 * 33] * sc[2], s[3 * 33] * sc[3]); o.z = pk2(s[4 * 33] * sc[4], s[5 * 33] * sc[5]); o.w = pk2(s[6 * 33] * sc[6], s[7 * 33] * sc[7]);
        *(v4u*)(WT + (size_t)(n0 + n) * K + k0 + 8 * c) = o; }
    asm volatile("s_waitcnt lgkmcnt(0)" ::: "memory");
}
#define PREP(Wp, K_, Nsrc_, WTp, rows_, mode_, coloff_, ksp) do { const int nit_ = ((K_) / 64) * ((rows_) / 32); \
    for (int it_ = gw; it_ < nit_; it_ += NGW) prep_item((Wp), (K_), (Nsrc_), (WTp), (rows_), (mode_), (coloff_), (ksp), scr, it_, flane); } while (0)

typedef const volatile __attribute__((address_space(4))) unsigned long long* kargp_t;
#define KARG(i) ((unsigned long long)(*((kargp_t)__builtin_amdgcn_kernarg_segment_ptr() + (i))))
#define KIN(i) ((const float*)(const GAS float*)KARG(i))
#define KOUT ((float*)(GAS float*)KARG(14))
#define KWS ((unsigned char*)(GAS unsigned char*)KARG(15))
#define SEAM() do { XcdBarrier b_; b_.bar = (unsigned*)(KWS + WS_BAR); b_.x = xb_xcc_id(); b_.st = (volatile LAS unsigned*)(F.lds + RING_BYTES) + 8; xcd_barrier(b_); } while (0)
#define XS ((LAS float*)(F.lds + RING_BYTES + 1024))
#define GEMM_PHASE(EpiT, Aop, Bop, N_, K_, Eobj) do { int k_ = (K_); asm volatile("" : "+s"(k_));     \
        pg8::Gemm g_{(const pg8::bf16_t*)(Aop), (const pg8::bf16_t*)(Bop), T, (N_), k_}; pg8::StaticOrder S_; S_.init(T, (N_), F.G, (int)blockIdx.x); \
        pg8::gemm_phase<EpiT, pg8::StaticOrder, true, true>(F.lds, g_, S_, (Eobj)); } while (0)

__device__ __forceinline__ void p0_prologue(const Frame& F) {
    TID_FRESH(ftid, flane, fwave)
    unsigned char* ws = KWS;
    const float* norm_w = KIN(2);
    float* SS = (float*)(ws + WS_SS); float* HSS = (float*)(ws + WS_HSS);
    const int gw = F.vcu * NWAVES + fwave, NGW = F.G * NWAVES, gtid = gw * 64 + flane, NGT = NGW * 64;
    LAS float* scr = (LAS float*)(F.lds + fwave * 16384);
    { float* ROPE = (float*)(ws + WS_ROPE);
      for (int i = gtid; i < 4096 * 128; i += NGT) { const int pos = i >> 7, j = i & 127;
        const float inv = exp2f(-(float)j * (13.287712379549449f / 128.0f)); const float ang = (float)pos * inv;
        double tr = (double)ang * 0.15915494309189535; tr -= rint(tr); const float tf = (float)tr;
        ROPE[2 * i] = __builtin_amdgcn_cosf(tf); ROPE[2 * i + 1] = __builtin_amdgcn_sinf(tf); } }
    { const float* x = KIN(0); bf16* HB = (bf16*)(ws + WS_HB);
      for (int m = gw; m < T / 2; m += NGW) {
        f32x4 v[2][4];
#pragma unroll
        for (int rr = 0; rr < 2; ++rr)
#pragma unroll
            for (int j = 0; j < 4; ++j) v[rr][j] = __builtin_nontemporal_load((const f32x4*)(x + (size_t)(m + rr * (T / 2)) * DM) + flane + 64 * j);
#pragma unroll
        for (int rr = 0; rr < 2; ++rr) { float s = 0.f; unsigned long long* o8 = (unsigned long long*)(HB + (size_t)(m + rr * (T / 2)) * DM) + flane;
#pragma unroll
            for (int j = 0; j < 4; ++j) { const f32x4 q = v[rr][j]; s += (q.x * q.x + q.y * q.y) + (q.z * q.z + q.w * q.w); o8[64 * j] = (unsigned long long)pk2(q.x, q.y) | ((unsigned long long)pk2(q.z, q.w) << 32); }
            s = wave_sum(s); if (flane < 4) SS[(size_t)(m + rr * (T / 2)) * 4 + flane] = flane == 0 ? s : 0.f; } } }
    { const float* pin = KIN(1); bf16* PB = (bf16*)(ws + WS_PB);
      for (int i = gtid; i < 2 * T * DPLE / 16; i += NGT) { f32x4 v[4];
#pragma unroll
        for (int j = 0; j < 4; ++j) v[j] = __builtin_nontemporal_load((const f32x4*)pin + (size_t)j * (2 * T * DPLE / 16) + i);
#pragma unroll
        for (int j = 0; j < 4; ++j) ((unsigned long long*)PB)[(size_t)j * (2 * T * DPLE / 16) + i] = (unsigned long long)pk2(v[j].x, v[j].y) | ((unsigned long long)pk2(v[j].z, v[j].w) << 32); } }
    { const float* fox_w_in = KIN(8); bf16* WFZ = (bf16*)(ws + WS_WFZ);
      for (int i = gtid; i < 16 * 1024; i += NGT) { const int n = i >> 10, k = i & 1023; WFZ[i] = (bf16)f2bf(fox_w_in[(size_t)k * 3088 + 3072 + n] * norm_w[(4 + 1) * DM + k]); } }
#pragma unroll 1
    for (int fi = 0; fi < 4; ++fi) { const int li = fi >> 1, f = fi & 1;
        PREP(KIN(3) + (size_t)fi * DM * 2 * DFF, DM, 2 * DFF, (bf16*)(ws + WS_WFFI) + (size_t)fi * 2 * DFF * DM, 2 * DFF, 1, 0, norm_w + (li * 4 + (f ? 2 : 0)) * DM);
        PREP(KIN(4) + (size_t)fi * DFF * DM, DFF, DM, (bf16*)(ws + WS_WFFO) + (size_t)fi * DM * DFF, DM, 0, 0, (const float*)nullptr); }
    PREP(KIN(5), DM, 6144, (bf16*)(ws + WS_WRIN), 4096, 0, 0, norm_w + 1 * DM);
    PREP(KIN(5), DM, 6144, (bf16*)(ws + WS_WRG), 2048, 0, 4096, norm_w + 1 * DM);
    PREP(KIN(7), 2048, DM, (bf16*)(ws + WS_WRO), DM, 0, 0, (const float*)nullptr);
    PREP(KIN(8), DM, 3088, (bf16*)(ws + WS_WFIN), 3072, 0, 0, norm_w + (4 + 1) * DM);
    PREP(KIN(10), DM, DM, (bf16*)(ws + WS_WFO), DM, 0, 0, (const float*)nullptr);
#pragma unroll 1
    for (int li = 0; li < 2; ++li) {
        PREP(KIN(12) + (size_t)li * DM * DM, DM, DM, (bf16*)(ws + WS_WPG) + (size_t)li * DM * DM, DM, 0, 0, norm_w + (li * 4 + 3) * DM);
        PREP(KIN(11) + (size_t)li * DPLE * DM, DPLE, DM, (bf16*)(ws + WS_WPP) + (size_t)li * DM * DPLE, DM, 0, 0, (const float*)nullptr); }
}

template <int LI> __device__ __forceinline__ bf16* resid() { return LI ? (bf16*)KOUT : (bf16*)(KWS + WS_HB); }
template <int FI, int SITE, bool WITH_PP> __device__ __forceinline__ void ffn_half(const Frame& F, cg::grid_group& grid) {
#ifdef PROBE_FFI
    { unsigned char* ws = KWS; pg8::EpiSwiglu E{(pg8::bf16_t*)(ws + WS_POOL), (const float*)(ws + WS_SS) + (size_t)SITE * T * 4};
      GEMM_PHASE(pg8::EpiSwiglu, resid<(FI >> 1)>(), (bf16*)(ws + WS_WFFI) + (size_t)FI * 2 * DFF * DM, 2 * DFF, DM, E); }
    SEAM();
#endif
    { unsigned char* ws = KWS; pg8::EpiSwiglu E{(pg8::bf16_t*)(ws + WS_POOL), (const float*)(ws + WS_SS) + (size_t)SITE * T * 4};
      GEMM_PHASE(pg8::EpiSwiglu, resid<(FI >> 1)>(), (bf16*)(ws + WS_WFFI) + (size_t)FI * 2 * DFF * DM, 2 * DFF, DM, E); }
    SEAM();
    { unsigned char* ws = KWS; bf16* R = resid<(FI >> 1)>(); pg8::EpiRes E{(const pg8::bf16_t*)R, (pg8::bf16_t*)R, (float*)(ws + WS_SS) + (size_t)(SITE + 1) * T * 4, 0.5f, XS};
      GEMM_PHASE(pg8::EpiRes, ws + WS_POOL, (bf16*)(ws + WS_WFFO) + (size_t)FI * DM * DFF, DM, DFF, E); }
    if (WITH_PP) { unsigned char* ws = KWS; constexpr int LI = FI >> 1; pg8::EpiPlain<false> E{(pg8::bf16_t*)(ws + WS_POOL + 176 * MiB), DM, (const float*)nullptr, 0, 0, 1.0f};
      GEMM_PHASE(pg8::EpiPlain<false>, (bf16*)(ws + WS_PB) + (size_t)LI * T * DPLE, (bf16*)(ws + WS_WPP) + (size_t)LI * DM * DPLE, DM, DPLE, E); }
    SEAM();
}
template <int LI> __device__ __forceinline__ void ple_phase(const Frame& F, cg::grid_group& grid) {
    { unsigned char* ws = KWS; float* SS = (float*)(ws + WS_SS); bf16* R = resid<LI>();
      pg8::EpiPle<LI == 1> E{(const pg8::bf16_t*)R, (pg8::bf16_t*)KOUT, (float*)(ws + WS_POOL), SS + (size_t)(4 * LI + 4) * T * 4, SS + (size_t)(4 * LI + 3) * T * 4, (const pg8::bf16_t*)(ws + WS_POOL + 176 * MiB), XS};
      GEMM_PHASE(pg8::EpiPle<LI == 1>, R, (bf16*)(ws + WS_WPG) + (size_t)LI * DM * DM, DM, DM, E); }
    SEAM();
}
__device__ __forceinline__ void retention_mixer(const Frame& F, cg::grid_group& grid) {
    { unsigned char* ws = KWS; pg8::EpiRetIn E{(pg8::bf16_t*)(ws + WS_POOL), (pg8::bf16_t*)(ws + WS_POOL + 64 * MiB), (pg8::bf16_t*)(ws + WS_POOL + 128 * MiB), (const float*)(ws + WS_SS) + (size_t)T * 4, (const float*)(ws + WS_ROPE)};
      GEMM_PHASE(pg8::EpiRetIn, ws + WS_HB, ws + WS_WRIN, 4096, DM, E); }
    SEAM();
#ifdef PROBE_RET
    { unsigned char* ws = KWS; ret::ret_phase((LAS char*)F.lds, (const bf16*)(ws + WS_POOL), (const bf16*)(ws + WS_POOL + 64 * MiB), (bf16*)(ws + WS_POOL + 128 * MiB), (float*)(ws + WS_HSS), F.vcu, KARG(15) == 1ull); }
    SEAM();
#endif
    { unsigned char* ws = KWS; ret::ret_phase((LAS char*)F.lds, (const bf16*)(ws + WS_POOL), (const bf16*)(ws + WS_POOL + 64 * MiB), (bf16*)(ws + WS_POOL + 128 * MiB), (float*)(ws + WS_HSS), F.vcu); }
    SEAM();
    { unsigned char* ws = KWS; pg8::EpiRetGate E{(pg8::bf16_t*)(ws + WS_POOL + 128 * MiB), (const float*)(ws + WS_SS) + (size_t)T * 4, (const float*)(ws + WS_HSS), KIN(6)};
      GEMM_PHASE(pg8::EpiRetGate, ws + WS_HB, ws + WS_WRG, 2048, DM, E); }
    SEAM();
    { unsigned char* ws = KWS; pg8::EpiRes E{(const pg8::bf16_t*)(ws + WS_HB), (pg8::bf16_t*)(ws + WS_HB), (float*)(ws + WS_SS) + 2 * (size_t)T * 4, 1.0f, XS};
      GEMM_PHASE(pg8::EpiRes, ws + WS_POOL + 128 * MiB, ws + WS_WRO, DM, 2048, E); }
    SEAM();
}
__device__ __forceinline__ void fox_mixer(const Frame& F, cg::grid_group& grid, unsigned char* lds_generic) {
    { unsigned char* ws = KWS; pg8::EpiPlain<true> E{(pg8::bf16_t*)(ws + WS_POOL), DM, (const float*)(ws + WS_SS) + 5 * (size_t)T * 4, DM, (size_t)(64 * MiB / 2), attn_body::C2};
      GEMM_PHASE(pg8::EpiPlain<true>, KOUT, ws + WS_WFIN, 3072, DM, E); }
    { unsigned char* ws = KWS; const bf16* HB = (const bf16*)KOUT; const bf16* WFZ = (const bf16*)(ws + WS_WFZ); float* LOGF = (float*)(ws + WS_LOGF); const float* ssm = (const float*)(ws + WS_SS) + 5 * (size_t)T * 4; const float* fox_b_f = KIN(9);
      TID_FRESH(ztid, zlane, zwave)
      const int gw = F.vcu * NWAVES + zwave, NGW = F.G * NWAVES;
      for (int task = gw; task < T / 16; task += NGW) {
        const int m16 = zlane & 15, g = zlane >> 4; f32x4 a4 = (f32x4){0.f, 0.f, 0.f, 0.f};
        const bf16* ar = HB + (size_t)(16 * task + m16) * DM + 8 * g; const bf16* br = WFZ + (size_t)m16 * DM + 8 * g;
#pragma unroll 8
        for (int s = 0; s < 32; ++s) a4 = __builtin_amdgcn_mfma_f32_16x16x32_bf16(*(const bf16x8*)(ar + 32 * s), *(const bf16x8*)(br + 32 * s), a4, 0, 0, 0);
        const float bfh = fox_b_f[m16];
#pragma unroll
        for (int r = 0; r < 4; ++r) { const int t = 16 * task + 4 * g + r; const float z = a4[r] * pg8::rinv_of(ssm, t) + bfh;
            LOGF[(size_t)t * 16 + m16] = fminf(z, 0.f) - log1pf(__expf(-fabsf(z))); } } }
    SEAM();
    {
        TID_FRESH(stid, slane, swave)
        unsigned char* ws = KWS; const float* LOGF = (const float*)(ws + WS_LOGF);
        const int bh = F.vcu >> 1, b = bh >> 4, h = bh & 15; LAS float* nb = (LAS float*)(F.lds + attn_body::LDS_NB); LAS float* wtot = (LAS float*)(F.lds + attn_body::LDS_WS);
        float v[8]; float run = 0.f;
#pragma unroll
        for (int q = 0; q < 8; ++q) { run += LOGF[((size_t)b * SEQ + 8 * stid + q) * 16 + h]; v[q] = run; }
        float incl = run;
#pragma unroll
        for (int o = 1; o < 64; o <<= 1) { const float y = __int_as_float(__builtin_amdgcn_ds_bpermute((slane - o) << 2, __float_as_int(incl))); if (slane >= o) incl += y; }
        if (slane == 63) wtot[swave] = incl;
        __syncthreads();
        float off = incl - run;
        for (int w2 = 0; w2 < swave; ++w2) off += wtot[w2];
#pragma unroll
        for (int q = 0; q < 8; ++q) nb[8 * stid + q] = -(off + v[q]) * 1.4426950408889634f;
        __syncthreads();
        const attn_body::bf16* FQ = (const attn_body::bf16*)(ws + WS_POOL);
        const attn_body::AttnTensors AT{FQ, FQ + (size_t)T * DM, FQ + (size_t)2 * T * DM, (attn_body::bf16*)FQ};
        const attn_body::StaticOrder S((int)F.G, (int)blockIdx.x);
#ifdef PROBE_ATTN
        attn_body::attn_phase<attn_body::StaticOrder>((char*)lds_generic, AT, S, KARG(15) == 1ull);
#endif
        attn_body::attn_phase<attn_body::StaticOrder, 64>((char*)lds_generic, AT, S);
    }
    SEAM();
    { unsigned char* ws = KWS; bf16* R = (bf16*)KOUT; pg8::EpiRes E{(const pg8::bf16_t*)R, (pg8::bf16_t*)R, (float*)(ws + WS_SS) + 6 * (size_t)T * 4, 1.0f, XS};
      GEMM_PHASE(pg8::EpiRes, ws + WS_POOL, ws + WS_WFO, DM, DM, E); }
    SEAM();
}

__global__ void __launch_bounds__(NWAVES * 64, 2) hybrid_fwd(Args args) {
    extern __shared__ __attribute__((aligned(16))) unsigned char lds[];
    cg::grid_group grid = cg::this_grid();
    Frame F; F.lds = (LAS unsigned char*)lds;
    F.G = gridDim.x; { const int bx = blockIdx.x; F.vcu = (F.G % 8 == 0) ? (bx % 8) * (F.G / 8) + bx / 8 : bx; }
    if (threadIdx.x < 64) ((LAS unsigned*)(F.lds + RING_BYTES))[threadIdx.x] = 0u;
    __syncthreads();
    (void)xcd_barrier_post((unsigned*)(KWS + WS_BAR), (volatile LAS unsigned*)(F.lds + RING_BYTES) + 8);
    p0_prologue(F);
    grid.sync();
#ifdef PROBE_P0
    p0_prologue(F);
    SEAM();
#endif
    ffn_half<0, 0, false>(F, grid);
    retention_mixer(F, grid);
    ffn_half<1, 2, true>(F, grid);
    ple_phase<0>(F, grid);
    ffn_half<2, 4, false>(F, grid);
    fox_mixer(F, grid, lds);
    ffn_half<3, 6, true>(F, grid);
    ple_phase<1>(F, grid);
#ifdef PROBE_SYNC
#pragma unroll 1
    for (int i_ = 0; i_ < PROBE_SYNC; ++i_) grid.sync();
#endif
    { float* hres = KOUT; const float* hfin = (const float*)(KWS + WS_POOL); const float* final_norm_w = KIN(13); TID_FRESH(ntid, nlane, nwave) const int gw = F.vcu * NWAVES + nwave, NGW = F.G * NWAVES;
      for (int m = gw; m < T; m += NGW) {
        const f32x4* xi = (const f32x4*)(hfin + (size_t)m * DM) + nlane; f32x4* xr = (f32x4*)(hres + (size_t)m * DM) + nlane; const f32x4* wr = (const f32x4*)final_norm_w + nlane; f32x4 v[4]; float s = 0.f;
#pragma unroll
        for (int j = 0; j < 4; ++j) { v[j] = xi[64 * j]; s += (v[j].x * v[j].x + v[j].y * v[j].y) + (v[j].z * v[j].z + v[j].w * v[j].w); }
        const float ri = 1.0f / sqrtf(wave_sum(s) * (1.0f / DM) + 1e-6f);
#pragma unroll
        for (int j = 0; j < 4; ++j) xr[64 * j] = v[j] * ri * wr[64 * j];
      } }
}

extern "C" void kernel_launch(void* const* d_in, const int* in_sizes, int n_in, void* d_out, int out_size, void* d_ws, size_t ws_size, hipStream_t stream) {
    static int grid = 0;
    if (grid == 0) {
        if (n_in != 14 || out_size != T * DM || ws_size < WS_END) { fprintf(stderr, "kernel_launch: unexpected shapes (n_in %d out %d ws %zu)\n", n_in, out_size, ws_size); grid = -1; return; }
        int dev = 0, cus = 0, per_cu = 0;
        if (hipGetDevice(&dev) != hipSuccess || hipDeviceGetAttribute(&cus, hipDeviceAttributeMultiprocessorCount, dev) != hipSuccess) { grid = -1; return; }
        if (hipFuncSetAttribute((const void*)hybrid_fwd, hipFuncAttributeMaxDynamicSharedMemorySize, LDS_BYTES) != hipSuccess) { fprintf(stderr, "kernel_launch: hipFuncSetAttribute failed\n"); grid = -1; return; }
        if (hipOccupancyMaxActiveBlocksPerMultiprocessor(&per_cu, (const void*)hybrid_fwd, NWAVES * 64, LDS_BYTES) != hipSuccess || per_cu < 1) { fprintf(stderr, "kernel_launch: occupancy query says %d\n", per_cu); per_cu = 1; }
        (void)hipGetLastError();
        grid = cus * 1;
    }
    if (grid < 0) return;
    if (hipMemsetAsync((char*)d_ws + WS_BAR, 0, 16384, stream) != hipSuccess) { fprintf(stderr, "kernel_launch: memset failed\n"); return; }
    Args a{};
    for (int i = 0; i < 14; ++i) a.in[i] = (const float*)d_in[i];
    a.out = (float*)d_out; a.ws = (unsigned char*)d_ws;
    void* kargs[] = {&a};
    hipError_t e = hipLaunchCooperativeKernel((const void*)hybrid_fwd, dim3(grid), dim3(NWAVES * 64), kargs, LDS_BYTES, stream);
    if (e != hipSuccess) fprintf(stderr, "cooperative launch failed: %s (grid %d)\n", hipGetErrorString(e), grid);
}
```
